# Optimizing an MI355X kernel written in HIP

```python
import jax, jax.numpy as jnp
from jax import lax
import numpy as np

D_MODEL = 4096
BATCH = 2
SEQ = 4096
DEPTH = 1

HEAD_DIM = 128
DIL_CONFIGS = ((128, 1), (512, 4), (2048, 16))
N_DIL_GROUPS = 3
DIL_HEADS = 8
DIL_WIDTH = N_DIL_GROUPS * DIL_HEADS * HEAD_DIM
DIL_OUT_WIDTH = DIL_HEADS * HEAD_DIM
DIFF_HEADS = 8
DIFF_QK_WIDTH = DIFF_HEADS * 2 * HEAD_DIM
DIFF_V_DIM = 2 * HEAD_DIM
DIFF_V_WIDTH = DIFF_HEADS * DIFF_V_DIM
MEM_LEN = 256
MEM_HEADS = 4
MEM_WIDTH = MEM_HEADS * HEAD_DIM
D_FF = 4 * D_MODEL
ROPE_THETA = 10000.0
Q_BLOCK = 128
NORM_EPS = 1e-6
MASK_VALUE = -1e30
IN_SPLITS = (DIL_WIDTH, DIL_WIDTH, DIL_WIDTH,
             DIFF_QK_WIDTH, DIFF_QK_WIDTH, DIFF_V_WIDTH,
             D_MODEL, D_MODEL)
D_IN = DIL_WIDTH * 3 + DIFF_QK_WIDTH * 2 + DIFF_V_WIDTH + 2 * D_MODEL

kernel_name = "hybrid_dilated_diffattn_gated_encoder"


def _split_points():
    pts, acc = [], 0
    for s in IN_SPLITS[:-1]:
        acc += s
        pts.append(acc)
    return pts


def rms_norm(x, g):
    xf = x.astype(jnp.float32)
    y = xf * lax.rsqrt(jnp.mean(xf * xf, axis=-1, keepdims=True) + NORM_EPS)
    return (y * g.astype(jnp.float32)).astype(x.dtype)


def rope(x, positions):
    d = x.shape[-1]
    inv_freq = ROPE_THETA ** (-jnp.arange(0, d, 2, dtype=jnp.float32) / d)
    ang = positions.astype(jnp.float32)[..., None] * inv_freq
    ang = ang.reshape(ang.shape[:2] + (1,) * (x.ndim - 3) + (d // 2,))
    cos, sin = jnp.cos(ang), jnp.sin(ang)
    xf = x.astype(jnp.float32)
    x1, x2 = xf[..., : d // 2], xf[..., d // 2:]
    out = jnp.concatenate([x1 * cos - x2 * sin, x2 * cos + x1 * sin], axis=-1)
    return out.astype(x.dtype)


def dilated_attention(q, k, v):
    b, s, g_n, h_n, d = q.shape
    nb = s // Q_BLOCK
    scale = HEAD_DIM ** -0.5
    q_blocks = q.reshape(b, nb, Q_BLOCK, g_n, h_n, d).transpose(1, 0, 2, 3, 4, 5)

    def one_block(args):
        q_blk, blk = args
        qpos = blk * Q_BLOCK + jnp.arange(Q_BLOCK)
        outs, lses = [], []
        for g, (window, dil) in enumerate(DIL_CONFIGS):
            n_side = window // (2 * dil)
            offsets = jnp.arange(-n_side, n_side + 1) * dil
            idx = qpos[:, None] + offsets[None, :]
            valid = (idx >= 0) & (idx < s)
            idx = jnp.clip(idx, 0, s - 1)
            k_sel = k[:, :, g][:, idx]
            v_sel = v[:, :, g][:, idx]
            sc = jnp.einsum('bqhd,bqjhd->bhqj', q_blk[:, :, g], k_sel,
                            preferred_element_type=jnp.float32) * scale
            sc = jnp.where(valid[None, None], sc, MASK_VALUE)
            m = jnp.max(sc, axis=-1, keepdims=True)
            p = jnp.exp(sc - m)
            l = jnp.sum(p, axis=-1, keepdims=True)
            o = jnp.einsum('bhqj,bqjhd->bqhd', p, v_sel.astype(jnp.float32))
            o = o / l.transpose(0, 2, 1, 3)
            outs.append(o)
            lses.append((m + jnp.log(l))[..., 0].transpose(0, 2, 1))
        o_all = jnp.stack(outs, axis=0)
        alpha = jax.nn.softmax(jnp.stack(lses, axis=0), axis=0)[..., None]
        return jnp.sum(alpha * o_all, axis=0).astype(q.dtype)

    out = lax.map(one_block, (q_blocks, jnp.arange(nb)))
    return out.transpose(1, 0, 2, 3, 4).reshape(b, s, h_n * d)


def differential_attention(q, k, v, lam, lam_init, subln):
    b, s, h_n, _, d = q.shape
    nb = s // Q_BLOCK
    scale = HEAD_DIM ** -0.5
    q_blocks = q.reshape(b, nb, Q_BLOCK, h_n, 2, d).transpose(1, 0, 2, 3, 4, 5)
    v32 = v.astype(jnp.float32)

    def one_block(q_blk):
        sc = jnp.einsum('bqhcd,bkhcd->bchqk', q_blk, k,
                        preferred_element_type=jnp.float32) * scale
        a = jax.nn.softmax(sc, axis=-1)
        attn = a[:, 0] - lam * a[:, 1]
        o = jnp.einsum('bhqk,bkhe->bqhe', attn, v32)
        o = rms_norm(o, subln) * (1.0 - lam_init)
        return o.astype(q.dtype)

    out = lax.map(one_block, q_blocks)
    return out.transpose(1, 0, 2, 3, 4).reshape(b, s, h_n * DIFF_V_DIM)


def memory_cross_attention(h, m, w_q, w_kv, w_o):
    b, s, _ = h.shape
    q = (h @ w_q).reshape(b, s, MEM_HEADS, HEAD_DIM)
    kv = m @ w_kv
    k, v = jnp.split(kv, 2, axis=-1)
    k = k.reshape(b, m.shape[1], MEM_HEADS, HEAD_DIM)
    v = v.reshape(b, m.shape[1], MEM_HEADS, HEAD_DIM)
    sc = jnp.einsum('bshd,bmhd->bhsm', q, k,
                    preferred_element_type=jnp.float32) * HEAD_DIM ** -0.5
    a = jax.nn.softmax(sc, axis=-1)
    o = jnp.einsum('bhsm,bmhd->bshd', a, v.astype(jnp.float32)).astype(h.dtype)
    return o.reshape(b, s, MEM_WIDTH) @ w_o


def setup_inputs(seed: int = 0) -> dict:
    key = jax.random.key(seed)
    ks = jax.random.split(key, 24)
    f32 = jnp.float32

    def dense(k, fan_in, fan_out):
        return jax.random.normal(k, (DEPTH, fan_in, fan_out), f32) * fan_in ** -0.5

    def gain(k, n):
        return 1.0 + 0.05 * jax.random.normal(k, (DEPTH, n), f32)

    return {
        "x": jax.random.normal(ks[0], (BATCH, SEQ, D_MODEL), f32),
        "mem": jax.random.normal(ks[1], (BATCH, MEM_LEN, D_MODEL), f32),
        "positions": (jnp.arange(SEQ, dtype=jnp.int32)[None, :]
                      + jax.random.randint(ks[2], (BATCH, 1), 0, 1024, dtype=jnp.int32)),
        "norm_mix_pre": gain(ks[3], D_MODEL),
        "w_in": dense(ks[4], D_MODEL, D_IN),
        "w_a": dense(ks[5], DIL_OUT_WIDTH, D_MODEL),
        "w_b": dense(ks[6], DIFF_V_WIDTH, D_MODEL),
        "w_mix_out": dense(ks[7], D_MODEL, D_MODEL),
        "norm_mix_post": gain(ks[8], D_MODEL),
        "lambda_q1": 0.1 * jax.random.normal(ks[9], (DEPTH, HEAD_DIM), f32),
        "lambda_k1": 0.1 * jax.random.normal(ks[10], (DEPTH, HEAD_DIM), f32),
        "lambda_q2": 0.1 * jax.random.normal(ks[11], (DEPTH, HEAD_DIM), f32),
        "lambda_k2": 0.1 * jax.random.normal(ks[12], (DEPTH, HEAD_DIM), f32),
        "diff_subln": gain(ks[13], DIFF_V_DIM),
        "norm_mem_pre": gain(ks[14], D_MODEL),
        "norm_mem_kv": gain(ks[15], D_MODEL),
        "w_mem_q": dense(ks[16], D_MODEL, MEM_WIDTH),
        "w_mem_kv": dense(ks[17], D_MODEL, 2 * MEM_WIDTH),
        "w_mem_o": dense(ks[18], MEM_WIDTH, D_MODEL),
        "norm_mem_post": gain(ks[19], D_MODEL),
        "norm_mlp_pre": gain(ks[20], D_MODEL),
        "w_mlp_up": dense(ks[21], D_MODEL, D_FF),
        "w_mlp_down": dense(ks[22], D_FF, D_MODEL),
        "norm_mlp_post": gain(ks[23], D_MODEL),
    }


def reference(x, mem, positions, norm_mix_pre, w_in, w_a, w_b, w_mix_out, norm_mix_post,
              lambda_q1, lambda_k1, lambda_q2, lambda_k2, diff_subln,
              norm_mem_pre, norm_mem_kv, w_mem_q, w_mem_kv, w_mem_o, norm_mem_post,
              norm_mlp_pre, w_mlp_up, w_mlp_down, norm_mlp_post):
    b, s, _ = x.shape
    for layer in range(DEPTH):
        h = rms_norm(x, norm_mix_pre[layer])
        proj = h @ w_in[layer]
        qa, ka, va, qb, kb, vb, ga, gb = jnp.split(proj, _split_points(), axis=-1)

        qa = rope(qa.reshape(b, s, N_DIL_GROUPS, DIL_HEADS, HEAD_DIM), positions)
        ka = rope(ka.reshape(b, s, N_DIL_GROUPS, DIL_HEADS, HEAD_DIM), positions)
        va = va.reshape(b, s, N_DIL_GROUPS, DIL_HEADS, HEAD_DIM)
        out_a = dilated_attention(qa, ka, va)

        qb = rope(qb.reshape(b, s, DIFF_HEADS, 2, HEAD_DIM), positions)
        kb = rope(kb.reshape(b, s, DIFF_HEADS, 2, HEAD_DIM), positions)
        vb = vb.reshape(b, s, DIFF_HEADS, DIFF_V_DIM)
        lam_init = 0.8 - 0.6 * float(np.exp(-0.3 * layer))
        lam = (jnp.exp(jnp.sum(lambda_q1[layer].astype(jnp.float32) * lambda_k1[layer].astype(jnp.float32)))
               - jnp.exp(jnp.sum(lambda_q2[layer].astype(jnp.float32) * lambda_k2[layer].astype(jnp.float32)))
               + lam_init)
        out_b = differential_attention(qb, kb, vb, lam, lam_init, diff_subln[layer])

        merged = (jax.nn.sigmoid(ga) * (out_a @ w_a[layer])
                  + jax.nn.sigmoid(gb) * (out_b @ w_b[layer]))
        x = x + rms_norm(merged @ w_mix_out[layer], norm_mix_post[layer])

        h = rms_norm(x, norm_mem_pre[layer])
        m = rms_norm(mem, norm_mem_kv[layer])
        y = memory_cross_attention(h, m, w_mem_q[layer], w_mem_kv[layer], w_mem_o[layer])
        x = x + rms_norm(y, norm_mem_post[layer])

        h = rms_norm(x, norm_mlp_pre[layer])
        u = jnp.square(jax.nn.relu(h @ w_mlp_up[layer]))
        x = x + rms_norm(u @ w_mlp_down[layer], norm_mlp_post[layer])
    return x
```

```cpp
#include <hip/hip_runtime.h>
#include <cstdio>
#include <cstdint>

constexpr int DM = 4096, BATCH = 2, SEQ = 4096, MTOK = BATCH * SEQ;
constexpr int HD = 128;
constexpr int DIL_W = 3072, DIFF_QK = 2048, DIFF_V = 2048;
constexpr int C_QA = 0, C_KA = 3072, C_VA = 6144, C_QB = 9216, C_KB = 11264, C_VB = 13312, C_GA = 15360, C_GB = 19456, D_IN = 23552;
constexpr int MEM_LEN = 256, MROWS = BATCH * MEM_LEN, MEM_W = 512, D_FF = 16384;
constexpr float NORM_EPS = 1e-6f;
constexpr float ATT_SCALE = 0.088388347648318440f;

constexpr size_t MiB = 1u << 20;
constexpr size_t WS_CTL = 0, CTL_ZERO_BYTES = 1 * MiB;
constexpr size_t WS_ROPE = 2 * MiB;
constexpr size_t WS_SA = 6 * MiB;
constexpr size_t WS_SB = 6 * MiB + 64 * 1024;
constexpr size_t WS_SU = 6 * MiB + 128 * 1024;
constexpr size_t WS_SD = 6 * MiB + 160 * 1024, WS_WSUM = 6 * MiB + 176 * 1024;
constexpr size_t WS_SA0 = 6 * MiB + 192 * 1024, WS_SBIN = 6 * MiB + 256 * 1024;
constexpr size_t WS_SA4 = 6 * MiB + 384 * 1024, WS_SA5 = 6 * MiB + 416 * 1024, WS_SBA = 6 * MiB + 448 * 1024, WS_SBB = 6 * MiB + 464 * 1024;
constexpr int CW_UMAX = 65536;
constexpr size_t WS_WIN = 8 * MiB;
constexpr size_t WS_W8 = WS_WIN + 48 * MiB;
constexpr size_t WS_H8 = WS_WIN + 116 * MiB;
constexpr size_t WS_WA = WS_WIN + 184 * MiB;
constexpr size_t WS_WB = WS_WA + 8 * MiB;
constexpr size_t WS_WMIX = WS_WB + 16 * MiB;
constexpr size_t WS_WMQ = WS_WMIX + 32 * MiB;
constexpr size_t WS_WMKV = WS_WMQ + 4 * MiB;
constexpr size_t WS_WMO = WS_WMKV + 8 * MiB;
constexpr size_t WS_WUP = WS_WMO + 4 * MiB;
constexpr size_t WS_WDN = WS_WUP + 128 * MiB;
constexpr size_t WS_H = WS_WDN + 128 * MiB;
constexpr size_t WS_MB = WS_H + 64 * MiB;
constexpr size_t WS_PROJ = WS_MB + 4 * MiB;
constexpr size_t WS_U = WS_PROJ;
constexpr size_t WS_OD = WS_PROJ + 368 * MiB;
constexpr size_t WS_LSE = WS_OD + 96 * MiB;
constexpr size_t WS_OBR = WS_LSE + 1 * MiB;
constexpr size_t WS_DTMP = WS_OBR + 64 * MiB;
constexpr size_t WS_OA = WS_DTMP + 32 * MiB;
constexpr size_t WS_OBN = WS_OA + 16 * MiB;
constexpr size_t WS_MERGED = WS_OBN + 32 * MiB;
constexpr size_t WS_Y = WS_MERGED + 64 * MiB;
constexpr size_t WS_Q2 = WS_Y + 128 * MiB;
constexpr size_t WS_KV2 = WS_Q2 + 8 * MiB;
constexpr size_t WS_O2 = WS_KV2 + 1 * MiB;
constexpr size_t WS_END = WS_O2 + 8 * MiB;
constexpr int CW_TMO = 0, CW_CODE = 1, CW_BAR = 4096;

constexpr int RING_OFF = 0, RING_BYTES = 131072;
constexpr int LDSCTL_OFF = 133120, MISC_OFF = LDSCTL_OFF + 320;
constexpr int LDS_BYTES = 147456;
constexpr int NWAVES = 8;

#define GAS __attribute__((address_space(1)))
#define LAS __attribute__((address_space(3)))
typedef unsigned short bf16;
typedef unsigned v4u __attribute__((ext_vector_type(4)));
typedef unsigned v2u __attribute__((ext_vector_type(2)));
typedef float f32x4 __attribute__((ext_vector_type(4)));
typedef short bf16x8 __attribute__((ext_vector_type(8)));
typedef GAS unsigned gu32;
#define RLX_AGENT __ATOMIC_RELAXED, __HIP_MEMORY_SCOPE_AGENT
#define LDS_WAIT() asm volatile("s_waitcnt lgkmcnt(0)" ::: "memory")
#define VM_WAIT() asm volatile("s_waitcnt vmcnt(0)" ::: "memory")
__device__ __forceinline__ unsigned f2bf(float f) { unsigned u = __builtin_bit_cast(unsigned, f); return (u + 0x7fffu + ((u >> 16) & 1u)) >> 16; }
__device__ __forceinline__ unsigned pk2(float lo, float hi) { return f2bf(lo) | (f2bf(hi) << 16); }
__device__ __forceinline__ float bf2f(unsigned short b) { return __builtin_bit_cast(float, ((unsigned)b) << 16); }

__device__ const float INV_FREQ[64] = {
1.0f, 0.8659643233600653f, 0.7498942093324559f, 0.6493816315762113f, 0.5623413251903491f, 0.4869675251658631f, 0.4216965034285822f, 0.3651741272548377f,
0.31622776601683794f, 0.27384196342643613f, 0.23713737056616552f, 0.20535250264571459f, 0.1778279410038923f, 0.1539926526059492f, 0.1333521432163324f, 0.11547819846894582f,
0.1f, 0.08659643233600653f, 0.07498942093324558f, 0.06493816315762113f, 0.05623413251903491f, 0.04869675251658631f, 0.04216965034285822f, 0.03651741272548377f,
0.03162277660168379f, 0.027384196342643614f, 0.023713737056616554f, 0.02053525026457146f, 0.01778279410038923f, 0.01539926526059492f, 0.01333521432163324f, 0.011547819846894581f,
0.01f, 0.008659643233600653f, 0.007498942093324558f, 0.006493816315762113f, 0.005623413251903491f, 0.004869675251658631f, 0.004216965034285823f, 0.0036517412725483771f,
0.0031622776601683794f, 0.0027384196342643613f, 0.0023713737056616554f, 0.002053525026457146f, 0.0017782794100389228f, 0.001539926526059492f, 0.001333521432163324f, 0.0011547819846894581f,
0.001f, 0.0008659643233600653f, 0.0007498942093324559f, 0.0006493816315762113f, 0.0005623413251903491f, 0.0004869675251658631f, 0.00042169650342858224f, 0.00036517412725483773f,
0.00031622776601683794f, 0.00027384196342643613f, 0.00023713737056616554f, 0.00020535250264571459f, 0.00017782794100389227f, 0.0001539926526059492f, 0.0001333521432163324f, 0.00011547819846894582f };

#define XB_TMO      128
#define XB_XCNT(j)  (256  + 64 * (j))
#define XB_XSUB(j)  (1280 + 64 * (j))
#define XB_XGEN(j)  (2304 + 64 * (j))
#define XB_TOP      3328
#define XB_TOPGEN   3392
#define XCD_BAR_WORDS 3456
#define XB_SPIN_CAP (1u << 18)
__device__ __forceinline__ unsigned xb_ld(unsigned* p)              { return __hip_atomic_load(p, __ATOMIC_RELAXED, __HIP_MEMORY_SCOPE_AGENT); }
__device__ __forceinline__ unsigned xb_add(unsigned* p, unsigned v) { return __hip_atomic_fetch_add(p, v, __ATOMIC_RELAXED, __HIP_MEMORY_SCOPE_AGENT); }
__device__ __forceinline__ unsigned xb_xcc_id() { return (unsigned)__builtin_amdgcn_s_getreg((3 << 11) | 20) & 0xFu; }
#define XB_SPIN(cond, bar) do { unsigned _sp = 0; while (cond) { __builtin_amdgcn_s_sleep(1); \
    if ((++_sp & 255u) == 0u) { if (xb_ld(&(bar)[XB_TMO])) break; if (_sp > XB_SPIN_CAP) { atomicAdd(&(bar)[XB_TMO], 1u); break; } } } } while (0)
struct XcdBarrier { unsigned* bar; unsigned x; volatile LAS unsigned* st; };
__device__ __forceinline__ XcdBarrier xcd_barrier_post(unsigned* bar, volatile LAS unsigned* st) {
    XcdBarrier b; b.bar = bar; b.x = xb_xcc_id(); b.st = st;
    if (threadIdx.x == 0) (void)xb_add(&bar[XB_XCNT(b.x)], 1u);
    return b;
}
__device__ __forceinline__ void xcd_barrier_complete(unsigned* bar, unsigned x, unsigned& nloc, unsigned& nx) {
    const unsigned G = gridDim.x * gridDim.y * gridDim.z;
    unsigned sum, cnt, mine, sp = 0u;
    for (;;) {
        sum = 0u; cnt = 0u; mine = 0u;
#pragma unroll
        for (unsigned j = 0; j < 16; ++j) { const unsigned c = xb_ld(&bar[XB_XCNT(j)]); sum += c; cnt += (c > 0u) ? 1u : 0u; mine = (j == x) ? c : mine; }
        if (sum == G) break;
        __builtin_amdgcn_s_sleep(1);
        if ((++sp & 255u) == 0u) { if (xb_ld(&bar[XB_TMO])) break; if (sp > XB_SPIN_CAP) { atomicAdd(&bar[XB_TMO], 1u); break; } }
    }
    nloc = mine > 0u ? mine : 1u; nx = cnt > 0u ? cnt : 1u;
}
__device__ __forceinline__ void xcd_barrier(const XcdBarrier& b) {
    asm volatile("s_waitcnt vmcnt(0)" ::: "memory");
    __syncthreads();
    if (threadIdx.x == 0) {
        unsigned* bar = b.bar;
        __builtin_amdgcn_s_waitcnt(0);
        unsigned nloc = b.st[0], nx = b.st[1];
        if (nloc == 0u) { xcd_barrier_complete(bar, b.x, nloc, nx); b.st[0] = nloc; b.st[1] = nx; }
        const unsigned old = xb_add(&bar[XB_XSUB(b.x)], 1u);
        const unsigned gen = old / nloc;
        if (old + 1u == (gen + 1u) * nloc) {
            __builtin_amdgcn_fence(__ATOMIC_RELEASE, "agent");
            asm volatile("s_waitcnt vmcnt(0)" ::: "memory");
            const unsigned og = xb_add(&bar[XB_TOP], 1u);
            const unsigned tg = og / nx;
            if (og + 1u == (tg + 1u) * nx) xb_add(&bar[XB_TOPGEN], 1u);
            else XB_SPIN(xb_ld(&bar[XB_TOPGEN]) == tg, bar);
            __builtin_amdgcn_fence(__ATOMIC_ACQUIRE, "agent");
            xb_add(&bar[XB_XGEN(b.x)], 1u);
            asm volatile("s_waitcnt vmcnt(0)" ::: "memory");
        } else {
            XB_SPIN(xb_ld(&bar[XB_XGEN(b.x)]) == gen, bar);
            __builtin_amdgcn_fence(__ATOMIC_ACQUIRE, "agent");
            asm volatile("s_waitcnt vmcnt(0)" ::: "memory");
        }
    }
    __syncthreads();
}


namespace pg8 {
#define PG8_LAS __attribute__((address_space(3)))
typedef unsigned short bf16_t;
typedef short bf16x8 __attribute__((ext_vector_type(8)));
typedef float f32x4 __attribute__((ext_vector_type(4)));
typedef unsigned u32x4 __attribute__((ext_vector_type(4)));
typedef int i32x4 __attribute__((ext_vector_type(4)));
constexpr int BM = 256, BK = 64, HALF = 128, HTB = HALF * BK * 2, STAGE_BYTES = 8 * HTB, NXCD = 8, WGM = 8;
__host__ __device__ __forceinline__ int lds_byte(int r, int c) { const int st = (r >> 4) * 2 + (c >> 5), rr = r & 15, cc = c & 31, ob = rr * 64 + cc * 2; return st * 1024 + (ob ^ (((ob >> 9) & 1) << 5)); }
__host__ __device__ __forceinline__ void stage_rc(int b, int& R, int& C) { const int st = b / 1024, sb = b % 1024, swz = sb ^ (((sb >> 9) & 1) << 5); R = (st >> 1) * 16 + swz / 64; C = (st & 1) * 32 + (swz % 64) / 2; }
__host__ __device__ __forceinline__ int perm32(int rho) { const int n = rho >> 4, i = rho & 15; return 8 * (i >> 2) + 4 * n + (i & 3); }
struct Unit { int pm, pn; };
struct Gemm { const bf16_t* A; const bf16_t* Bt; int M, N, K, lda, ldb; int rlo = 0, ra0 = 0, ra1 = 0; };
struct StaticOrder {
    int nM, nN, nwg, G, c;
    __host__ __device__ void init(int M, int N, int G_, int c_) { nM = M / BM; nN = N / BM; nwg = nM * nN; G = G_; c = c_; }
    __host__ __device__ bool next(int i, Unit& u) const {
        const long L = (long)i * G + c; if (L >= nwg) return false;
        int wgid = (int)L; { const int q = nwg / NXCD, r = nwg % NXCD, xcd = wgid % NXCD, off = wgid / NXCD; wgid = (xcd < r ? xcd * (q + 1) : r * (q + 1) + (xcd - r) * q) + off; }
        const int nig = WGM * nN, gid = wgid / nig, fm = gid * WGM, gsz = (nM - fm) < WGM ? (nM - fm) : WGM;
        u.pm = fm + ((wgid % nig) % gsz); u.pn = (wgid % nig) / gsz; return true;
    }
    __device__ __forceinline__ void a_ready(const Unit&) const {}
    __device__ __forceinline__ void done(const Unit&) const {}
};
__device__ __forceinline__ unsigned cvt_pk_bf16(float lo, float hi) { unsigned r; asm volatile("v_cvt_pk_bf16_f32 %0, %1, %2" : "=v"(r) : "v"(lo), "v"(hi)); return r;}
struct EpiF32 {
    static constexpr bool PERM = false, AFTER_DRAIN = false, ROPEMAP = false;
    float* C; int ldc;
    __device__ __forceinline__ void operator()(const f32x4 (&acc)[2][2][4][2], const Unit& u, int wr, int wc, int fr, int fq) const {
        const int row0 = u.pm * BM + wr * 64 + fr, col0 = u.pn * BM + wc * 32 + 4 * fq;
#pragma unroll
        for (int ai = 0; ai < 2; ++ai)
#pragma unroll
            for (int m = 0; m < 4; ++m) { float* rowp = C + (size_t)(row0 + ai * HALF + m * 16) * ldc + col0;
#pragma unroll
                for (int bj = 0; bj < 2; ++bj)
#pragma unroll
                    for (int n = 0; n < 2; ++n) *(f32x4*)(rowp + bj * HALF + n * 16) = acc[ai][bj][m][n]; }
    }
};
template <int ACT  > struct EpiBf16 {
    static constexpr bool PERM = true, AFTER_DRAIN = false, ROPEMAP = false;
    bf16_t* O; int ldc;
    __device__ __forceinline__ void operator()(const f32x4 (&acc)[2][2][4][2], const Unit& u, int wr, int wc, int fr, int fq) const {
        const int row0 = u.pm * BM + wr * 64 + fr, col0 = u.pn * BM + wc * 32 + 8 * fq;
#pragma unroll
        for (int ai = 0; ai < 2; ++ai)
#pragma unroll
            for (int m = 0; m < 4; ++m) { bf16_t* rowp = O + (size_t)(row0 + ai * HALF + m * 16) * ldc + col0;
#pragma unroll
                for (int bj = 0; bj < 2; ++bj) { f32x4 v0 = acc[ai][bj][m][0], v1 = acc[ai][bj][m][1];
                    if (ACT == 1) {
#pragma unroll
                        for (int j = 0; j < 4; ++j) { const float a = fmaxf(v0[j], 0.f), b = fmaxf(v1[j], 0.f); v0[j] = a * a; v1[j] = b * b; } }
                    u32x4 w; w.x = cvt_pk_bf16(v0[0], v0[1]); w.y = cvt_pk_bf16(v0[2], v0[3]); w.z = cvt_pk_bf16(v1[0], v1[1]); w.w = cvt_pk_bf16(v1[2], v1[3]);
                    *(u32x4*)(rowp + bj * HALF) = w; } }
    }
};
struct EpiProjI8 {
    static constexpr bool PERM = true, AFTER_DRAIN = false, ROPEMAP = true;
    bf16_t* O; const float* rope; const float* sa; const float* sb;
    __device__ __forceinline__ void operator()(const f32x4 (&acc)[2][2][4][2], const Unit& u, int wr, int wc, int fr, int fq) const {
        const int row0 = u.pm * BM + wr * 64 + fr, cb = u.pn * BM + (wc >> 1) * 128, i0 = (wc & 1) * 32 + 8 * fq;
        const int kind = (u.pn < 24 || (u.pn >= 36 && u.pn < 52)) ? 1 : (u.pn >= 60 ? 2 : 0);
        const f32x4 sa0 = *(const f32x4*)(sb + cb + i0), sa1 = *(const f32x4*)(sb + cb + i0 + 4), sb0 = *(const f32x4*)(sb + cb + 64 + i0), sb1 = *(const f32x4*)(sb + cb + 64 + i0 + 4);
        float srv[8];
#pragma unroll
        for (int i = 0; i < 8; ++i) srv[i] = sa[(size_t)(row0 + (i >> 2) * HALF + (i & 3) * 16)];
#pragma unroll
        for (int am = 0; am < 4; ++am) { const int ai = am >> 1;
            f32x4 rt[4][4];
            if (kind == 1) {
#pragma unroll
                for (int m = 2 * (am & 1); m < 2 * (am & 1) + 2; ++m) { const f32x4* rp = (const f32x4*)(rope + ((size_t)(row0 + ai * HALF + m * 16) * 64 + i0) * 2); rt[m][0] = rp[0]; rt[m][1] = rp[1]; rt[m][2] = rp[2]; rt[m][3] = rp[3]; } }
#pragma unroll
            for (int m = 2 * (am & 1); m < 2 * (am & 1) + 2; ++m) { const size_t r = (size_t)(row0 + ai * HALF + m * 16); bf16_t* rowp = O + r * D_IN + cb + i0; const float sr = srv[ai * 4 + m];
                f32x4 a0 = __builtin_convertvector(__builtin_bit_cast(i32x4, acc[ai][0][m][0]), f32x4) * (sa0 * sr), a1 = __builtin_convertvector(__builtin_bit_cast(i32x4, acc[ai][0][m][1]), f32x4) * (sa1 * sr);
                f32x4 b0 = __builtin_convertvector(__builtin_bit_cast(i32x4, acc[ai][1][m][0]), f32x4) * (sb0 * sr), b1 = __builtin_convertvector(__builtin_bit_cast(i32x4, acc[ai][1][m][1]), f32x4) * (sb1 * sr);
                if (kind == 1) { const f32x4 t0 = rt[m][0], t1 = rt[m][1], t2 = rt[m][2], t3 = rt[m][3];
                    const f32x4 c0 = {t0[0], t0[2], t1[0], t1[2]}, s0 = {t0[1], t0[3], t1[1], t1[3]}, c1 = {t2[0], t2[2], t3[0], t3[2]}, s1 = {t2[1], t2[3], t3[1], t3[3]};
                    const f32x4 na0 = a0 * c0 - b0 * s0, nb0 = b0 * c0 + a0 * s0, na1 = a1 * c1 - b1 * s1, nb1 = b1 * c1 + a1 * s1;
                    a0 = na0; b0 = nb0; a1 = na1; b1 = nb1; }
                if (kind == 2) {
#pragma unroll
                    for (int j = 0; j < 4; ++j) { a0[j] = __builtin_amdgcn_rcpf(1.f + __expf(-a0[j])); a1[j] = __builtin_amdgcn_rcpf(1.f + __expf(-a1[j]));
                                                  b0[j] = __builtin_amdgcn_rcpf(1.f + __expf(-b0[j])); b1[j] = __builtin_amdgcn_rcpf(1.f + __expf(-b1[j])); } }
                u32x4 w; w.x = cvt_pk_bf16(a0[0], a0[1]); w.y = cvt_pk_bf16(a0[2], a0[3]); w.z = cvt_pk_bf16(a1[0], a1[1]); w.w = cvt_pk_bf16(a1[2], a1[3]);
                *(u32x4*)(rowp) = w;
                w.x = cvt_pk_bf16(b0[0], b0[1]); w.y = cvt_pk_bf16(b0[2], b0[3]); w.z = cvt_pk_bf16(b1[0], b1[1]); w.w = cvt_pk_bf16(b1[2], b1[3]);
                *(u32x4*)(rowp + 64) = w; } }
    }
};
typedef unsigned short u16x2 __attribute__((ext_vector_type(2)));
struct EpiI8Relu2 {
    static constexpr bool PERM = true, AFTER_DRAIN = false, ROPEMAP = false;
    bf16_t* O; int ldc; const float* sa; const float* sb; unsigned* umax;
    __device__ __forceinline__ void operator()(const f32x4 (&acc)[2][2][4][2], const Unit& u, int wr, int wc, int fr, int fq) const {
        const int row0 = u.pm * BM + wr * 64 + fr, col0 = u.pn * BM + wc * 32 + 8 * fq;
        f32x4 sbv[2][2];
#pragma unroll
        for (int bj = 0; bj < 2; ++bj) { sbv[bj][0] = *(const f32x4*)(sb + col0 + bj * HALF); sbv[bj][1] = *(const f32x4*)(sb + col0 + bj * HALF + 4); }
        float srv[8];
#pragma unroll
        for (int i = 0; i < 8; ++i) srv[i] = sa[(size_t)(row0 + (i >> 2) * HALF + (i & 3) * 16)];
#pragma unroll
        for (int ai = 0; ai < 2; ++ai)
#pragma unroll
            for (int m = 0; m < 4; ++m) { const size_t r = (size_t)(row0 + ai * HALF + m * 16); const float sr = srv[ai * 4 + m]; bf16_t* rowp = O + r * ldc + col0; u16x2 rp = {0, 0};
#pragma unroll
                for (int bj = 0; bj < 2; ++bj) {
                    f32x4 v0 = __builtin_convertvector(__builtin_bit_cast(i32x4, acc[ai][bj][m][0]), f32x4) * (sbv[bj][0] * sr);
                    f32x4 v1 = __builtin_convertvector(__builtin_bit_cast(i32x4, acc[ai][bj][m][1]), f32x4) * (sbv[bj][1] * sr);
#pragma unroll
                    for (int j = 0; j < 4; ++j) { const float a = fmaxf(v0[j], 0.f), b = fmaxf(v1[j], 0.f); v0[j] = a * a; v1[j] = b * b; }
                    u32x4 w; w.x = cvt_pk_bf16(v0[0], v0[1]); w.y = cvt_pk_bf16(v0[2], v0[3]); w.z = cvt_pk_bf16(v1[0], v1[1]); w.w = cvt_pk_bf16(v1[2], v1[3]);
                    *(u32x4*)(rowp + bj * HALF) = w;
#pragma unroll
                    for (int j = 0; j < 4; ++j) { const unsigned wj = w[j]; rp = __builtin_elementwise_max(rp, __builtin_bit_cast(u16x2, wj)); } }
                unsigned rmx = (unsigned)(rp.x > rp.y ? rp.x : rp.y) << 16;
                { const unsigned a = (unsigned)__shfl_xor((int)rmx, 16); rmx = rmx > a ? rmx : a; const unsigned b = (unsigned)__shfl_xor((int)rmx, 32); rmx = rmx > b ? rmx : b; }
                if (fq == 0) atomicMax(umax + r, rmx); }
    }
};
struct EpiI8Down {
    static constexpr bool PERM = true, AFTER_DRAIN = false, ROPEMAP = false;
    bf16_t* O; int ldc; const float* sa; const float* sb; const int* wsum;
    __device__ __forceinline__ void operator()(const f32x4 (&acc)[2][2][4][2], const Unit& u, int wr, int wc, int fr, int fq) const {
        const int row0 = u.pm * BM + wr * 64 + fr, col0 = u.pn * BM + wc * 32 + 8 * fq;
        f32x4 sbv[2][2], off[2][2];
#pragma unroll
        for (int bj = 0; bj < 2; ++bj)
#pragma unroll
            for (int n = 0; n < 2; ++n) { sbv[bj][n] = *(const f32x4*)(sb + col0 + bj * HALF + 4 * n); off[bj][n] = __builtin_convertvector(*(const i32x4*)(wsum + col0 + bj * HALF + 4 * n), f32x4) * 128.f; }
        float srv[8];
#pragma unroll
        for (int i = 0; i < 8; ++i) srv[i] = sa[(size_t)(row0 + (i >> 2) * HALF + (i & 3) * 16)];
#pragma unroll
        for (int ai = 0; ai < 2; ++ai)
#pragma unroll
            for (int m = 0; m < 4; ++m) { const size_t r = (size_t)(row0 + ai * HALF + m * 16); const float sr = srv[ai * 4 + m]; bf16_t* rowp = O + r * ldc + col0;
#pragma unroll
                for (int bj = 0; bj < 2; ++bj) {
                    const f32x4 v0 = (__builtin_convertvector(__builtin_bit_cast(i32x4, acc[ai][bj][m][0]), f32x4) + off[bj][0]) * (sbv[bj][0] * sr);
                    const f32x4 v1 = (__builtin_convertvector(__builtin_bit_cast(i32x4, acc[ai][bj][m][1]), f32x4) + off[bj][1]) * (sbv[bj][1] * sr);
                    u32x4 w; w.x = cvt_pk_bf16(v0[0], v0[1]); w.y = cvt_pk_bf16(v0[2], v0[3]); w.z = cvt_pk_bf16(v1[0], v1[1]); w.w = cvt_pk_bf16(v1[2], v1[3]);
                    *(u32x4*)(rowp + bj * HALF) = w; } }
    }
};
__device__ __forceinline__ float bfl(unsigned w) { return __builtin_bit_cast(float, w << 16); }
__device__ __forceinline__ float bfh(unsigned w) { return __builtin_bit_cast(float, w & 0xffff0000u); }
template <bool ADD> struct EpiGate {
    static constexpr bool PERM = true, AFTER_DRAIN = false, ROPEMAP = false;
    bf16_t* O; int ldc; const bf16_t* gate; int ldg;
    __device__ __forceinline__ void operator()(const f32x4 (&acc)[2][2][4][2], const Unit& u, int wr, int wc, int fr, int fq) const {
        const int row0 = u.pm * BM + wr * 64 + fr, col0 = u.pn * BM + wc * 32 + 8 * fq;
#pragma unroll
        for (int am = 0; am < 4; ++am) { const int ai = am >> 1;
            u32x4 gv[4][2], pv[4][2];
#pragma unroll
            for (int m = 2 * (am & 1); m < 2 * (am & 1) + 2; ++m) { const size_t r = (size_t)(row0 + ai * HALF + m * 16);
#pragma unroll
                for (int bj = 0; bj < 2; ++bj) { gv[m][bj] = *(const u32x4*)(gate + r * ldg + col0 + bj * HALF); if (ADD) pv[m][bj] = *(const u32x4*)(O + r * ldc + col0 + bj * HALF); } }
#pragma unroll
            for (int m = 2 * (am & 1); m < 2 * (am & 1) + 2; ++m) { const size_t r = (size_t)(row0 + ai * HALF + m * 16); bf16_t* rowp = O + r * ldc + col0;
#pragma unroll
                for (int bj = 0; bj < 2; ++bj) { f32x4 v0 = acc[ai][bj][m][0], v1 = acc[ai][bj][m][1];
                    const u32x4 g = gv[m][bj];
                    v0[0] *= bfl(g.x); v0[1] *= bfh(g.x); v0[2] *= bfl(g.y); v0[3] *= bfh(g.y); v1[0] *= bfl(g.z); v1[1] *= bfh(g.z); v1[2] *= bfl(g.w); v1[3] *= bfh(g.w);
                    if (ADD) { const u32x4 p = pv[m][bj];
                        v0[0] += bfl(p.x); v0[1] += bfh(p.x); v0[2] += bfl(p.y); v0[3] += bfh(p.y); v1[0] += bfl(p.z); v1[1] += bfh(p.z); v1[2] += bfl(p.w); v1[3] += bfh(p.w); }
                    u32x4 w; w.x = cvt_pk_bf16(v0[0], v0[1]); w.y = cvt_pk_bf16(v0[2], v0[3]); w.z = cvt_pk_bf16(v1[0], v1[1]); w.w = cvt_pk_bf16(v1[2], v1[3]);
                    *(u32x4*)(rowp + bj * HALF) = w; } } }
    }
};
template <bool ADD> struct EpiGateI8 {
    static constexpr bool PERM = true, AFTER_DRAIN = false, ROPEMAP = false;
    bf16_t* O; int ldc; const bf16_t* gate; int ldg; const float* sa; const float* sb;
    __device__ __forceinline__ void operator()(const f32x4 (&acc)[2][2][4][2], const Unit& u, int wr, int wc, int fr, int fq) const {
        const int row0 = u.pm * BM + wr * 64 + fr, col0 = u.pn * BM + wc * 32 + 8 * fq;
        f32x4 sbv[2][2];
#pragma unroll
        for (int bj = 0; bj < 2; ++bj) { sbv[bj][0] = *(const f32x4*)(sb + col0 + bj * HALF); sbv[bj][1] = *(const f32x4*)(sb + col0 + bj * HALF + 4); }
        float srv[8];
#pragma unroll
        for (int i = 0; i < 8; ++i) srv[i] = sa[(size_t)(row0 + (i >> 2) * HALF + (i & 3) * 16)];
#pragma unroll
        for (int ai = 0; ai < 2; ++ai) {
            u32x4 gv[4][2], pv[4][2];
#pragma unroll
            for (int m = 0; m < 4; ++m) { const size_t r = (size_t)(row0 + ai * HALF + m * 16);
#pragma unroll
                for (int bj = 0; bj < 2; ++bj) { gv[m][bj] = *(const u32x4*)(gate + r * ldg + col0 + bj * HALF); if (ADD) pv[m][bj] = *(const u32x4*)(O + r * ldc + col0 + bj * HALF); } }
#pragma unroll
            for (int m = 0; m < 4; ++m) { const size_t r = (size_t)(row0 + ai * HALF + m * 16); bf16_t* rowp = O + r * ldc + col0; const float sr = srv[ai * 4 + m];
#pragma unroll
                for (int bj = 0; bj < 2; ++bj) {
                    f32x4 v0 = __builtin_convertvector(__builtin_bit_cast(i32x4, acc[ai][bj][m][0]), f32x4) * (sbv[bj][0] * sr);
                    f32x4 v1 = __builtin_convertvector(__builtin_bit_cast(i32x4, acc[ai][bj][m][1]), f32x4) * (sbv[bj][1] * sr);
                    const u32x4 g = gv[m][bj];
                    v0[0] *= bfl(g.x); v0[1] *= bfh(g.x); v0[2] *= bfl(g.y); v0[3] *= bfh(g.y); v1[0] *= bfl(g.z); v1[1] *= bfh(g.z); v1[2] *= bfl(g.w); v1[3] *= bfh(g.w);
                    if (ADD) { const u32x4 p = pv[m][bj];
                        v0[0] += bfl(p.x); v0[1] += bfh(p.x); v0[2] += bfl(p.y); v0[3] += bfh(p.y); v1[0] += bfl(p.z); v1[1] += bfh(p.z); v1[2] += bfl(p.w); v1[3] += bfh(p.w); }
                    u32x4 w; w.x = cvt_pk_bf16(v0[0], v0[1]); w.y = cvt_pk_bf16(v0[2], v0[3]); w.z = cvt_pk_bf16(v1[0], v1[1]); w.w = cvt_pk_bf16(v1[2], v1[3]);
                    *(u32x4*)(rowp + bj * HALF) = w; } } }
    }
};
template <bool NOROPE = false> struct EpiProj {
    static constexpr bool PERM = true, AFTER_DRAIN = false, ROPEMAP = true;
    bf16_t* O; const float* rope; float sc;
    __device__ __forceinline__ void operator()(const f32x4 (&acc)[2][2][4][2], const Unit& u, int wr, int wc, int fr, int fq) const {
        const int row0 = u.pm * BM + wr * 64 + fr, cb = u.pn * BM + (wc >> 1) * 128, i0 = (wc & 1) * 32 + 8 * fq;
        const int kind = NOROPE ? (u.pn >= 60 ? 2 : 0) : ((u.pn < 24 || (u.pn >= 36 && u.pn < 52)) ? 1 : (u.pn >= 60 ? 2 : 0));
#pragma unroll
        for (int am = 0; am < 4; ++am) { const int ai = am >> 1;
            f32x4 rt[4][4];
            if (!NOROPE && kind == 1) {
#pragma unroll
                for (int m = 2 * (am & 1); m < 2 * (am & 1) + 2; ++m) { const f32x4* rp = (const f32x4*)(rope + ((size_t)(row0 + ai * HALF + m * 16) * 64 + i0) * 2); rt[m][0] = rp[0]; rt[m][1] = rp[1]; rt[m][2] = rp[2]; rt[m][3] = rp[3]; } }
#pragma unroll
            for (int m = 2 * (am & 1); m < 2 * (am & 1) + 2; ++m) { const size_t r = (size_t)(row0 + ai * HALF + m * 16); bf16_t* rowp = O + r * D_IN + cb + i0;
                f32x4 a0 = acc[ai][0][m][0] * sc, a1 = acc[ai][0][m][1] * sc, b0 = acc[ai][1][m][0] * sc, b1 = acc[ai][1][m][1] * sc;
                if (!NOROPE && kind == 1) { const f32x4 t0 = rt[m][0], t1 = rt[m][1], t2 = rt[m][2], t3 = rt[m][3];
                    const f32x4 c0 = {t0[0], t0[2], t1[0], t1[2]}, s0 = {t0[1], t0[3], t1[1], t1[3]}, c1 = {t2[0], t2[2], t3[0], t3[2]}, s1 = {t2[1], t2[3], t3[1], t3[3]};
                    const f32x4 na0 = a0 * c0 - b0 * s0, nb0 = b0 * c0 + a0 * s0, na1 = a1 * c1 - b1 * s1, nb1 = b1 * c1 + a1 * s1;
                    a0 = na0; b0 = nb0; a1 = na1; b1 = nb1; }
                if (kind == 2) {
#pragma unroll
                    for (int j = 0; j < 4; ++j) { a0[j] = __builtin_amdgcn_rcpf(1.f + __expf(-a0[j])); a1[j] = __builtin_amdgcn_rcpf(1.f + __expf(-a1[j]));
                                                  b0[j] = __builtin_amdgcn_rcpf(1.f + __expf(-b0[j])); b1[j] = __builtin_amdgcn_rcpf(1.f + __expf(-b1[j])); } }
                u32x4 w; w.x = cvt_pk_bf16(a0[0], a0[1]); w.y = cvt_pk_bf16(a0[2], a0[3]); w.z = cvt_pk_bf16(a1[0], a1[1]); w.w = cvt_pk_bf16(a1[2], a1[3]);
                *(u32x4*)(rowp) = w;
                w.x = cvt_pk_bf16(b0[0], b0[1]); w.y = cvt_pk_bf16(b0[2], b0[3]); w.z = cvt_pk_bf16(b1[0], b1[1]); w.w = cvt_pk_bf16(b1[2], b1[3]);
                *(u32x4*)(rowp + 64) = w; } }
    }
};

typedef int i32x8 __attribute__((ext_vector_type(8)));
typedef float f32x8 __attribute__((ext_vector_type(8)));
template <class Epi, class Sched, bool ALIGN_EPI = false, bool SP2 = false, bool FP8 = false, bool I8 = false>
__device__ __forceinline__ void gemm_phase(PG8_LAS unsigned char* lds, const Gemm g, const Sched& S, const Epi& E) {
    int tid = threadIdx.x; asm volatile("" : "+v"(tid));
    const int wid = __builtin_amdgcn_readfirstlane(tid >> 6), lane = tid & 63, wr = wid >> 2, wc = wid & 3, fr = lane & 15, fq = lane >> 4;
    constexpr int ESZ = (FP8 || I8) ? 1 : 2;
    const int K = g.K, nt = K / ((FP8 || I8) ? 2 * BK : BK);
    unsigned voffA[2], voffB[2];
#pragma unroll
    for (int i = 0; i < 2; ++i) { int R, C; stage_rc(tid * 16 + i * 8192, R, C); int Rb = Epi::PERM ? ((R & ~31) + perm32(R & 31)) : R;
        if (Epi::ROPEMAP) Rb = (Rb >> 6) * 128 + (Rb & 63);
        voffA[i] = (unsigned)(R * g.lda * ESZ + C * 2); voffB[i] = (unsigned)(Rb * g.ldb * ESZ + C * 2); }
    const size_t kstep = (size_t)(BK * 2);
    const size_t hstepA = (size_t)HALF * g.lda * ESZ, hstepB = (size_t)(Epi::ROPEMAP ? 64 : HALF) * g.ldb * ESZ;
    const size_t tstepA = (size_t)BM * g.lda * ESZ, tstepB = (size_t)BM * g.ldb * ESZ;
    const unsigned ldsw = (unsigned)wid * 1024u;
    const int aoff = lds_byte(wr * 64 + fr, fq * 8), boff = lds_byte(wc * 32 + fr, fq * 8);
#define PG8_SA(b, h) (((b) * 2 + (h)) * HTB)
#define PG8_SB(b, h) ((4 + (b) * 2 + (h)) * HTB)
#define PG8_STAGE(bufoff, gbase, voff) do { if constexpr (FP8) { int t_ = tid; asm volatile("" : "+v"(t_));     \
            _Pragma("unroll") for (int _i = 0; _i < 2; ++_i) { int R_, C_; stage_rc(t_ * 16 + _i * 8192, R_, C_); int Rb_ = ((&(voff)[0] == &voffB[0]) && Epi::PERM) ? ((R_ & ~31) + perm32(R_ & 31)) : R_; \
                if ((&(voff)[0] == &voffB[0]) && Epi::ROPEMAP) Rb_ = (Rb_ >> 6) * 128 + (Rb_ & 63); const unsigned o_ = (unsigned)(Rb_ * ((&(voff)[0] == &voffB[0]) ? g.ldb : g.lda) * ESZ + C_ * 2); \
                __builtin_amdgcn_global_load_lds((const unsigned*)((const char*)(gbase) + o_), (PG8_LAS unsigned*)(lds + (bufoff) + ldsw + _i * 8192), 16, 0, 0); } } \
        else { _Pragma("unroll") for (int _i = 0; _i < 2; ++_i) \
        __builtin_amdgcn_global_load_lds((const unsigned*)((const char*)(gbase) + (voff)[_i]), (PG8_LAS unsigned*)(lds + (bufoff) + ldsw + _i * 8192), 16, 0, 0); } } while (0)
#define PG8_LD8(X) __builtin_shufflevector(__builtin_bit_cast(f32x4, X[0]), __builtin_bit_cast(f32x4, X[1]), 0, 1, 2, 3, 4, 5, 6, 7)
#define PG8_LDA(dst, b, h) do { _Pragma("unroll") for (int m = 0; m < 4; ++m) _Pragma("unroll") for (int k = 0; k < 2; ++k) dst[m][k] = *(const PG8_LAS bf16x8*)(lds + PG8_SA(b, h) + aoff + m * 2048 + k * 1024); \
        if constexpr (FP8) { _Pragma("unroll") for (int m = 0; m < 4; ++m) dst##8[m] = PG8_LD8(dst[m]); } } while (0)
#define PG8_LDB(dst, b, h) do { _Pragma("unroll") for (int n = 0; n < 2; ++n) _Pragma("unroll") for (int k = 0; k < 2; ++k) dst[n][k] = *(const PG8_LAS bf16x8*)(lds + PG8_SB(b, h) + boff + n * 2048 + k * 1024); \
        if constexpr (FP8) { _Pragma("unroll") for (int n = 0; n < 2; ++n) dst##8[n] = PG8_LD8(dst[n]); } } while (0)
#define PG8_MMA(ai, bj, At, Bt) do { __builtin_amdgcn_s_setprio(1); _Pragma("unroll") for (int m = 0; m < 4; ++m) _Pragma("unroll") for (int n = 0; n < 2; ++n) { \
        if constexpr (FP8) acc[ai][bj][m][n] = __builtin_amdgcn_mfma_scale_f32_16x16x128_f8f6f4(__builtin_bit_cast(i32x8, Bt##8[n]), __builtin_bit_cast(i32x8, At##8[m]), acc[ai][bj][m][n], 0, 0, 0, 0, 0, 0); \
        else if constexpr (I8) { _Pragma("unroll") for (int k = 0; k < 2; ++k) acc[ai][bj][m][n] = __builtin_bit_cast(f32x4, __builtin_amdgcn_mfma_i32_16x16x64_i8(__builtin_bit_cast(i32x4, Bt[n][k]), __builtin_bit_cast(i32x4, At[m][k]), __builtin_bit_cast(i32x4, acc[ai][bj][m][n]), 0, 0, 0)); } \
        else { _Pragma("unroll") for (int k = 0; k < 2; ++k) acc[ai][bj][m][n] = __builtin_amdgcn_mfma_f32_16x16x32_bf16(Bt[n][k], At[m][k], acc[ai][bj][m][n], 0, 0, 0); } } __builtin_amdgcn_s_setprio(0); } while (0)
#define PG8_WAIT_V(n) asm volatile("s_waitcnt vmcnt(" #n ")" ::: "memory")
#define PG8_WAIT_L(n) asm volatile("s_waitcnt lgkmcnt(" #n ")" ::: "memory")
#define PG8_BAR __builtin_amdgcn_s_barrier()
#define PG8_SCHED __builtin_amdgcn_sched_barrier(0)
    Unit cur, nxt; int ui = 0;
    if (!S.next(0, cur)) return;
    f32x4 acc[2][2][4][2];
#pragma unroll
    for (int a = 0; a < 2; ++a)
#pragma unroll
        for (int b = 0; b < 2; ++b)
#pragma unroll
            for (int m = 0; m < 4; ++m)
#pragma unroll
                for (int n = 0; n < 2; ++n) acc[a][b][m][n] = (f32x4){0.f, 0.f, 0.f, 0.f};
    bf16x8 At[4][2], B0[2][2], B1[2][2]; f32x8 At8[4], B08[2], B18[2];
    const char* cA = (const char*)g.A + (size_t)cur.pm * tstepA; const char* cB = (const char*)g.Bt + (size_t)cur.pn * tstepB;
    S.a_ready(cur);
    if constexpr (SP2) {
        PG8_STAGE(PG8_SB(0, 0), cB, voffB); PG8_STAGE(PG8_SB(0, 1), cB + hstepB, voffB); PG8_STAGE(PG8_SA(0, 0), cA, voffA); PG8_STAGE(PG8_SA(0, 1), cA + hstepA, voffA);
        if (wr == 1) PG8_BAR;
        PG8_WAIT_V(2); PG8_BAR;
        PG8_STAGE(PG8_SB(1, 0), cB + kstep, voffB); PG8_STAGE(PG8_SA(1, 0), cA + kstep, voffA); PG8_STAGE(PG8_SB(1, 1), cB + hstepB + kstep, voffB);
        PG8_WAIT_V(6); PG8_BAR;
    } else {
        PG8_STAGE(PG8_SB(0, 0), cB, voffB); PG8_STAGE(PG8_SA(0, 0), cA, voffA); PG8_STAGE(PG8_SB(0, 1), cB + hstepB, voffB); PG8_STAGE(PG8_SA(0, 1), cA + hstepA, voffA);
        if (wr == 1) PG8_BAR;
        PG8_WAIT_V(4); PG8_BAR;
        PG8_STAGE(PG8_SB(1, 0), cB + kstep, voffB); PG8_STAGE(PG8_SA(1, 0), cA + kstep, voffA); PG8_STAGE(PG8_SB(1, 1), cB + hstepB + kstep, voffB);
        PG8_WAIT_V(6); PG8_BAR;
    }
    for (;;) {
        const bool has_next = S.next(ui + 1, nxt);
        const char* nA = has_next ? (const char*)g.A + (size_t)nxt.pm * tstepA : cA; const char* nB = has_next ? (const char*)g.Bt + (size_t)nxt.pn * tstepB : cB;
        for (int t = 0; t < nt; t += 2) {
            const bool last = (t == nt - 2);
            const char* a1 = cA + (size_t)(t + 1) * kstep;
            const char* a2 = last ? nA : cA + (size_t)(t + 2) * kstep; const char* b2 = last ? nB : cB + (size_t)(t + 2) * kstep;
            const char* a3 = a2 + kstep; const char* b3 = b2 + kstep;
            if (last && has_next) S.a_ready(nxt);
            if constexpr (SP2) {
            PG8_LDB(B0, 0, 0); PG8_LDB(B1, 0, 1); PG8_SCHED; PG8_LDA(At, 0, 0); PG8_STAGE(PG8_SA(1, 1), a1 + hstepA, voffA);
            PG8_WAIT_V(8); PG8_WAIT_L(0); PG8_BAR; PG8_MMA(0, 0, At, B0); PG8_MMA(0, 1, At, B1); PG8_BAR; PG8_SCHED;
            PG8_LDA(At, 0, 1); PG8_STAGE(PG8_SB(0, 0), b2, voffB); PG8_STAGE(PG8_SB(0, 1), b2 + hstepB, voffB); PG8_STAGE(PG8_SA(0, 0), a2, voffA);
            PG8_WAIT_V(8); PG8_WAIT_L(0); PG8_BAR; PG8_MMA(1, 0, At, B0); PG8_MMA(1, 1, At, B1); PG8_BAR; PG8_SCHED;
            PG8_LDB(B0, 1, 0); PG8_LDB(B1, 1, 1); PG8_SCHED; PG8_LDA(At, 1, 0); PG8_STAGE(PG8_SA(0, 1), a2 + hstepA, voffA);
            PG8_WAIT_V(8); PG8_WAIT_L(0); PG8_BAR; PG8_MMA(0, 0, At, B0); PG8_MMA(0, 1, At, B1); PG8_BAR; PG8_SCHED;
            PG8_LDA(At, 1, 1); PG8_STAGE(PG8_SB(1, 0), b3, voffB); PG8_STAGE(PG8_SB(1, 1), b3 + hstepB, voffB); PG8_STAGE(PG8_SA(1, 0), a3, voffA);
            PG8_WAIT_V(8); PG8_WAIT_L(0); PG8_BAR; PG8_MMA(1, 0, At, B0); PG8_MMA(1, 1, At, B1); PG8_BAR; PG8_SCHED;
            } else {
            PG8_LDB(B0, 0, 0); PG8_SCHED; PG8_LDA(At, 0, 0); PG8_STAGE(PG8_SA(1, 1), a1 + hstepA, voffA);
            PG8_WAIT_L(8); PG8_BAR; PG8_WAIT_L(0); PG8_MMA(0, 0, At, B0); PG8_BAR; PG8_SCHED;
            PG8_LDB(B1, 0, 1); PG8_STAGE(PG8_SB(0, 0), b2, voffB);
            PG8_BAR; PG8_WAIT_L(0); PG8_MMA(0, 1, At, B1); PG8_BAR;
            PG8_LDA(At, 0, 1); PG8_STAGE(PG8_SA(0, 0), a2, voffA);
            PG8_BAR; PG8_WAIT_L(0); PG8_MMA(1, 0, At, B0); PG8_BAR; PG8_SCHED;
            PG8_STAGE(PG8_SB(0, 1), b2 + hstepB, voffB);
            PG8_WAIT_V(6); PG8_BAR; PG8_MMA(1, 1, At, B1); PG8_BAR;
            PG8_LDB(B0, 1, 0); PG8_SCHED; PG8_LDA(At, 1, 0); PG8_STAGE(PG8_SA(0, 1), a2 + hstepA, voffA);
            PG8_WAIT_L(8); PG8_BAR; PG8_WAIT_L(0); PG8_MMA(0, 0, At, B0); PG8_BAR; PG8_SCHED;
            PG8_LDB(B1, 1, 1); PG8_STAGE(PG8_SB(1, 0), b3, voffB);
            PG8_BAR; PG8_WAIT_L(0); PG8_MMA(0, 1, At, B1); PG8_BAR;
            PG8_LDA(At, 1, 1); PG8_STAGE(PG8_SA(1, 0), a3, voffA);
            PG8_BAR; PG8_WAIT_L(0); PG8_MMA(1, 0, At, B0); PG8_BAR; PG8_SCHED;
            PG8_STAGE(PG8_SB(1, 1), b3 + hstepB, voffB);
            PG8_WAIT_V(6); PG8_BAR; PG8_MMA(1, 1, At, B1); PG8_BAR;
            }
        }
        if constexpr (ALIGN_EPI) { if (wr == 0) PG8_BAR; }
        { Unit eu = cur; eu.pn += (cur.pn < g.rlo) ? g.ra0 : g.ra1; int le = lane; asm volatile("" : "+v"(le));
          E(acc, eu, wr, wc, le & 15, le >> 4); } S.done(cur);
        if (!has_next) break;
#pragma unroll
        for (int a = 0; a < 2; ++a)
#pragma unroll
            for (int b = 0; b < 2; ++b)
#pragma unroll
                for (int m = 0; m < 4; ++m)
#pragma unroll
                    for (int n = 0; n < 2; ++n) acc[a][b][m][n] = (f32x4){0.f, 0.f, 0.f, 0.f};
        cur = nxt; cA = nA; cB = nB; ++ui;
        if constexpr (ALIGN_EPI) { if (wr == 1) PG8_BAR; }
    }
    PG8_WAIT_V(0);
    if constexpr (!ALIGN_EPI) { if (wr == 0) PG8_BAR; }
    PG8_BAR;
#undef PG8_SA
#undef PG8_SB
#undef PG8_STAGE
#undef PG8_LDA
#undef PG8_LDB
#undef PG8_MMA
#undef PG8_LD8
#undef PG8_WAIT_V
#undef PG8_WAIT_L
#undef PG8_BAR
#undef PG8_SCHED
}
}


namespace att {
constexpr int D = 128, NW = 8, QBLK = 32, KVBLK = 64;
constexpr float SCALE = 0.088388347648318440f;
constexpr float THR = 8.f;
constexpr float NEG_BIG = -1.2676506002282294e30f;
constexpr size_t SHM_V = KVBLK * D * 2, SHM_K = KVBLK * D * 2, SHM_Q = 2 * SHM_V + 2 * SHM_K + NW * 64 * 4  , SHM_ATTN = SHM_Q + NW * 8192;
using bf16x8 = __attribute__((ext_vector_type(8))) short;
using s16x4  = __attribute__((ext_vector_type(4))) short;
using f32x16 = __attribute__((ext_vector_type(16))) float;
using u32x4  = __attribute__((ext_vector_type(4))) unsigned;
#define KSWZ(row, colB) ((row) * 256 + ((colB) ^ (((row) & 7) << 4)))
#define SBAR() __builtin_amdgcn_sched_barrier(0)
__device__ __forceinline__ int crow(int r, int hi) { return (r & 3) + 8 * (r >> 2) + 4 * hi; }
__device__ __forceinline__ unsigned cvtpk(float lo, float hi) { unsigned r; asm volatile("v_cvt_pk_bf16_f32 %0, %1, %2" : "=v"(r) : "v"(lo), "v"(hi)); return r; }
__device__ __forceinline__ void partialSM(f32x16& p0, f32x16& p1, float& m_reg, float& mn, float& alpha) {
  constexpr float C = SCALE * 1.4426950408889634f;
  float pmax = p0[0]; for (int r = 1; r < 16; ++r) pmax = fmaxf(pmax, p0[r]); for (int r = 0; r < 16; ++r) pmax = fmaxf(pmax, p1[r]);
  { auto rr = __builtin_amdgcn_permlane32_swap(__float_as_uint(pmax), __float_as_uint(pmax), false, false);
    pmax = fmaxf(__uint_as_float(rr[0]), __uint_as_float(rr[1])); }
  if (__builtin_expect(__all(pmax - m_reg <= THR / SCALE), 1)) { mn = m_reg; alpha = 1.f; }
  else { mn = fmaxf(m_reg, pmax); alpha = __builtin_amdgcn_exp2f((m_reg - mn) * C); m_reg = mn; }
  float mnC = -mn * C;
  for (int r = 0; r < 16; ++r) p0[r] = fmaf(p0[r], C, mnC); for (int r = 0; r < 16; ++r) p1[r] = fmaf(p1[r], C, mnC);
  for (int r = 0; r < 16; ++r) p0[r] = __builtin_amdgcn_exp2f(p0[r]);
}
__device__ __forceinline__ void bandmask(f32x16& p0, f32x16& p1, int kt0, int qi, int hi) {
#pragma unroll
  for (int r = 0; r < 16; ++r) { const int d0 = kt0 + crow(r, hi) - qi, d1 = d0 + 32;
    p0[r] = (d0 > 64 || d0 < -64) ? NEG_BIG : p0[r]; p1[r] = (d1 > 64 || d1 < -64) ? NEG_BIG : p1[r]; }
}
__device__ __forceinline__ void finishSM(f32x16& p0, f32x16& p1, float alpha, float& l_reg, bf16x8& pa0, bf16x8& pa1, bf16x8& pa2, bf16x8& pa3) {
  for (int r = 0; r < 16; ++r) p1[r] = __builtin_amdgcn_exp2f(p1[r]);
  float ps = 0; for (int r = 0; r < 16; ++r) ps += p0[r]; for (int r = 0; r < 16; ++r) ps += p1[r];
  { auto rr = __builtin_amdgcn_permlane32_swap(__float_as_uint(ps), __float_as_uint(ps), false, false);
    ps = __uint_as_float(rr[0]) + __uint_as_float(rr[1]); }
  l_reg = l_reg * alpha + ps;
#define PK4(P, BASE, OUT) do { unsigned a0 = cvtpk(P[BASE + 0], P[BASE + 1]), a1 = cvtpk(P[BASE + 2], P[BASE + 3]);   \
    unsigned b0 = cvtpk(P[BASE + 4], P[BASE + 5]), b1 = cvtpk(P[BASE + 6], P[BASE + 7]);                              \
    auto r0 = __builtin_amdgcn_permlane32_swap(a0, b0, false, false); auto r1 = __builtin_amdgcn_permlane32_swap(a1, b1, false, false); \
    u32x4 w = {r0[0], r1[0], r0[1], r1[1]}; OUT = *reinterpret_cast<bf16x8*>(&w); } while (0)
  PK4(p0, 0, pa0); PK4(p0, 8, pa1); PK4(p1, 0, pa2); PK4(p1, 8, pa3);
#undef PK4
}
template <bool QREG>
__device__ __forceinline__ void qkt(f32x16& p0, f32x16& p1, const bf16* Ks, const char* qs, const bf16x8* qv, int r32, int hi) {
  p0 = f32x16{}; p1 = f32x16{};
#pragma unroll
  for (int d0 = 0; d0 < 8; ++d0) { int cb = (d0 * 16 + hi * 8) * 2;
    bf16x8 b0 = *reinterpret_cast<const bf16x8*>((const char*)Ks + KSWZ(r32, cb));
    bf16x8 b1 = *reinterpret_cast<const bf16x8*>((const char*)Ks + KSWZ(32 + r32, cb));
    bf16x8 q; if (QREG) q = qv[d0]; else q = *reinterpret_cast<const bf16x8*>(qs + d0 * 1024);
    p0 = __builtin_amdgcn_mfma_f32_32x32x16_bf16(b0, q, p0, 0, 0, 0);
    p1 = __builtin_amdgcn_mfma_f32_32x32x16_bf16(b1, q, p1, 0, 0, 0); }
}
__device__ __forceinline__ int v_st(int k, int c) { const int kk = (k & ~0xC) | ((k & 4) << 1) | ((k & 8) >> 1); return ((kk >> 3) * 4 + (c >> 5)) * 512 + ((kk & 7) * 32 + (c & 31)) * 2; }
__device__ __forceinline__ int v_rd_base(int lane) { return ((lane & 3) << 3) | (((lane >> 2) & 3) << 6) | (((lane >> 4) & 1) << 5) | (((lane >> 5) & 1) << 8); }
constexpr int v_rd_off(int d0, int ks, int half) { return d0 * 512 + ks * 4096 + half * 2048; }
template <int OFF> __device__ __forceinline__ s16x4 tr_read(int vb) {
  s16x4 r; asm volatile("ds_read_b64_tr_b16 %0, %1 offset:%2" : "=&v"(r) : "v"(vb), "i"(OFF) : "memory"); return r;
}
template <int D0> __device__ __forceinline__ void pv_one(f32x16& od, int vb, bf16x8 pa0, bf16x8 pa1, bf16x8 pa2, bf16x8 pa3) {
  const s16x4 l0 = tr_read<v_rd_off(D0, 0, 0)>(vb), h0 = tr_read<v_rd_off(D0, 0, 1)>(vb), l1 = tr_read<v_rd_off(D0, 1, 0)>(vb), h1 = tr_read<v_rd_off(D0, 1, 1)>(vb);
  const s16x4 l2 = tr_read<v_rd_off(D0, 2, 0)>(vb), h2 = tr_read<v_rd_off(D0, 2, 1)>(vb), l3 = tr_read<v_rd_off(D0, 3, 0)>(vb), h3 = tr_read<v_rd_off(D0, 3, 1)>(vb);
  asm volatile("s_waitcnt lgkmcnt(0)" ::: "memory"); SBAR();
#define PK(L, H) (bf16x8){L[0], L[1], L[2], L[3], H[0], H[1], H[2], H[3]}
  od = __builtin_amdgcn_mfma_f32_32x32x16_bf16(pa0, PK(l0, h0), od, 0, 0, 0);
  od = __builtin_amdgcn_mfma_f32_32x32x16_bf16(pa1, PK(l1, h1), od, 0, 0, 0);
  od = __builtin_amdgcn_mfma_f32_32x32x16_bf16(pa2, PK(l2, h2), od, 0, 0, 0);
  od = __builtin_amdgcn_mfma_f32_32x32x16_bf16(pa3, PK(l3, h3), od, 0, 0, 0);
#undef PK
}
__device__ __forceinline__ void pv_d0(f32x16* o, int vb, bf16x8 pa0, bf16x8 pa1, bf16x8 pa2, bf16x8 pa3) {
  pv_one<0>(o[0], vb, pa0, pa1, pa2, pa3); pv_one<1>(o[1], vb, pa0, pa1, pa2, pa3); pv_one<2>(o[2], vb, pa0, pa1, pa2, pa3); pv_one<3>(o[3], vb, pa0, pa1, pa2, pa3);
}
template <bool BAND, bool QREG>
__device__ __forceinline__ void body(const bf16* __restrict__ Qb, long ldq, const bf16* __restrict__ Kh, const bf16* __restrict__ Vh, long ldk, int NT, int qrel,
                                     char* lds, f32x16 (&o)[4], float& m_reg, float& l_reg) {
  const int tid = threadIdx.x, wid = tid >> 6, lane = tid & 63, r32 = lane & 31, hi = lane >> 5;
  bf16* V_lds = (bf16*)lds; bf16* K_lds = (bf16*)(lds + 2 * SHM_V);
  float* ws = (float*)(lds + 2 * SHM_V + 2 * SHM_K) + wid * 64; float* al_l = ws + 32;
  m_reg = NEG_BIG; l_reg = 0;
#pragma unroll
  for (int d = 0; d < 4; ++d) o[d] = f32x16{};
  char* qr = lds + SHM_Q + wid * 8192 + lane * 16;
  bf16x8 qv[8];
  { int tq = tid; asm volatile("" : "+v"(tq));
    const unsigned qo = (unsigned)((((tq >> 6) << 5) | (tq & 31)) * (int)ldq + ((tq >> 5) & 1) * 8) * 2u;
#pragma unroll
    for (int d0 = 0; d0 < 8; ++d0) { const bf16x8 t = *reinterpret_cast<const bf16x8*>((const char*)Qb + qo + d0 * 32); if (QREG) qv[d0] = t; else *reinterpret_cast<bf16x8*>(qr + d0 * 1024) = t; } }
  const int qi = qrel + wid * QBLK + r32;
  const int sr = tid >> 4, sc = (tid & 15) * 8, vst0 = v_st(sr, sc), vst1 = v_st(32 + sr, sc);
  const int vb0 = (int)(uintptr_t)V_lds + v_rd_base(lane);
  const unsigned ko0 = (unsigned)(sr * (int)ldk + sc) * 2u, ko1 = ko0 + (unsigned)(64 * (int)ldk);
  struct { bf16x8 vs0, vs1, ks0, ks1; } sr_[2];
#define SLOAD(i, k0) do { const long _t = (long)(k0) * ldk * 2; const char* _kt = (const char*)Kh + _t; const char* _vt = (const char*)Vh + _t; \
    sr_[i].vs0 = *reinterpret_cast<const bf16x8*>(_vt + ko0); sr_[i].vs1 = *reinterpret_cast<const bf16x8*>(_vt + ko1); \
    sr_[i].ks0 = *reinterpret_cast<const bf16x8*>(_kt + ko0); sr_[i].ks1 = *reinterpret_cast<const bf16x8*>(_kt + ko1); } while (0)
#define SWRITE(b, i) do { *(bf16x8*)((char*)V_lds + (b) * SHM_V + vst0) = sr_[i].vs0;          \
    *(bf16x8*)((char*)V_lds + (b) * SHM_V + vst1) = sr_[i].vs1; int kc = sc * 2;               \
    *(bf16x8*)((char*)K_lds + (b) * SHM_K + KSWZ(sr, kc)) = sr_[i].ks0;                       \
    *(bf16x8*)((char*)K_lds + (b) * SHM_K + KSWZ(32 + sr, kc)) = sr_[i].ks1; } while (0)
#define SWAIT() asm volatile("s_waitcnt vmcnt(4)" ::: "memory")
#define RESC(a) do { if (__any((a) < 1.f)) { if (hi == 0) al_l[r32] = (a); asm volatile("s_waitcnt lgkmcnt(0)" ::: "memory"); \
    for (int d = 0; d < 4; ++d) for (int r = 0; r < 16; ++r) o[d][r] *= al_l[crow(r, hi)]; } } while (0)
  f32x16 pA0, pA1, pB0, pB1; float mnA, mnB, alA, alB; bf16x8 pa0, pa1, pa2, pa3;
  constexpr int SE = 0, SO = 1;
  SLOAD(SE, 0); asm volatile("s_waitcnt vmcnt(0)" ::: "memory"); SWRITE(0, SE); __syncthreads();
  qkt<QREG>(pA0, pA1, K_lds, qr, qv, r32, hi); if (BAND) bandmask(pA0, pA1, 0, qi, hi); partialSM(pA0, pA1, m_reg, mnA, alA);
  SLOAD(SO, KVBLK); if (2 < NT) SLOAD(SE, 2 * KVBLK);
  SWAIT(); SWRITE(1, SO); __syncthreads();
  for (int j = 1; j + 1 < NT; j += 2) {
    SBAR(); qkt<QREG>(pB0, pB1, (bf16*)((char*)K_lds + SHM_K), qr, qv, r32, hi); if (BAND) bandmask(pB0, pB1, 64 * j, qi, hi);
    finishSM(pA0, pA1, alA, l_reg, pa0, pa1, pa2, pa3); SBAR();
    SLOAD(SO, (j + 2) * KVBLK); SBAR();
    pv_d0(o, vb0, pa0, pa1, pa2, pa3); partialSM(pB0, pB1, m_reg, mnB, alB);
    __syncthreads(); SWAIT(); SWRITE(0, SE);
    RESC(alB); __syncthreads();
    SBAR(); qkt<QREG>(pA0, pA1, K_lds, qr, qv, r32, hi); if (BAND) bandmask(pA0, pA1, 64 * (j + 1), qi, hi);
    finishSM(pB0, pB1, alB, l_reg, pa0, pa1, pa2, pa3); SBAR();
    if (j + 3 < NT) SLOAD(SE, (j + 3) * KVBLK); SBAR();
    pv_d0(o, vb0 + (int)SHM_V, pa0, pa1, pa2, pa3); partialSM(pA0, pA1, m_reg, mnA, alA);
    __syncthreads(); SWAIT(); SWRITE(1, SO);
    RESC(alA); __syncthreads();
  }
  SBAR(); qkt<QREG>(pB0, pB1, (bf16*)((char*)K_lds + SHM_K), qr, qv, r32, hi); if (BAND) bandmask(pB0, pB1, 64 * (NT - 1), qi, hi);
  finishSM(pA0, pA1, alA, l_reg, pa0, pa1, pa2, pa3); SBAR();
  pv_d0(o, vb0, pa0, pa1, pa2, pa3); partialSM(pB0, pB1, m_reg, mnB, alB);
  __syncthreads(); RESC(alB);
  finishSM(pB0, pB1, alB, l_reg, pa0, pa1, pa2, pa3); SBAR();
  pv_d0(o, vb0 + (int)SHM_V, pa0, pa1, pa2, pa3);
#undef SLOAD
#undef SWRITE
#undef SWAIT
#undef RESC
}

struct VFrag { s16x4 l0, h0, l1, h1, l2, h2, l3, h3; };
template <int D> __device__ __forceinline__ void vf_load(VFrag& f, int vb) {
  constexpr int B = (D >> 2) * 16384 + (D & 3) * 512;
  f.l0 = tr_read<B + 0 * 4096>(vb); f.h0 = tr_read<B + 0 * 4096 + 2048>(vb); f.l1 = tr_read<B + 1 * 4096>(vb); f.h1 = tr_read<B + 1 * 4096 + 2048>(vb);
  f.l2 = tr_read<B + 2 * 4096>(vb); f.h2 = tr_read<B + 2 * 4096 + 2048>(vb); f.l3 = tr_read<B + 3 * 4096>(vb); f.h3 = tr_read<B + 3 * 4096 + 2048>(vb);
}
__device__ __forceinline__ void vf_mma(f32x16& od, const VFrag& f, bf16x8 pa0, bf16x8 pa1, bf16x8 pa2, bf16x8 pa3) {
#define PK(L, H) (bf16x8){L[0], L[1], L[2], L[3], H[0], H[1], H[2], H[3]}
  od = __builtin_amdgcn_mfma_f32_32x32x16_bf16(pa0, PK(f.l0, f.h0), od, 0, 0, 0);
  od = __builtin_amdgcn_mfma_f32_32x32x16_bf16(pa1, PK(f.l1, f.h1), od, 0, 0, 0);
  od = __builtin_amdgcn_mfma_f32_32x32x16_bf16(pa2, PK(f.l2, f.h2), od, 0, 0, 0);
  od = __builtin_amdgcn_mfma_f32_32x32x16_bf16(pa3, PK(f.l3, f.h3), od, 0, 0, 0);
#undef PK
}
__device__ __forceinline__ void pv_wide(f32x16* o, int vb, bf16x8 pa0, bf16x8 pa1, bf16x8 pa2, bf16x8 pa3) {
  VFrag A, B;
#define VW(n) do { asm volatile("s_waitcnt lgkmcnt(" #n ")" ::: "memory"); SBAR(); } while (0)
  vf_load<0>(A, vb);
  vf_load<1>(B, vb); VW(8); vf_mma(o[0], A, pa0, pa1, pa2, pa3); SBAR();
  vf_load<2>(A, vb); VW(8); vf_mma(o[1], B, pa0, pa1, pa2, pa3); SBAR();
  vf_load<3>(B, vb); VW(8); vf_mma(o[2], A, pa0, pa1, pa2, pa3); SBAR();
  vf_load<4>(A, vb); VW(8); vf_mma(o[3], B, pa0, pa1, pa2, pa3); SBAR();
  vf_load<5>(B, vb); VW(8); vf_mma(o[4], A, pa0, pa1, pa2, pa3); SBAR();
  vf_load<6>(A, vb); VW(8); vf_mma(o[5], B, pa0, pa1, pa2, pa3); SBAR();
  vf_load<7>(B, vb); VW(8); vf_mma(o[6], A, pa0, pa1, pa2, pa3); SBAR();
  VW(0); vf_mma(o[7], B, pa0, pa1, pa2, pa3);
#undef VW
}
constexpr int DP_K = 0, DP_V = 32768, DP_P = 98304, DP_X = 131072;
#define DP_BAR() do { asm volatile("s_waitcnt vmcnt(0) lgkmcnt(0)" ::: "memory"); __builtin_amdgcn_s_barrier(); asm volatile("" ::: "memory"); } while (0)
__device__ __forceinline__ void diff_pass(const bf16* __restrict__ Qb, const bf16* __restrict__ Kh, const bf16* __restrict__ Vh, int ld, int NT, char* lds, bf16* Ob, int pfq) {
  int tid = threadIdx.x; asm volatile("" : "+v"(tid));
  const int wid = __builtin_amdgcn_readfirstlane(tid >> 6), lane = tid & 63, r32 = lane & 31, hi = lane >> 5, g = wid & 3;
  const bool prod = wid < 4;
  unsigned koff[4], voff[4];
#pragma unroll
  for (int i = 0; i < 4; ++i) { const int p = g * 4 + i, row = p * 4 + (lane >> 4), cpos = (lane & 15) * 16; koff[i] = (unsigned)(row * ld * 2 + (cpos ^ ((row & 7) << 4))); }
#pragma unroll
  for (int i = 0; i < 4; ++i) { const int p = wid * 4 + i, hf = p >> 4, sub = (p & 15) * 2 + (lane >> 5), kk = (sub >> 2) * 8 + ((lane & 31) >> 2);
    const int k = (kk & ~0xC) | ((kk & 4) << 1) | ((kk & 8) >> 1), col = hf * 128 + (sub & 3) * 32 + (lane & 3) * 8; voff[i] = (unsigned)(k * ld * 2 + col * 2); }
  const long tstep = (long)64 * ld * 2;
  typedef __attribute__((address_space(3))) unsigned lds_u32;
#define DP_DMA_K(t, b) do { if (prod) { const char* _s = (const char*)Kh + (long)(t) * tstep; _Pragma("unroll") for (int _i = 0; _i < 4; ++_i) \
    __builtin_amdgcn_global_load_lds((const unsigned*)(_s + koff[_i]), (lds_u32*)(lds + DP_K + (b) * 16384 + (g * 4 + _i) * 1024), 16, 0, 0); } } while (0)
#define DP_DMA_V(t, b) do { const char* _s = (const char*)Vh + (long)(t) * tstep; _Pragma("unroll") for (int _i = 0; _i < 4; ++_i) \
    __builtin_amdgcn_global_load_lds((const unsigned*)(_s + voff[_i]), (lds_u32*)(lds + DP_V + (b) * 32768 + (wid * 4 + _i) * 1024), 16, 0, 0); } while (0)
  float* xg = (float*)(lds + DP_X) + g * 64;
  char* pg = lds + DP_P + g * 4096 + lane * 16;
  DP_DMA_K(0, 0); DP_DMA_V(0, 0); DP_DMA_K(1, 1);
#define DP_ISSUE(s) do { if ((s) + 2 < NT) DP_DMA_K((s) + 2, (s) & 1); if ((s) + 1 < NT) DP_DMA_V((s) + 1, ((s) + 1) & 1); } while (0)
  const int pl = 12 * pfq + lane; const unsigned pfo = pl < 128 ? (unsigned)((pl >> 1) * ld * 2 + (pl & 1) * 128) : (unsigned)(((pl - 128) >> 2) * ld * 2 + ((pl - 128) & 3) * 128);
  const char* pfb = pl < 128 ? (const char*)Kh : (const char*)Vh;
#define DP_PF(s) do { if (lane < 12) { const int _t = ((s) + 4 < NT) ? (s) + 4 : NT - 1; \
    __builtin_amdgcn_global_load_lds((const unsigned*)(pfb + (long)_t * tstep + pfo), (lds_u32*)(lds + 143360), 4, 0, 0); } } while (0)
#define DP_BAR1() do { asm volatile("s_waitcnt vmcnt(1) lgkmcnt(0)" ::: "memory"); __builtin_amdgcn_s_barrier(); asm volatile("" ::: "memory"); } while (0)
  if (prod) {
    float m_reg = NEG_BIG, l_reg = 0.f; bf16x8 qv[8];
    { const unsigned qo = (unsigned)((g * 32 + r32) * ld + hi * 8) * 2u;
#pragma unroll
      for (int d0 = 0; d0 < 8; ++d0) qv[d0] = *reinterpret_cast<const bf16x8*>((const char*)Qb + qo + d0 * 32); }
    DP_BAR();
#define DP_SCORE(j) do { f32x16 p0, p1; float mn, al; bf16x8 pa0, pa1, pa2, pa3; \
    qkt<true>(p0, p1, (const bf16*)(lds + DP_K + ((j) & 1) * 16384), nullptr, qv, r32, hi); partialSM(p0, p1, m_reg, mn, al); finishSM(p0, p1, al, l_reg, pa0, pa1, pa2, pa3); \
    char* _p = pg + ((j) & 1) * 16384; *reinterpret_cast<bf16x8*>(_p) = pa0; *reinterpret_cast<bf16x8*>(_p + 1024) = pa1; *reinterpret_cast<bf16x8*>(_p + 2048) = pa2; *reinterpret_cast<bf16x8*>(_p + 3072) = pa3; \
    float* _x = xg + ((j) & 1) * 256; const bool _any = __any(al < 1.f); if (hi == 0) _x[r32] = al; if (lane == 0) _x[32] = _any ? 1.f : 0.f; } while (0)
    DP_SCORE(0);
    DP_BAR();
    for (int s = 0; s < NT; ++s) { DP_ISSUE(s); if (s + 1 < NT) DP_SCORE(s + 1); DP_BAR(); }
    if (hi == 0) xg[r32] = l_reg;
    DP_BAR();
  } else {
    f32x16 o[8];
#pragma unroll
    for (int d = 0; d < 8; ++d) o[d] = f32x16{};
    DP_BAR();
    DP_BAR();
    for (int s = 0; s < NT; ++s) {
      DP_ISSUE(s); if (wid == 7) DP_PF(s);
      const float* x = xg + (s & 1) * 256;
      if (__builtin_amdgcn_readfirstlane(__float_as_int(x[32])) != 0) {
#pragma unroll
        for (int r = 0; r < 16; ++r) { const float a = x[crow(r, hi)];
#pragma unroll
          for (int d = 0; d < 8; ++d) o[d][r] *= a; } }
      const char* p = pg + (s & 1) * 16384;
      const bf16x8 pa0 = *reinterpret_cast<const bf16x8*>(p), pa1 = *reinterpret_cast<const bf16x8*>(p + 1024), pa2 = *reinterpret_cast<const bf16x8*>(p + 2048), pa3 = *reinterpret_cast<const bf16x8*>(p + 3072);
      const int vb = (int)(uintptr_t)(lds + DP_V + (s & 1) * 32768) + v_rd_base(lane);
      asm volatile("s_waitcnt lgkmcnt(0)" ::: "memory"); SBAR();
      pv_wide(o, vb, pa0, pa1, pa2, pa3);
      if (wid == 7) DP_BAR1(); else DP_BAR();
    }
    DP_BAR();
    bf16* Ow = Ob + (size_t)(g * 32) * 2048 + r32;
#pragma unroll
    for (int r = 0; r < 16; ++r) { const float il = __builtin_amdgcn_rcpf(xg[crow(r, hi)]); bf16* pr = Ow + (size_t)crow(r, hi) * 2048;
#pragma unroll
      for (int d = 0; d < 8; ++d) pr[d * 32] = (bf16)f2bf(o[d][r] * il); }
  }
  DP_BAR();
#undef DP_ISSUE
#undef DP_PF
#undef DP_BAR1
#undef DP_DMA_K
#undef DP_DMA_V
#undef DP_SCORE
}
__device__ __forceinline__ void row_recip(char* lds, float l_reg, float (&rli)[16]) {
  const int tid = threadIdx.x, wid = tid >> 6, lane = tid & 63, r32 = lane & 31, hi = lane >> 5;
  float* li_l = (float*)(lds + 2 * SHM_V + 2 * SHM_K) + wid * 64;
  if (hi == 0) li_l[r32] = l_reg; asm volatile("s_waitcnt lgkmcnt(0)" ::: "memory");
#pragma unroll
  for (int r = 0; r < 16; ++r) rli[r] = __builtin_amdgcn_rcpf(li_l[crow(r, hi)]);
  asm volatile("s_waitcnt lgkmcnt(0)" ::: "memory");
}
#undef KSWZ
}

struct Args {
    const float* x; const float* mem; const int* pos;
    const float *g_mix_pre, *w_in, *w_a, *w_b, *w_mix, *g_mix_post, *lq1, *lk1, *lq2, *lk2, *subln;
    const float *g_mem_pre, *g_mem_kv, *w_mq, *w_mkv, *w_mo, *g_mem_post, *g_mlp_pre, *w_up, *w_dn, *g_mlp_post;
    float* out; unsigned char* ws; int ph_lo, ph_hi, li, pad;
};
struct Frame {
    LAS unsigned char* lds; volatile LAS unsigned* MISC; gu32* ctl;
    int tid, lane, wave, vcu, G;
};
__device__ __forceinline__ float wave_sum(float v) {
#pragma unroll
    for (int o = 1; o < 64; o <<= 1) v += __shfl_xor(v, o);
    return v;
}
__device__ __forceinline__ float wave_max(float v) {
#pragma unroll
    for (int o = 1; o < 64; o <<= 1) v = fmaxf(v, __shfl_xor(v, o));
    return v;
}
__device__ __forceinline__ void p0_transpose_cols(const float* W, int K, int N, int scol, bf16* WT, int drow, LAS float* scr, int kb, int lane);
__device__ __forceinline__ void p0_transpose_item(const float* W, int K, int N, bf16* WT, LAS float* scr, int item, int lane) {
    const int nblk = N / 32, kb = item / nblk, nb = item % nblk, k0 = 64 * kb, n0 = 32 * nb;
    const int lr = lane >> 3, lc = (lane & 7) * 4;
    const GAS float* src = (const GAS float*)W + (size_t)(k0 + lr) * N + n0 + lc;
    f32x4 v[8];
#pragma unroll
    for (int i = 0; i < 8; ++i) v[i] = __builtin_nontemporal_load((const GAS f32x4*)(src + (size_t)(8 * i) * N));
#pragma unroll
    for (int i = 0; i < 8; ++i) { LAS float* d = scr + (8 * i + lr) * 33 + lc; d[0] = v[i].x; d[1] = v[i].y; d[2] = v[i].z; d[3] = v[i].w; }
    LDS_WAIT(); asm volatile("" ::: "memory");
    const int c = lane & 7;
#pragma unroll
    for (int j = 0; j < 4; ++j) { const int n = (lane >> 3) + 8 * j; const LAS float* s = scr + (8 * c) * 33 + n;
        v4u o; o.x = pk2(s[0 * 33], s[1 * 33]); o.y = pk2(s[2 * 33], s[3 * 33]); o.z = pk2(s[4 * 33], s[5 * 33]); o.w = pk2(s[6 * 33], s[7 * 33]);
        __builtin_nontemporal_store(o, (GAS v4u*)(WT + (size_t)(n0 + n) * K + k0 + 8 * c)); }
    LDS_WAIT(); asm volatile("" ::: "memory");
}
__device__ __forceinline__ void p0_transpose_cols(const float* W, int K, int N, int scol, bf16* WT, int drow, LAS float* scr, int kb, int lane) {
    const int k0 = 64 * kb;
    const int lr = lane >> 3, lc = (lane & 7) * 4;
    const GAS float* src = (const GAS float*)W + (size_t)(k0 + lr) * N + scol + lc;
    f32x4 v[8];
#pragma unroll
    for (int i = 0; i < 8; ++i) v[i] = __builtin_nontemporal_load((const GAS f32x4*)(src + (size_t)(8 * i) * N));
#pragma unroll
    for (int i = 0; i < 8; ++i) { LAS float* d = scr + (8 * i + lr) * 33 + lc; d[0] = v[i].x; d[1] = v[i].y; d[2] = v[i].z; d[3] = v[i].w; }
    LDS_WAIT(); asm volatile("" ::: "memory");
    const int c = lane & 7;
#pragma unroll
    for (int j = 0; j < 4; ++j) { const int n = (lane >> 3) + 8 * j; const LAS float* s = scr + (8 * c) * 33 + n;
        v4u o; o.x = pk2(s[0 * 33], s[1 * 33]); o.y = pk2(s[2 * 33], s[3 * 33]); o.z = pk2(s[4 * 33], s[5 * 33]); o.w = pk2(s[6 * 33], s[7 * 33]);
        __builtin_nontemporal_store(o, (GAS v4u*)(WT + (size_t)(drow + n) * K + k0 + 8 * c)); }
    LDS_WAIT(); asm volatile("" ::: "memory");
}
__device__ __forceinline__ unsigned pk4_fp8(float a, float b, float c, float d) { int w = 0; w = __builtin_amdgcn_cvt_pk_fp8_f32(a, b, w, false); w = __builtin_amdgcn_cvt_pk_fp8_f32(c, d, w, true); return (unsigned)w; }
__device__ __forceinline__ void p0_transpose_item_fp8(const float* W, int K, int N, int ncol0, unsigned char* W8, int row0, float scale, LAS float* scr, int kb, int nb, int lane) {
    const int k0 = 64 * kb, n0 = 32 * nb;
    const int lr = lane >> 3, lc = (lane & 7) * 4;
    const GAS float* src = (const GAS float*)W + (size_t)(k0 + lr) * N + ncol0 + n0 + lc;
    f32x4 v[8];
#pragma unroll
    for (int i = 0; i < 8; ++i) v[i] = __builtin_nontemporal_load((const GAS f32x4*)(src + (size_t)(8 * i) * N));
#pragma unroll
    for (int i = 0; i < 8; ++i) { LAS float* d = scr + (8 * i + lr) * 33 + lc; d[0] = v[i].x; d[1] = v[i].y; d[2] = v[i].z; d[3] = v[i].w; }
    LDS_WAIT(); asm volatile("" ::: "memory");
    const int c = lane & 7;
#pragma unroll
    for (int j = 0; j < 4; ++j) { const int n = (lane >> 3) + 8 * j; const LAS float* s = scr + (8 * c) * 33 + n;
        v2u o; o.x = pk4_fp8(s[0 * 33] * scale, s[1 * 33] * scale, s[2 * 33] * scale, s[3 * 33] * scale); o.y = pk4_fp8(s[4 * 33] * scale, s[5 * 33] * scale, s[6 * 33] * scale, s[7 * 33] * scale);
        __builtin_nontemporal_store(o, (GAS v2u*)(W8 + (size_t)(row0 + n0 + n) * K + k0 + 8 * c)); }
    LDS_WAIT(); asm volatile("" ::: "memory");
}
__device__ __forceinline__ void rms_row_to_bf16(const float* xrow, const float* g, bf16* orow, int lane, unsigned char* o8row = nullptr) {
    const GAS f32x4* xr = (const GAS f32x4*)xrow + lane; const GAS f32x4* gr = (const GAS f32x4*)g + lane;
    f32x4 v[16]; float s = 0.f;
#pragma unroll
    for (int j = 0; j < 16; ++j) { v[j] = __builtin_nontemporal_load(xr + 64 * j); s += (v[j].x * v[j].x + v[j].y * v[j].y) + (v[j].z * v[j].z + v[j].w * v[j].w); }
    const float rstd = 1.f / sqrtf(wave_sum(s) * (1.f / DM) + NORM_EPS);
    GAS v2u* o8 = (GAS v2u*)orow + lane;
#pragma unroll
    for (int j = 0; j < 16; ++j) { const f32x4 gg = gr[64 * j]; const f32x4 y = {v[j].x * rstd * gg.x, v[j].y * rstd * gg.y, v[j].z * rstd * gg.z, v[j].w * rstd * gg.w};
        v2u o; o.x = pk2(y.x, y.y); o.y = pk2(y.z, y.w); o8[64 * j] = o;
        if (o8row) ((GAS unsigned*)o8row + lane)[64 * j] = pk4_fp8(y.x, y.y, y.z, y.w); }
}
__device__ __forceinline__ void rms_row_to_i8(const float* xrow, const float* g, unsigned char* qrow, float* scale, int lane, bf16* hrow = nullptr) {
    const GAS f32x4* xr = (const GAS f32x4*)xrow + lane; const GAS f32x4* gr = (const GAS f32x4*)g + lane;
    f32x4 v[16]; float s = 0.f;
#pragma unroll
    for (int j = 0; j < 16; ++j) { v[j] = __builtin_nontemporal_load(xr + 64 * j); s += (v[j].x * v[j].x + v[j].y * v[j].y) + (v[j].z * v[j].z + v[j].w * v[j].w); }
    const float rstd = 1.f / sqrtf(wave_sum(s) * (1.f / DM) + NORM_EPS); float am = 0.f;
#pragma unroll
    for (int j = 0; j < 16; ++j) { const f32x4 gg = gr[64 * j]; v[j].x *= rstd * gg.x; v[j].y *= rstd * gg.y; v[j].z *= rstd * gg.z; v[j].w *= rstd * gg.w;
        am = fmaxf(fmaxf(am, fmaxf(fabsf(v[j].x), fabsf(v[j].y))), fmaxf(fabsf(v[j].z), fabsf(v[j].w))); }
    am = wave_max(am); const float inv = am > 0.f ? 127.f / am : 0.f;
    if (lane == 0) *scale = am * (1.f / 127.f);
    GAS unsigned* o4 = (GAS unsigned*)qrow + lane;
#pragma unroll
    for (int j = 0; j < 16; ++j) { const int a = (int)__builtin_rintf(v[j].x * inv), b = (int)__builtin_rintf(v[j].y * inv), c = (int)__builtin_rintf(v[j].z * inv), d = (int)__builtin_rintf(v[j].w * inv);
        o4[64 * j] = (unsigned)(a & 255) | ((unsigned)(b & 255) << 8) | ((unsigned)(c & 255) << 16) | ((unsigned)d << 24);
        if (hrow) { v2u o; o.x = pk2(v[j].x, v[j].y); o.y = pk2(v[j].z, v[j].w); ((GAS v2u*)hrow + lane)[64 * j] = o; } }
}
__device__ __forceinline__ void unpack4(const v2u w, f32x4& v) { v.x = __builtin_bit_cast(float, w.x << 16); v.y = __builtin_bit_cast(float, w.x & 0xffff0000u); v.z = __builtin_bit_cast(float, w.y << 16); v.w = __builtin_bit_cast(float, w.y & 0xffff0000u); }
template <bool BB, bool OB>
__device__ __forceinline__ void norm_res_row(const bf16* yrow, const float* g1, const void* brow, void* orow, const float* g2, bf16* hrow, int lane, unsigned char* q8row = nullptr, float* qscale = nullptr) {
    const GAS v2u* yr = (const GAS v2u*)yrow + lane; const GAS f32x4* gr = (const GAS f32x4*)g1 + lane;
    f32x4 v[16]; float s = 0.f;
    v2u yw[16], bw[BB ? 16 : 1]; f32x4 bf[BB ? 1 : 16];
#pragma unroll
    for (int j = 0; j < 16; ++j) yw[j] = __builtin_nontemporal_load(yr + 64 * j);
#pragma unroll
    for (int j = 0; j < 16; ++j) { if (BB) bw[j] = __builtin_nontemporal_load((const GAS v2u*)brow + lane + 64 * j); else bf[j] = __builtin_nontemporal_load((const GAS f32x4*)brow + lane + 64 * j); }
#pragma unroll
    for (int j = 0; j < 16; ++j) { unpack4(yw[j], v[j]); s += (v[j].x * v[j].x + v[j].y * v[j].y) + (v[j].z * v[j].z + v[j].w * v[j].w); }
    const float rstd = 1.f / sqrtf(wave_sum(s) * (1.f / DM) + NORM_EPS);
    float s2 = 0.f;
#pragma unroll
    for (int j = 0; j < 16; ++j) { const f32x4 gg = gr[64 * j]; f32x4 bb;
        if (BB) unpack4(bw[j], bb); else bb = bf[j];
        v[j] = bb + v[j] * rstd * gg;
        if (OB) { v2u o; o.x = pk2(v[j].x, v[j].y); o.y = pk2(v[j].z, v[j].w); ((GAS v2u*)orow + lane)[64 * j] = o; unpack4(o, v[j]); }
        else __builtin_nontemporal_store(v[j], (GAS f32x4*)orow + lane + 64 * j);
        s2 += (v[j].x * v[j].x + v[j].y * v[j].y) + (v[j].z * v[j].z + v[j].w * v[j].w); }
    if (g2) {
        const float rstd2 = 1.f / sqrtf(wave_sum(s2) * (1.f / DM) + NORM_EPS);
        const GAS f32x4* g2r = (const GAS f32x4*)g2 + lane;
        if (q8row) {
            float am = 0.f;
#pragma unroll
            for (int j = 0; j < 16; ++j) { const f32x4 gg = g2r[64 * j]; v[j].x *= rstd2 * gg.x; v[j].y *= rstd2 * gg.y; v[j].z *= rstd2 * gg.z; v[j].w *= rstd2 * gg.w;
                am = fmaxf(fmaxf(am, fmaxf(fabsf(v[j].x), fabsf(v[j].y))), fmaxf(fabsf(v[j].z), fabsf(v[j].w))); }
            am = wave_max(am); const float inv = am > 0.f ? 127.f / am : 0.f;
            if (lane == 0) *qscale = am * (1.f / 127.f);
            GAS unsigned* o4 = (GAS unsigned*)q8row + lane;
#pragma unroll
            for (int j = 0; j < 16; ++j) { const int a = (int)__builtin_rintf(v[j].x * inv), b = (int)__builtin_rintf(v[j].y * inv), c = (int)__builtin_rintf(v[j].z * inv), d = (int)__builtin_rintf(v[j].w * inv);
                o4[64 * j] = (unsigned)(a & 255) | ((unsigned)(b & 255) << 8) | ((unsigned)(c & 255) << 16) | ((unsigned)d << 24); }
        } else {
            GAS v2u* o8 = (GAS v2u*)hrow + lane;
#pragma unroll
            for (int j = 0; j < 16; ++j) { const f32x4 gg = g2r[64 * j]; v2u o; o.x = pk2(v[j].x * rstd2 * gg.x, v[j].y * rstd2 * gg.y); o.y = pk2(v[j].z * rstd2 * gg.z, v[j].w * rstd2 * gg.w); o8[64 * j] = o; }
        }
    }
}
__device__ __forceinline__ void quant_row_wdn(const bf16* xrow, unsigned char* qrow, float* scale, int* rsum, int lane) {
    float am = 0.f;
    for (int sgm = 0; sgm < D_FF / DM; ++sgm) { const GAS v4u* xr = (const GAS v4u*)(xrow + sgm * DM) + lane;
#pragma unroll
        for (int i = 0; i < 8; ++i) { const v4u w = xr[64 * i];
#pragma unroll
            for (int j = 0; j < 4; ++j) am = fmaxf(am, fmaxf(fabsf(__builtin_bit_cast(float, w[j] << 16)), fabsf(__builtin_bit_cast(float, w[j] & 0xffff0000u)))); } }
    am = wave_max(am); const float inv = am > 0.f ? 127.f / am : 0.f; int sum = 0;
    for (int sgm = 0; sgm < D_FF / DM; ++sgm) { const GAS v4u* xr = (const GAS v4u*)(xrow + sgm * DM) + lane; GAS v2u* o = (GAS v2u*)(qrow + sgm * DM) + lane;
#pragma unroll
        for (int i = 0; i < 8; ++i) { const v4u w = xr[64 * i]; unsigned q[8];
#pragma unroll
            for (int j = 0; j < 4; ++j) { const int a = (int)__builtin_rintf(__builtin_bit_cast(float, w[j] << 16) * inv), b = (int)__builtin_rintf(__builtin_bit_cast(float, w[j] & 0xffff0000u) * inv); sum += a + b; q[2 * j] = (unsigned)a & 255u; q[2 * j + 1] = (unsigned)b & 255u; }
            v2u ov; ov.x = q[0] | (q[1] << 8) | (q[2] << 16) | (q[3] << 24); ov.y = q[4] | (q[5] << 8) | (q[6] << 16) | (q[7] << 24); o[64 * i] = ov; } }
#pragma unroll
    for (int o = 1; o < 64; o <<= 1) sum += __shfl_xor(sum, o);
    if (lane == 0) { *scale = am * (1.f / 127.f); *rsum = sum; }
}
template <int NCH = 8>
__device__ __forceinline__ void quant_row_bf16_i8(const bf16* xrow, unsigned char* qrow, float* scale, int lane) {
    const GAS v4u* xr = (const GAS v4u*)xrow + lane; v4u w[NCH]; float am = 0.f;
#pragma unroll
    for (int i = 0; i < NCH; ++i) { w[i] = xr[64 * i];
#pragma unroll
        for (int j = 0; j < 4; ++j) am = fmaxf(am, fmaxf(fabsf(__builtin_bit_cast(float, w[i][j] << 16)), fabsf(__builtin_bit_cast(float, w[i][j] & 0xffff0000u)))); }
    am = wave_max(am); const float inv = am > 0.f ? 127.f / am : 0.f;
    if (lane == 0) *scale = am * (1.f / 127.f);
    GAS v2u* o = (GAS v2u*)qrow + lane;
#pragma unroll
    for (int i = 0; i < NCH; ++i) { unsigned q[8];
#pragma unroll
        for (int j = 0; j < 4; ++j) { q[2 * j] = (unsigned)((int)__builtin_rintf(__builtin_bit_cast(float, w[i][j] << 16) * inv)) & 255u; q[2 * j + 1] = (unsigned)((int)__builtin_rintf(__builtin_bit_cast(float, w[i][j] & 0xffff0000u) * inv)) & 255u; }
        v2u ov; ov.x = q[0] | (q[1] << 8) | (q[2] << 16) | (q[3] << 24); ov.y = q[4] | (q[5] << 8) | (q[6] << 16) | (q[7] << 24); o[64 * i] = ov; }
}

template <bool SPLITK>
__device__ __forceinline__ void colblock32_i8(const float* W, int N, int c0, int k0, unsigned char* qrows, int qpitch, float* scales, LAS unsigned char* img, int tid_,
                                              unsigned* gmax = nullptr, unsigned* gcnt = nullptr, int* gsum = nullptr) {
    int tid = tid_; asm volatile("" : "+v"(tid));
    const int w = tid >> 6, l = tid & 63, g = l & 7, s = w * 8 + (l >> 3);
    LAS unsigned* red = (LAS unsigned*)(img + 131072);
    if (tid < 64) red[tid] = 0u;
    const unsigned voff = (unsigned)((4 * s) * N + 4 * g) * 4u;
    const size_t rowB = (size_t)N * 4;
    const char* pb = (const char*)(W + (size_t)k0 * N + c0);
    unsigned d[16][8]; float mx[4] = {0.f, 0.f, 0.f, 0.f};
    f32x4 v[3][4];
#define CB_LOAD(b) do { _Pragma("unroll") for (int i = 0; i < 4; ++i) v[(b) % 3][i] = __builtin_nontemporal_load((const GAS f32x4*)(pb + (size_t)i * rowB + voff)); pb += 256 * rowB; } while (0)
    CB_LOAD(0); CB_LOAD(1);
#pragma unroll
    for (int j = 0; j < 16; ++j) {
        if (j + 2 < 16) CB_LOAD(j + 2);
#pragma unroll
        for (int q = 0; q < 4; ++q) { const float a0 = v[j % 3][0][q], a1 = v[j % 3][1][q], a2 = v[j % 3][2][q], a3 = v[j % 3][3][q];
            d[j][2 * q] = att::cvtpk(a0, a1); d[j][2 * q + 1] = att::cvtpk(a2, a3);
            mx[q] = fmaxf(fmaxf(mx[q], fmaxf(fabsf(a0), fabsf(a1))), fmaxf(fabsf(a2), fabsf(a3))); }
        __builtin_amdgcn_sched_barrier(0);
    }
#undef CB_LOAD
    __syncthreads();
#pragma unroll
    for (int q = 0; q < 4; ++q) __hip_atomic_fetch_max(red + 4 * g + q, __builtin_bit_cast(unsigned, mx[q]), __ATOMIC_RELAXED, __HIP_MEMORY_SCOPE_WORKGROUP);
    __syncthreads();
    if constexpr (SPLITK) {
        if (tid < 64) {
            if (tid < 32) __hip_atomic_fetch_max(gmax + tid, red[tid], __ATOMIC_RELAXED, __HIP_MEMORY_SCOPE_AGENT);
            __builtin_amdgcn_fence(__ATOMIC_RELEASE, "agent");
            if (tid == 0) { __hip_atomic_fetch_add(gcnt, 1u, __ATOMIC_RELEASE, __HIP_MEMORY_SCOPE_AGENT);
                while (__hip_atomic_load(gcnt, __ATOMIC_ACQUIRE, __HIP_MEMORY_SCOPE_AGENT) < 4u) __builtin_amdgcn_s_sleep(2); }
            __builtin_amdgcn_fence(__ATOMIC_ACQUIRE, "agent");
            if (tid < 32) red[tid] = __hip_atomic_load(gmax + tid, __ATOMIC_RELAXED, __HIP_MEMORY_SCOPE_AGENT); }
        __syncthreads();
    }
    float inv[4];
#pragma unroll
    for (int q = 0; q < 4; ++q) { float m = __builtin_bit_cast(float, red[4 * g + q]);
        m = __builtin_bit_cast(float, f2bf(m) << 16);
        inv[q] = m > 0.f ? 127.f / m : 0.f;
        if (s == 0 && k0 == 0) scales[4 * g + q] = m * (1.f / 127.f); }
    LAS unsigned char* wb = img + (4 * g) * 4096 + (((s >> 2) ^ g) << 4) + ((s & 3) << 2);
    int sq[4] = {0, 0, 0, 0};
#pragma unroll
    for (int j = 0; j < 16; ++j)
#pragma unroll
        for (int q = 0; q < 4; ++q) { const unsigned p0 = d[j][2 * q], p1 = d[j][2 * q + 1];
            const int i0 = (int)__builtin_rintf(__builtin_bit_cast(float, p0 << 16) * inv[q]), i1 = (int)__builtin_rintf(__builtin_bit_cast(float, p0 & 0xffff0000u) * inv[q]);
            const int i2 = (int)__builtin_rintf(__builtin_bit_cast(float, p1 << 16) * inv[q]), i3 = (int)__builtin_rintf(__builtin_bit_cast(float, p1 & 0xffff0000u) * inv[q]);
            if constexpr (SPLITK) sq[q] += (i0 + i1) + (i2 + i3);
            *(LAS unsigned*)(wb + q * 4096 + j * 256) = ((unsigned)i0 & 255u) | (((unsigned)i1 & 255u) << 8) | (((unsigned)i2 & 255u) << 16) | ((unsigned)i3 << 24); }
    if constexpr (SPLITK) {
#pragma unroll
        for (int q = 0; q < 4; ++q) __hip_atomic_fetch_add((LAS int*)red + 32 + 4 * g + q, sq[q], __ATOMIC_RELAXED, __HIP_MEMORY_SCOPE_WORKGROUP); }
    __syncthreads();
    if constexpr (SPLITK) { if (tid < 32) __hip_atomic_fetch_add(gsum + tid, ((LAS int*)red)[32 + tid], __ATOMIC_RELAXED, __HIP_MEMORY_SCOPE_AGENT); }
    { const LAS unsigned char* rb = img + (4 * w) * 4096 + ((l ^ w) << 4); GAS unsigned char* ob = (GAS unsigned char*)qrows + (size_t)(4 * w) * qpitch + 16 * l;
#pragma unroll
      for (int r = 0; r < 4; ++r)
#pragma unroll
        for (int i = 0; i < 4; ++i) { const v4u x = *(const LAS v4u*)(rb + r * 4096 + i * 1024); *(GAS v4u*)(ob + (size_t)r * qpitch + i * 1024) = x; } }
    __syncthreads();
}
__device__ __forceinline__ void q_drain(Frame& F, const Args& a, int q, int cw, int n);
constexpr int CW_Q0 = 256;
constexpr int Q0_QK = (DM / 64) * (4096 / 32), Q0_MKV = (DM / 64) * (1024 / 32), Q0_N = Q0_QK + Q0_MKV + MTOK + MROWS;
__device__ __forceinline__ void p0_prologue(Frame& F, const Args& a) {
    unsigned char* ws = a.ws;
    for (int job = F.vcu; job < (D_IN - 4096) / 32; job += F.G) { const int vr0 = 32 * job, n0 = vr0 < C_QB ? vr0 : vr0 + 4096;
        colblock32_i8<false>(a.w_in, D_IN, n0, 0, ws + WS_OD + (size_t)vr0 * DM, DM, (float*)(ws + WS_SBIN) + n0, F.lds + RING_OFF, F.tid); }
    q_drain(F, a, 0, CW_Q0, Q0_N);
}

constexpr int QI_A = (1024 / 64) * (DM / 32), QI_B = (2048 / 64) * (DM / 32), QI_MIX = (DM / 64) * (DM / 32), QI_MQ = (DM / 64) * (512 / 32), QI_MO = (512 / 64) * (DM / 32),
              QI_UP = (DM / 64) * (D_FF / 32), QI_DN = (D_FF / 64) * (DM / 32);
constexpr int Q1_N = QI_A + QI_B + QI_MIX + QI_MQ + QI_MO;
constexpr int CW_QJ = 320;
constexpr int CW_DMAX = 81920, CW_DSUM = 86016, CW_DCNT = 90112;
constexpr int CW_Q1 = 64, CW_Q2 = 128, CW_Q3 = 192;
__device__ __forceinline__ void q_item(const Args& a, int q, int r, LAS float* scr, int lane) {
    unsigned char* ws = a.ws;
    if (q == 0) {
        if (r < Q0_QK) { const int kb = r / 128, nb = r % 128; p0_transpose_cols(a.w_in, DM, D_IN, C_QB + 32 * nb, (bf16*)(ws + WS_WIN), C_QB + 32 * nb, scr, kb, lane); return; } r -= Q0_QK;
        if (r < Q0_MKV) { p0_transpose_item(a.w_mkv, DM, 1024, (bf16*)(ws + WS_WMKV), scr, r, lane); return; } r -= Q0_MKV;
        if (r < MTOK) { const int m = r;
            rms_row_to_i8(a.x + (size_t)m * DM, a.g_mix_pre, ws + WS_OBR + (size_t)m * DM, (float*)(ws + WS_SA0) + m, lane, (bf16*)(ws + WS_H) + (size_t)m * DM);
            const float ang = (float)a.pos[m] * INV_FREQ[lane];
            const double rev = (double)ang * 0.15915494309189533577;
            const float fr = (float)(rev - __builtin_floor(rev));
            float2 cs; cs.x = __builtin_amdgcn_cosf(fr); cs.y = __builtin_amdgcn_sinf(fr);
            ((float2*)(ws + WS_ROPE))[(size_t)m * 64 + lane] = cs; return; } r -= MTOK;
        rms_row_to_bf16(a.mem + (size_t)r * DM, a.g_mem_kv, (bf16*)(ws + WS_MB) + (size_t)r * DM, lane); return;
    }
    if (q == 1) {
        if (r < QI_A) { p0_transpose_item(a.w_a, 1024, DM, (bf16*)(ws + WS_WA), scr, r, lane); return; } r -= QI_A;
        if (r < QI_B) { p0_transpose_item(a.w_b, 2048, DM, (bf16*)(ws + WS_WB), scr, r, lane); return; } r -= QI_B;
        if (r < QI_MIX) { p0_transpose_item(a.w_mix, DM, DM, (bf16*)(ws + WS_WMIX), scr, r, lane); return; } r -= QI_MIX;
        if (r < QI_MQ) { p0_transpose_item(a.w_mq, DM, 512, (bf16*)(ws + WS_WMQ), scr, r, lane); return; } r -= QI_MQ;
        p0_transpose_item(a.w_mo, 512, DM, (bf16*)(ws + WS_WMO), scr, r, lane);
    }
}
__device__ __forceinline__ void q_drain(Frame& F, const Args& a, int q, int cw, int n) {
    LAS float* scr = (LAS float*)(F.lds + RING_OFF + F.wave * 16384);
    int lane = F.lane; asm volatile("" : "+v"(lane));
    constexpr int BATCH_ITEMS = 8;
    for (;;) {
        unsigned base = 0;
        if (lane == 0) base = __hip_atomic_fetch_add((unsigned*)(F.ctl + cw), (unsigned)BATCH_ITEMS, __ATOMIC_RELAXED, __HIP_MEMORY_SCOPE_AGENT);
        base = (unsigned)__builtin_amdgcn_readfirstlane((int)base);
        if (base >= (unsigned)n) break;
        const int e = ((int)base + BATCH_ITEMS < n) ? (int)base + BATCH_ITEMS : n;
        for (int it = (int)base; it < e; ++it) q_item(a, q, it, scr, lane);
    }
}
__device__ __forceinline__ unsigned pk4_i8(const f32x4 v, float inv) { const int a = (int)__builtin_rintf(v.x * inv), b = (int)__builtin_rintf(v.y * inv), c = (int)__builtin_rintf(v.z * inv), d = (int)__builtin_rintf(v.w * inv);
    return (unsigned)(a & 255) | ((unsigned)(b & 255) << 8) | ((unsigned)(c & 255) << 16) | ((unsigned)d << 24); }
__device__ __forceinline__ float amax4(const f32x4 v) { return fmaxf(fmaxf(fabsf(v.x), fabsf(v.y)), fmaxf(fabsf(v.z), fabsf(v.w))); }
__device__ __forceinline__ void thin_mix_row(const bf16* OD, const float* LSE, const bf16* OBR, const bf16* OBR2, float lam, const float* subln, unsigned char* OA8, float* sa4, bf16* OBN, int row, int lane) {
    { const int h = lane >> 3;
      const float l0 = LSE[((size_t)0 * MTOK + row) * 8 + h], l1 = LSE[((size_t)1 * MTOK + row) * 8 + h], l2 = LSE[((size_t)2 * MTOK + row) * 8 + h];
      const float mx = fmaxf(l0, fmaxf(l1, l2)); float e0 = __expf(l0 - mx), e1 = __expf(l1 - mx), e2 = __expf(l2 - mx); const float inv = 1.f / (e0 + e1 + e2); e0 *= inv; e1 *= inv; e2 *= inv;
      const GAS v2u* p0 = (const GAS v2u*)(OD + ((size_t)0 * MTOK + row) * 1024) + lane * 4; const GAS v2u* p1 = (const GAS v2u*)(OD + ((size_t)1 * MTOK + row) * 1024) + lane * 4;
      const GAS v2u* p2 = (const GAS v2u*)(OD + ((size_t)2 * MTOK + row) * 1024) + lane * 4; f32x4 v[4]; float am = 0.f;
#pragma unroll
      for (int j = 0; j < 4; ++j) { f32x4 a, b, c; unpack4(__builtin_nontemporal_load(p0 + j), a); unpack4(__builtin_nontemporal_load(p1 + j), b); unpack4(__builtin_nontemporal_load(p2 + j), c); v[j] = a * e0 + b * e1 + c * e2; am = fmaxf(am, amax4(v[j])); }
      am = wave_max(am); const float qi = am > 0.f ? 127.f / am : 0.f; if (lane == 0) sa4[row] = am * (1.f / 127.f);
      v4u w;
#pragma unroll
      for (int j = 0; j < 4; ++j) w[j] = pk4_i8(v[j], qi);
      ((GAS v4u*)(OA8 + (size_t)row * 1024))[lane] = w; }
    { const GAS v2u* p = (const GAS v2u*)(OBR + (size_t)row * 2048) + lane; const GAS v2u* p2 = (const GAS v2u*)(OBR2 + (size_t)row * 2048) + lane; const f32x4 g = ((const GAS f32x4*)subln)[lane]; GAS v2u* o = (GAS v2u*)(OBN + (size_t)row * 2048) + lane;
      v2u aw[8], bw[8];
#pragma unroll
      for (int h = 0; h < 8; ++h) { aw[h] = __builtin_nontemporal_load(p + 64 * h); bw[h] = __builtin_nontemporal_load(p2 + 64 * h); }
#pragma unroll
      for (int h = 0; h < 8; ++h) { f32x4 a, b; unpack4(aw[h], a); unpack4(bw[h], b); const f32x4 v = a - b * lam; const float s = wave_sum((v.x * v.x + v.y * v.y) + (v.z * v.z + v.w * v.w));
          const float rstd = 0.8f / sqrtf(s * (1.f / 256.f) + NORM_EPS); v2u w; w.x = pk2(v.x * rstd * g.x, v.y * rstd * g.y); w.y = pk2(v.z * rstd * g.z, v.w * rstd * g.w); o[64 * h] = w; } }
}

#ifndef PG8_SP2
#define PG8_SP2 true
#endif
#ifndef PG8_ALIGN
#define PG8_ALIGN true
#endif
#ifndef MK_FP8_SP2
#define MK_FP8_SP2 true
#endif
#ifndef MK_FP8_ALIGN
#define MK_FP8_ALIGN true
#endif
#ifndef MK_QREG_DIFF
#define MK_QREG_DIFF true
#endif
#ifndef MK_QREG_CROSS
#define MK_QREG_CROSS true
#endif
constexpr int NPHASE = 15;
#ifndef MK_FAST
#define MK_FAST 0x7FFFu
#endif
constexpr unsigned FAST = MK_FAST;
__global__ void __launch_bounds__(NWAVES * 64, 2) mk_fwd(Args args) {
    extern __shared__ __attribute__((aligned(16))) unsigned char lds[];
    Frame F;
    F.lds = (LAS unsigned char*)lds;
    F.MISC = (volatile LAS unsigned*)(F.lds + MISC_OFF);
    F.tid = threadIdx.x; F.lane = F.tid & 63; F.wave = __builtin_amdgcn_readfirstlane(F.tid >> 6);
    F.G = gridDim.x; { const int bx = blockIdx.x; F.vcu = (F.G % 8 == 0) ? (bx % 8) * (F.G / 8) + bx / 8 : bx; }
    F.ctl = (gu32*)(args.ws + WS_CTL);
    for (int u = F.tid; u < (LDS_BYTES - LDSCTL_OFF) / 4; u += NWAVES * 64) ((LAS unsigned*)(F.lds + LDSCTL_OFF))[u] = 0u;
    __syncthreads();
    const int ph_lo_ = args.ph_lo, ph_hi_ = args.ph_hi;
    unsigned* barw = (unsigned*)(F.ctl + CW_BAR) + args.li * XCD_BAR_WORDS;
    XcdBarrier bar; bar.bar = barw; bar.x = 0; bar.st = F.MISC + 8;
    if (ph_hi_ - ph_lo_ > 1) bar = xcd_barrier_post(barw, F.MISC + 8);
#define IN(k) (ph_lo_ <= (k) && (k) < ph_hi_)
#define SEAM(k) do { if (IN(k) && IN((k) + 1)) xcd_barrier(bar); } while (0)
    if (IN(0)) { p0_prologue(F, args); SEAM(0); }
    unsigned char* ws = args.ws; asm volatile("" : "+s"(ws));
    bf16 *WIN = (bf16*)(ws + WS_WIN), *WA = (bf16*)(ws + WS_WA), *WB = (bf16*)(ws + WS_WB), *WMIX = (bf16*)(ws + WS_WMIX), *WMQ = (bf16*)(ws + WS_WMQ), *WMKV = (bf16*)(ws + WS_WMKV),
         *WMO = (bf16*)(ws + WS_WMO), *WUP = (bf16*)(ws + WS_WUP), *WDN = (bf16*)(ws + WS_WDN), *H = (bf16*)(ws + WS_H), *MB = (bf16*)(ws + WS_MB), *PROJ = (bf16*)(ws + WS_PROJ),
         *U = (bf16*)(ws + WS_U), *OA = (bf16*)(ws + WS_OA), *OBN = (bf16*)(ws + WS_OBN), *MERGED = (bf16*)(ws + WS_MERGED), *Q2 = (bf16*)(ws + WS_Q2), *KV2 = (bf16*)(ws + WS_KV2), *O2 = (bf16*)(ws + WS_O2);
    float *ROPE = (float*)(ws + WS_ROPE), *LSE = (float*)(ws + WS_LSE); bf16 *OD = (bf16*)(ws + WS_OD)  , *OBR = (bf16*)(ws + WS_OBR), *OBR2 = (bf16*)(ws + WS_OBR + 32 * MiB)  ; bf16* Y = (bf16*)(ws + WS_Y); bf16* XR = (bf16*)(ws + WS_OD + 48 * MiB);
    const int gw = F.vcu * NWAVES + F.wave, NGW = F.G * NWAVES;
    if (IN(1)) {
        { pg8::Gemm g{H, WIN + (size_t)C_QB * DM, MTOK, 4096, DM, DM, DM, 0, 0, C_QB / 256}; pg8::StaticOrder S; S.init(MTOK, 4096, F.G, (int)blockIdx.x);
          pg8::EpiProj<false> E{PROJ, ROPE, 1.f};
          pg8::gemm_phase<pg8::EpiProj<false>, pg8::StaticOrder, PG8_ALIGN, PG8_SP2>(F.lds + RING_OFF, g, S, E); }
        { pg8::Gemm g{(const bf16*)(ws + WS_OBR), (const bf16*)(ws + WS_OD), MTOK, D_IN - 4096, DM, DM, DM, C_QB / 256, 0, 16}; pg8::StaticOrder S; S.init(MTOK, D_IN - 4096, F.G, (int)blockIdx.x);
          pg8::EpiProjI8 E{PROJ, ROPE, (const float*)(ws + WS_SA0), (const float*)(ws + WS_SBIN)};
          pg8::gemm_phase<pg8::EpiProjI8, pg8::StaticOrder, PG8_ALIGN, PG8_SP2, false, true>(F.lds + RING_OFF, g, S, E); }
        { pg8::Gemm g{MB, WMKV, MROWS, 1024, DM / 2, DM, DM}; pg8::StaticOrder S; S.init(MROWS, 1024, F.G, (int)((blockIdx.x + F.G - 128) % F.G));
          pg8::EpiF32 E{(float*)(ws + WS_Y + 64 * MiB), 1024};
          pg8::gemm_phase<pg8::EpiF32, pg8::StaticOrder, PG8_ALIGN, PG8_SP2>(F.lds + RING_OFF, g, S, E); }
        { pg8::Gemm g{MB + DM / 2, WMKV + DM / 2, MROWS, 1024, DM / 2, DM, DM}; pg8::StaticOrder S; S.init(MROWS, 1024, F.G, (int)((blockIdx.x + F.G - 136) % F.G));
          pg8::EpiF32 E{(float*)(ws + WS_Y + 68 * MiB), 1024};
          pg8::gemm_phase<pg8::EpiF32, pg8::StaticOrder, PG8_ALIGN, PG8_SP2>(F.lds + RING_OFF, g, S, E); }
        q_drain(F, args, 1, CW_Q1, Q1_N);
        SEAM(1);
    }
    if (IN(2)) {
        char* alds = (char*)lds + RING_OFF;
        const int wid = F.wave;
#ifndef MK_NO_DIFF
        for (int u = F.vcu; u < BATCH * 8 * (SEQ / 128); u += F.G) {
            const int b = u / (8 * (SEQ / 128)), h = (u / (SEQ / 128)) % 8, qb = u % (SEQ / 128);
            const size_t row0 = (size_t)b * SEQ + (size_t)qb * 128;
            for (int c = 0; c < 2; ++c)
                att::diff_pass(PROJ + row0 * D_IN + C_QB + (h * 2 + c) * 128, PROJ + (size_t)b * SEQ * D_IN + C_KB + (h * 2 + c) * 128, PROJ + (size_t)b * SEQ * D_IN + C_VB + h * 256,
                               D_IN, SEQ / 64, alds, (c == 0 ? OBR : OBR2) + row0 * 2048 + h * 256, qb);
        }
#endif
#ifndef MK_NO_DIL
        for (int u = F.vcu; u < 768; u += F.G) {
            const int g = u >> 8, v = u & 255, b = v >> 7, h = (v >> 4) & 7, rq = v & 15;
            const int dil = (g == 0) ? 1 : (g == 1 ? 4 : 16), res = rq % dil, qblk = rq / dil, L = SEQ / dil;
            const int q0 = qblk * 256, NT = (g == 2) ? 4 : 6; int t0 = q0 / 64 - 1; t0 = t0 < 0 ? 0 : t0; t0 = (t0 > L / 64 - NT) ? (L / 64 - NT) : t0;
            const size_t base = ((size_t)b * SEQ + res) * D_IN + (g * 8 + h) * 128; const long ld = (long)dil * D_IN;
            att::f32x16 o[4]; float m_reg, l_reg;
            att::body<true, false>(PROJ + base + (size_t)q0 * ld + C_QA, ld, PROJ + base + (size_t)(t0 * 64) * ld + C_KA, PROJ + base + (size_t)(t0 * 64) * ld + C_VA, ld, NT, q0 - t0 * 64, alds, o, m_reg, l_reg);
            float rli[16]; att::row_recip(alds, l_reg, rli);
                int ln_ = F.lane; asm volatile("" : "+v"(ln_)); const int r32 = ln_ & 31, hi = ln_ >> 5;
            const size_t tok0 = (size_t)b * SEQ + res + (size_t)(q0 + wid * 32) * dil;
            bf16* Ow = OD + ((size_t)g * MTOK + tok0) * 1024 + h * 128 + r32;
#pragma unroll
            for (int r = 0; r < 16; ++r) { bf16* p = Ow + (size_t)att::crow(r, hi) * dil * 1024;
#pragma unroll
                for (int d0 = 0; d0 < 4; ++d0) p[d0 * 32] = (bf16)f2bf(o[d0][r] * rli[r]); }
            if (hi == 0) LSE[((size_t)g * MTOK + tok0 + (size_t)r32 * dil) * 8 + h] = m_reg * att::SCALE + __logf(l_reg);
        }
#endif
        SEAM(2);
    }
    if (IN(3)) {
        const float ld1 = wave_sum(args.lq1[F.lane] * args.lk1[F.lane] + args.lq1[F.lane + 64] * args.lk1[F.lane + 64]);
        const float ld2 = wave_sum(args.lq2[F.lane] * args.lk2[F.lane] + args.lq2[F.lane + 64] * args.lk2[F.lane + 64]);
        const float lam = __expf(ld1) - __expf(ld2) + 0.2f;
        for (int m = gw; m < MTOK; m += NGW) thin_mix_row(OD, LSE, OBR, OBR2, lam, args.subln, (unsigned char*)OA, (float*)(ws + WS_SA4), OBN, m, F.lane);
        for (int n = gw; n < DM; n += NGW) quant_row_bf16_i8<2>(WA + (size_t)n * 1024, ws + WS_DTMP + (size_t)n * 1024, (float*)(ws + WS_SBA) + n, F.lane);
        { const GAS f32x4* k0 = (const GAS f32x4*)(ws + WS_Y + 64 * MiB); const GAS f32x4* k1 = (const GAS f32x4*)(ws + WS_Y + 68 * MiB); GAS v2u* ko = (GAS v2u*)KV2;
          for (int c = F.vcu * (NWAVES * 64) + F.tid; c < MROWS * 1024 / 4; c += F.G * NWAVES * 64) { const f32x4 a = k0[c], b = k1[c]; v2u o; o.x = pk2(a.x + b.x, a.y + b.y); o.y = pk2(a.z + b.z, a.w + b.w); ko[c] = o; } }
        SEAM(3); }
    if (IN(4)) { pg8::Gemm g{OA, (const bf16*)(ws + WS_DTMP), MTOK, DM, 1024, 1024, 1024}; pg8::StaticOrder S; S.init(MTOK, DM, F.G, (int)blockIdx.x);
        pg8::EpiGateI8<false> E{MERGED, DM, PROJ + C_GA, D_IN, (const float*)(ws + WS_SA4), (const float*)(ws + WS_SBA)};
        pg8::gemm_phase<pg8::EpiGateI8<false>, pg8::StaticOrder, PG8_ALIGN, PG8_SP2, false, true>(F.lds + RING_OFF, g, S, E); }
    if (IN(5)) { pg8::Gemm g{OBN, WB, MTOK, DM, 2048, 2048, 2048}; pg8::StaticOrder S; S.init(MTOK, DM, F.G, (int)blockIdx.x);
        pg8::EpiGate<true> E{MERGED, DM, PROJ + C_GB, D_IN};
        pg8::gemm_phase<pg8::EpiGate<true>, pg8::StaticOrder, PG8_ALIGN, PG8_SP2>(F.lds + RING_OFF, g, S, E); SEAM(5); }
    if (IN(6)) { pg8::Gemm g{MERGED, WMIX, MTOK, DM, DM, DM, DM}; pg8::StaticOrder S; S.init(MTOK, DM, F.G, (int)blockIdx.x);
        pg8::EpiBf16<0> E{Y, DM};
        pg8::gemm_phase<pg8::EpiBf16<0>, pg8::StaticOrder, PG8_ALIGN, PG8_SP2>(F.lds + RING_OFF, g, S, E); SEAM(6); }
    if (IN(7)) { for (int m = gw; m < MTOK; m += NGW) norm_res_row<false, true>(Y + (size_t)m * DM, args.g_mix_post, args.x + (size_t)m * DM, XR + (size_t)m * DM, args.g_mem_pre, H + (size_t)m * DM, F.lane); SEAM(7); }
    if (IN(8)) {
        pg8::Gemm g{H, WMQ, MTOK, 512, DM, DM, DM}; pg8::StaticOrder S; S.init(MTOK, 512, F.G, (int)blockIdx.x);
        pg8::EpiBf16<0> E{Q2, 512};
        pg8::gemm_phase<pg8::EpiBf16<0>, pg8::StaticOrder, PG8_ALIGN, PG8_SP2>(F.lds + RING_OFF, g, S, E);
#ifndef MK_NO_CROSS
        pg8::Unit u8;
        if (S.next(0, u8)) {
            VM_WAIT(); __builtin_amdgcn_fence(__ATOMIC_ACQUIRE, "agent"); VM_WAIT(); __syncthreads();
            char* alds = (char*)lds + RING_OFF; const int wid = F.wave;
            const size_t row0 = (size_t)u8.pm * 256; const int b = u8.pm / (SEQ / 256);
            for (int hh = 2 * u8.pn; hh < 2 * u8.pn + 2; ++hh) {
                att::f32x16 o[4]; float m_reg, l_reg;
                att::body<false, MK_QREG_CROSS>(Q2 + row0 * 512 + hh * 128, 512, KV2 + (size_t)b * MEM_LEN * 1024 + hh * 128, KV2 + (size_t)b * MEM_LEN * 1024 + 512 + hh * 128, 1024, MEM_LEN / 64, 0, alds, o, m_reg, l_reg);
                float rli[16]; att::row_recip(alds, l_reg, rli);
                int ln_ = F.lane; asm volatile("" : "+v"(ln_)); const int r32 = ln_ & 31, hi = ln_ >> 5;
                bf16* Ow = O2 + (row0 + wid * 32) * 512 + hh * 128 + r32;
#pragma unroll
                for (int r = 0; r < 16; ++r) { bf16* p = Ow + (size_t)att::crow(r, hi) * 512;
#pragma unroll
                    for (int d0 = 0; d0 < 4; ++d0) { const float v = o[d0][r] * rli[r]; const float nb = __shfl_xor(v, 1); if (!(ln_ & 1)) *(unsigned*)(p + d0 * 32) = pk2(v, nb); } }
            }
            __syncthreads();
        }
#endif
        for (;;) { if (F.tid == 0) F.MISC[16] = __hip_atomic_fetch_add((unsigned*)(F.ctl + CW_QJ), 1u, __ATOMIC_RELAXED, __HIP_MEMORY_SCOPE_AGENT);
            __syncthreads(); const int job = (int)F.MISC[16]; __syncthreads();
            if (job >= D_FF / 32 + 4 * (DM / 32)) break;
            if (job < D_FF / 32) colblock32_i8<false>(args.w_up, D_FF, 32 * job, 0, ws + WS_WIN + (size_t)(32 * job) * DM, DM, (float*)(ws + WS_SB) + 32 * job, F.lds + RING_OFF, F.tid);
            else { const int jd = job - D_FF / 32, cb = jd >> 2, kq = jd & 3;
                colblock32_i8<true>(args.w_dn, DM, 32 * cb, 4096 * kq, ws + WS_DTMP + (size_t)(32 * cb) * D_FF + 4096 * kq, D_FF, (float*)(ws + WS_SD) + 32 * cb, F.lds + RING_OFF, F.tid,
                                    (unsigned*)(F.ctl + CW_DMAX) + 32 * cb, (unsigned*)(F.ctl + CW_DCNT) + cb, (int*)(F.ctl + CW_DSUM) + 32 * cb); } }
        SEAM(8);
    }
    if (IN(10)) { pg8::Gemm g{O2, WMO, MTOK, DM, 512, 512, 512}; pg8::StaticOrder S; S.init(MTOK, DM, F.G, (int)blockIdx.x);
        pg8::EpiBf16<0> E{Y, DM};
        pg8::gemm_phase<pg8::EpiBf16<0>, pg8::StaticOrder, PG8_ALIGN, PG8_SP2>(F.lds + RING_OFF, g, S, E); SEAM(10); }
    if (IN(11)) { for (int m = gw; m < MTOK; m += NGW) norm_res_row<true, true>(Y + (size_t)m * DM, args.g_mem_post, XR + (size_t)m * DM, XR + (size_t)m * DM, args.g_mlp_pre, nullptr, F.lane, ws + WS_H8 + (size_t)m * DM, (float*)(ws + WS_SA) + m);
        SEAM(11); }
    if (IN(12)) { pg8::Gemm g{(const bf16*)(ws + WS_H8), (const bf16*)(ws + WS_WIN), MTOK, D_FF, DM, DM, DM}; pg8::StaticOrder S; S.init(MTOK, D_FF, F.G, (int)blockIdx.x);
        pg8::EpiI8Relu2 E{U, D_FF, (const float*)(ws + WS_SA), (const float*)(ws + WS_SB), (unsigned*)(F.ctl + CW_UMAX)};
        pg8::gemm_phase<pg8::EpiI8Relu2, pg8::StaticOrder, PG8_ALIGN, PG8_SP2, false, true>(F.lds + RING_OFF, g, S, E);
        xcd_barrier(bar);
        { const unsigned* um = (const unsigned*)(F.ctl + CW_UMAX);
          for (int m = gw; m < MTOK; m += NGW) {
              const float mx = __builtin_bit_cast(float, __hip_atomic_load(um + m, __ATOMIC_RELAXED, __HIP_MEMORY_SCOPE_AGENT)); const float inv = mx > 0.f ? 255.f / mx : 0.f;
              const GAS v4u* src = (const GAS v4u*)(U + (size_t)m * D_FF) + F.lane; GAS v2u* dst = (GAS v2u*)(ws + WS_WIN + (size_t)m * D_FF) + F.lane;
#pragma unroll
              for (int bt = 0; bt < 2; ++bt) { v4u w[16];
#pragma unroll
                  for (int i = 0; i < 16; ++i) w[i] = __builtin_nontemporal_load(src + 64 * (16 * bt + i));
#pragma unroll
                  for (int i = 0; i < 16; ++i) { unsigned q[8];
#pragma unroll
                      for (int j = 0; j < 4; ++j) { int a = (int)__builtin_rintf(__builtin_bit_cast(float, w[i][j] << 16) * inv), b = (int)__builtin_rintf(__builtin_bit_cast(float, w[i][j] & 0xffff0000u) * inv);
                          a = (a > 255 ? 255 : a) - 128; b = (b > 255 ? 255 : b) - 128; q[2 * j] = (unsigned)a & 255u; q[2 * j + 1] = (unsigned)b & 255u; }
                      v2u ov; ov.x = q[0] | (q[1] << 8) | (q[2] << 16) | (q[3] << 24); ov.y = q[4] | (q[5] << 8) | (q[6] << 16) | (q[7] << 24); dst[64 * (16 * bt + i)] = ov; } }
              if (F.lane == 0) ((float*)(ws + WS_SU))[m] = mx * (1.f / 255.f); } }
        SEAM(12); }
    if (IN(13)) { pg8::Gemm g{(const bf16*)(ws + WS_WIN), (const bf16*)(ws + WS_DTMP), MTOK, DM, D_FF, D_FF, D_FF}; pg8::StaticOrder S; S.init(MTOK, DM, F.G, (int)blockIdx.x);
        pg8::EpiI8Down E{Y, DM, (const float*)(ws + WS_SU), (const float*)(ws + WS_SD), (const int*)(F.ctl + CW_DSUM)};
        pg8::gemm_phase<pg8::EpiI8Down, pg8::StaticOrder, PG8_ALIGN, PG8_SP2, false, true>(F.lds + RING_OFF, g, S, E); SEAM(13); }
    if (IN(14)) { for (int m = gw; m < MTOK; m += NGW) norm_res_row<true, false>(Y + (size_t)m * DM, args.g_mlp_post, XR + (size_t)m * DM, args.out + (size_t)m * DM, nullptr, nullptr, F.lane); }
#undef IN
#undef SEAM
}

namespace nv {
enum { EP_BF16 = 0, EP_F32 = 1, EP_RELU2 = 2, EP_GATE = 3, EP_GATE_ADD = 4 };
template <int EP>
__global__ __launch_bounds__(256) void gemm(const bf16* __restrict__ A, int lda, const bf16* __restrict__ Bt, int ldb, void* Cv, int ldc, int K, const bf16* __restrict__ gate, int ldg) {
    __shared__ float As[16][132], Bs[16][132];
    const int tid = threadIdx.x, tx = tid & 15, ty = tid >> 4;
    const int m0 = blockIdx.y * 128, n0 = blockIdx.x * 128;
    const int lr = tid >> 1, lc = (tid & 1) * 8;
    float acc[8][8];
#pragma unroll
    for (int i = 0; i < 8; ++i)
#pragma unroll
        for (int j = 0; j < 8; ++j) acc[i][j] = 0.f;
    for (int k0 = 0; k0 < K; k0 += 16) {
        const v4u av = *(const v4u*)(A + (size_t)(m0 + lr) * lda + k0 + lc);
        const v4u bv = *(const v4u*)(Bt + (size_t)(n0 + lr) * ldb + k0 + lc);
        __syncthreads();
        As[lc + 0][lr] = __builtin_bit_cast(float, av.x << 16); As[lc + 1][lr] = __builtin_bit_cast(float, av.x & 0xffff0000u);
        As[lc + 2][lr] = __builtin_bit_cast(float, av.y << 16); As[lc + 3][lr] = __builtin_bit_cast(float, av.y & 0xffff0000u);
        As[lc + 4][lr] = __builtin_bit_cast(float, av.z << 16); As[lc + 5][lr] = __builtin_bit_cast(float, av.z & 0xffff0000u);
        As[lc + 6][lr] = __builtin_bit_cast(float, av.w << 16); As[lc + 7][lr] = __builtin_bit_cast(float, av.w & 0xffff0000u);
        Bs[lc + 0][lr] = __builtin_bit_cast(float, bv.x << 16); Bs[lc + 1][lr] = __builtin_bit_cast(float, bv.x & 0xffff0000u);
        Bs[lc + 2][lr] = __builtin_bit_cast(float, bv.y << 16); Bs[lc + 3][lr] = __builtin_bit_cast(float, bv.y & 0xffff0000u);
        Bs[lc + 4][lr] = __builtin_bit_cast(float, bv.z << 16); Bs[lc + 5][lr] = __builtin_bit_cast(float, bv.z & 0xffff0000u);
        Bs[lc + 6][lr] = __builtin_bit_cast(float, bv.w << 16); Bs[lc + 7][lr] = __builtin_bit_cast(float, bv.w & 0xffff0000u);
        __syncthreads();
#pragma unroll
        for (int kk = 0; kk < 16; ++kk) {
            float a[8], b[8];
#pragma unroll
            for (int i = 0; i < 8; ++i) a[i] = As[kk][ty * 8 + i];
#pragma unroll
            for (int j = 0; j < 8; ++j) b[j] = Bs[kk][tx * 8 + j];
#pragma unroll
            for (int i = 0; i < 8; ++i)
#pragma unroll
                for (int j = 0; j < 8; ++j) acc[i][j] += a[i] * b[j];
        }
    }
#pragma unroll
    for (int i = 0; i < 8; ++i) {
        const size_t r = (size_t)(m0 + ty * 8 + i);
#pragma unroll
        for (int j = 0; j < 8; ++j) {
            const int c = n0 + tx * 8 + j; float v = acc[i][j];
            if (EP == EP_F32) { ((float*)Cv)[r * ldc + c] = v; }
            else {
                bf16* C = (bf16*)Cv;
                if (EP == EP_RELU2) { v = v > 0.f ? v * v : 0.f; }
                if (EP == EP_GATE) { v = v * bf2f(gate[r * ldg + c]); }
                if (EP == EP_GATE_ADD) { v = v * bf2f(gate[r * ldg + c]) + bf2f(C[r * ldc + c]); }
                C[r * ldc + c] = (bf16)f2bf(v);
            }
        }
    }
}
__global__ __launch_bounds__(256) void proj_post(bf16* proj, const float* rope) {
    const int row = blockIdx.x; bf16* p = proj + (size_t)row * D_IN; const float2* rt = (const float2*)rope + (size_t)row * 64;
    for (int e = threadIdx.x; e < 80 * 64; e += 256) {
        const int ch = e >> 6, i = e & 63; const int c0 = (ch < 48 ? ch * 128 : C_QB + (ch - 48) * 128);
        const float x1 = bf2f(p[c0 + i]), x2 = bf2f(p[c0 + 64 + i]); const float2 cs = rt[i];
        p[c0 + i] = (bf16)f2bf(x1 * cs.x - x2 * cs.y); p[c0 + 64 + i] = (bf16)f2bf(x2 * cs.x + x1 * cs.y);
    }
    for (int c = C_GA + threadIdx.x; c < D_IN; c += 256) { const float g = bf2f(p[c]); p[c] = (bf16)f2bf(1.f / (1.f + __expf(-g))); }
}
template <int NV>
__device__ __forceinline__ void attn_block(const float* qs, const bf16* Kb, const bf16* Vb, size_t pitch, int myrow, float& m, float& l, float (&o)[NV], int lane) {
    float s = -INFINITY;
    if (myrow >= 0) { const bf16* kp = Kb + (size_t)myrow * pitch; float acc = 0.f;
        for (int d = 0; d < 128; d += 8) { const v4u kv = *(const v4u*)(kp + d);
            acc += qs[d + 0] * __builtin_bit_cast(float, kv.x << 16) + qs[d + 1] * __builtin_bit_cast(float, kv.x & 0xffff0000u);
            acc += qs[d + 2] * __builtin_bit_cast(float, kv.y << 16) + qs[d + 3] * __builtin_bit_cast(float, kv.y & 0xffff0000u);
            acc += qs[d + 4] * __builtin_bit_cast(float, kv.z << 16) + qs[d + 5] * __builtin_bit_cast(float, kv.z & 0xffff0000u);
            acc += qs[d + 6] * __builtin_bit_cast(float, kv.w << 16) + qs[d + 7] * __builtin_bit_cast(float, kv.w & 0xffff0000u); }
        s = acc * ATT_SCALE; }
    const float bm = wave_max(s);
    if (bm == -INFINITY) return;
    const float mn = fmaxf(m, bm), alpha = __expf(m - mn);
    const float p = (myrow >= 0) ? __expf(s - mn) : 0.f;
    l = l * alpha + wave_sum(p);
#pragma unroll
    for (int t = 0; t < NV; ++t) o[t] *= alpha;
    for (int j = 0; j < 64; ++j) {
        const float pj = __shfl(p, j); const int rj = __shfl(myrow, j);
        if (rj >= 0) { const bf16* vp = Vb + (size_t)rj * pitch;
#pragma unroll
            for (int t = 0; t < NV; ++t) o[t] += pj * bf2f(vp[lane + 64 * t]); }
    }
    m = mn;
}
__global__ __launch_bounds__(256) void dil_attn(const bf16* proj, float* OD, float* LSE) {
    __shared__ float qsm[4][128];
    const int wv = threadIdx.x >> 6, lane = threadIdx.x & 63; const int task = blockIdx.x * 4 + wv; const int row = task >> 3, h = task & 7;
    const int b = row / SEQ, s = row % SEQ; float* qs = qsm[wv];
    for (int g = 0; g < 3; ++g) {
        const int dil = (g == 0) ? 1 : (g == 1 ? 4 : 16);
        const bf16* qp = proj + (size_t)row * D_IN + C_QA + (g * 8 + h) * 128;
        qs[lane] = bf2f(qp[lane]); qs[lane + 64] = bf2f(qp[lane + 64]);
        __syncthreads();
        const bf16* Kb = proj + (size_t)b * SEQ * D_IN + C_KA + (g * 8 + h) * 128; const bf16* Vb = proj + (size_t)b * SEQ * D_IN + C_VA + (g * 8 + h) * 128;
        float m = -INFINITY, l = 0.f, o[2] = {0.f, 0.f};
        for (int blk = 0; blk < 3; ++blk) {
            const int j = blk * 64 + lane; int idx = s + (j - 64) * dil; if (j > 128 || idx < 0 || idx >= SEQ) idx = -1;
            attn_block<2>(qs, Kb, Vb, D_IN, idx, m, l, o, lane);
        }
        const float il = 1.f / l;
        OD[((size_t)g * MTOK + row) * 1024 + h * 128 + lane] = o[0] * il; OD[((size_t)g * MTOK + row) * 1024 + h * 128 + 64 + lane] = o[1] * il;
        if (lane == 0) LSE[((size_t)g * MTOK + row) * 8 + h] = m + __logf(l);
        __syncthreads();
    }
}
__global__ __launch_bounds__(256) void diff_attn(const bf16* proj, float* OBR, const float* lq1, const float* lk1, const float* lq2, const float* lk2) {
    __shared__ float qsm[4][128];
    const int wv = threadIdx.x >> 6, lane = threadIdx.x & 63; const int task = blockIdx.x * 4 + wv; const int row = task >> 3, h = task & 7;
    const int b = row / SEQ; float* qs = qsm[wv];
    const float d1 = wave_sum(lq1[lane] * lk1[lane] + lq1[lane + 64] * lk1[lane + 64]), d2 = wave_sum(lq2[lane] * lk2[lane] + lq2[lane + 64] * lk2[lane + 64]);
    const float lam = __expf(d1) - __expf(d2) + 0.2f;
    float res[4] = {0.f, 0.f, 0.f, 0.f};
    for (int c = 0; c < 2; ++c) {
        const bf16* qp = proj + (size_t)row * D_IN + C_QB + (h * 2 + c) * 128;
        qs[lane] = bf2f(qp[lane]); qs[lane + 64] = bf2f(qp[lane + 64]);
        __syncthreads();
        const bf16* Kb = proj + (size_t)b * SEQ * D_IN + C_KB + (h * 2 + c) * 128; const bf16* Vb = proj + (size_t)b * SEQ * D_IN + C_VB + h * 256;
        float m = -INFINITY, l = 0.f, o[4] = {0.f, 0.f, 0.f, 0.f};
        for (int blk = 0; blk < SEQ / 64; ++blk) attn_block<4>(qs, Kb, Vb, D_IN, blk * 64 + lane, m, l, o, lane);
        const float il = (c == 0 ? 1.f : -lam) / l;
#pragma unroll
        for (int t = 0; t < 4; ++t) res[t] += o[t] * il;
        __syncthreads();
    }
#pragma unroll
    for (int t = 0; t < 4; ++t) OBR[(size_t)row * 2048 + h * 256 + lane + 64 * t] = res[t];
}
__global__ __launch_bounds__(256) void thin_mix(const float* OD, const float* LSE, const float* OBR, const float* subln, bf16* OA, bf16* OBN) {
    const int row = blockIdx.x, tid = threadIdx.x;
    for (int c = tid; c < 1024; c += 256) { const int h = c >> 7;
        const float l0 = LSE[((size_t)0 * MTOK + row) * 8 + h], l1 = LSE[((size_t)1 * MTOK + row) * 8 + h], l2 = LSE[((size_t)2 * MTOK + row) * 8 + h];
        const float mx = fmaxf(l0, fmaxf(l1, l2)); const float e0 = __expf(l0 - mx), e1 = __expf(l1 - mx), e2 = __expf(l2 - mx); const float inv = 1.f / (e0 + e1 + e2);
        const float v = (e0 * OD[((size_t)0 * MTOK + row) * 1024 + c] + e1 * OD[((size_t)1 * MTOK + row) * 1024 + c] + e2 * OD[((size_t)2 * MTOK + row) * 1024 + c]) * inv;
        OA[(size_t)row * 1024 + c] = (bf16)f2bf(v); }
    const int wv = tid >> 6, lane = tid & 63;
    for (int hh = 0; hh < 2; ++hh) { const int h = wv * 2 + hh; float v[4]; float s = 0.f;
#pragma unroll
        for (int t = 0; t < 4; ++t) { v[t] = OBR[(size_t)row * 2048 + h * 256 + lane + 64 * t]; s += v[t] * v[t]; }
        const float rstd = 1.f / sqrtf(wave_sum(s) * (1.f / 256.f) + NORM_EPS);
#pragma unroll
        for (int t = 0; t < 4; ++t) OBN[(size_t)row * 2048 + h * 256 + lane + 64 * t] = (bf16)f2bf(v[t] * rstd * subln[lane + 64 * t] * 0.8f); }
}
template <bool BB, bool OB>
__global__ __launch_bounds__(256) void norm_res(const bf16* Y, const float* g1, const void* base, void* out, const float* g2, bf16* H) {
    const int row = blockIdx.x * 4 + (threadIdx.x >> 6);
    const size_t bo = (size_t)row * DM * (BB ? 2 : 4), oo = (size_t)row * DM * (OB ? 2 : 4);
    norm_res_row<BB, OB>(Y + (size_t)row * DM, g1, (const char*)base + bo, (char*)out + oo, g2, H ? H + (size_t)row * DM : nullptr, threadIdx.x & 63);
}
__global__ __launch_bounds__(256) void cross_attn(const bf16* Q2, const bf16* KV2, bf16* O2) {
    __shared__ float qsm[4][128];
    const int wv = threadIdx.x >> 6, lane = threadIdx.x & 63; const int task = blockIdx.x * 4 + wv; const int row = task >> 2, h = task & 3;
    const int b = row / SEQ; float* qs = qsm[wv];
    const bf16* qp = Q2 + (size_t)row * 512 + h * 128;
    qs[lane] = bf2f(qp[lane]); qs[lane + 64] = bf2f(qp[lane + 64]);
    __syncthreads();
    const bf16* Kb = KV2 + (size_t)b * MEM_LEN * 1024 + h * 128; const bf16* Vb = Kb + 512;
    float m = -INFINITY, l = 0.f, o[2] = {0.f, 0.f};
    for (int blk = 0; blk < 4; ++blk) attn_block<2>(qs, Kb, Vb, 1024, blk * 64 + lane, m, l, o, lane);
    const float il = 1.f / l;
    O2[(size_t)row * 512 + h * 128 + lane] = (bf16)f2bf(o[0] * il); O2[(size_t)row * 512 + h * 128 + 64 + lane] = (bf16)f2bf(o[1] * il);
}
}

extern "C" void kernel_launch(void* const* d_in, const int* in_sizes, int n_in, void* d_out, int out_size, void* d_ws, size_t ws_size, hipStream_t stream) {
    static int grid = 0;
    if (grid == 0) {
        if (n_in != 24 || in_sizes[0] != MTOK * DM || out_size != MTOK * DM || ws_size < WS_END) { fprintf(stderr, "kernel_launch: shape mismatch n_in %d in0 %d out %d ws %zu (need %zu)\n", n_in, n_in > 0 ? in_sizes[0] : -1, out_size, ws_size, (size_t)WS_END); grid = -1; return; }
        int dev = 0, cus = 0;
        if (hipGetDevice(&dev) != hipSuccess || hipDeviceGetAttribute(&cus, hipDeviceAttributeMultiprocessorCount, dev) != hipSuccess) { grid = -1; return; }
        if (hipFuncSetAttribute((const void*)mk_fwd, hipFuncAttributeMaxDynamicSharedMemorySize, LDS_BYTES) != hipSuccess) { fprintf(stderr, "kernel_launch: hipFuncSetAttribute failed\n"); grid = -1; return; }
        (void)hipGetLastError();
        grid = cus;
    }
    if (grid < 0) return;
    (void)hipMemsetAsync((char*)d_ws + WS_CTL, 0, CTL_ZERO_BYTES, stream);
    Args a{};
    a.x = (const float*)d_in[0]; a.mem = (const float*)d_in[1]; a.pos = (const int*)d_in[2];
    a.g_mix_pre = (const float*)d_in[3]; a.w_in = (const float*)d_in[4]; a.w_a = (const float*)d_in[5]; a.w_b = (const float*)d_in[6]; a.w_mix = (const float*)d_in[7];
    a.g_mix_post = (const float*)d_in[8]; a.lq1 = (const float*)d_in[9]; a.lk1 = (const float*)d_in[10]; a.lq2 = (const float*)d_in[11]; a.lk2 = (const float*)d_in[12];
    a.subln = (const float*)d_in[13]; a.g_mem_pre = (const float*)d_in[14]; a.g_mem_kv = (const float*)d_in[15]; a.w_mq = (const float*)d_in[16]; a.w_mkv = (const float*)d_in[17];
    a.w_mo = (const float*)d_in[18]; a.g_mem_post = (const float*)d_in[19]; a.g_mlp_pre = (const float*)d_in[20]; a.w_up = (const float*)d_in[21]; a.w_dn = (const float*)d_in[22];
    a.g_mlp_post = (const float*)d_in[23];
    a.out = (float*)d_out; a.ws = (unsigned char*)d_ws;
    unsigned char* ws = (unsigned char*)d_ws;
    bf16 *WIN = (bf16*)(ws + WS_WIN), *WA = (bf16*)(ws + WS_WA), *WB = (bf16*)(ws + WS_WB), *WMIX = (bf16*)(ws + WS_WMIX), *WMQ = (bf16*)(ws + WS_WMQ), *WMKV = (bf16*)(ws + WS_WMKV),
         *WMO = (bf16*)(ws + WS_WMO), *WUP = (bf16*)(ws + WS_WUP), *WDN = (bf16*)(ws + WS_WDN), *H = (bf16*)(ws + WS_H), *MB = (bf16*)(ws + WS_MB), *PROJ = (bf16*)(ws + WS_PROJ),
         *U = (bf16*)(ws + WS_U), *OA = (bf16*)(ws + WS_OA), *OBN = (bf16*)(ws + WS_OBN), *MERGED = (bf16*)(ws + WS_MERGED), *Q2 = (bf16*)(ws + WS_Q2), *KV2 = (bf16*)(ws + WS_KV2), *O2 = (bf16*)(ws + WS_O2);
    float *ROPE = (float*)(ws + WS_ROPE), *OD = (float*)(ws + WS_OD), *LSE = (float*)(ws + WS_LSE), *OBR = (float*)(ws + WS_OBR); bf16* Y = (bf16*)(ws + WS_Y); float* OBR2 = (float*)(ws + WS_Y)  ; bf16* XR = (bf16*)(ws + WS_OD);
    float* OUT = (float*)d_out;
    auto naive = [&](int k) {
        switch (k) {
        case 1: hipLaunchKernelGGL(nv::gemm<nv::EP_BF16>, dim3(D_IN / 128, MTOK / 128), dim3(256), 0, stream, H, DM, WIN, DM, (void*)PROJ, D_IN, DM, (const bf16*)nullptr, 0);
                hipLaunchKernelGGL(nv::proj_post, dim3(MTOK), dim3(256), 0, stream, PROJ, (const float*)ROPE);
                hipLaunchKernelGGL(nv::gemm<nv::EP_BF16>, dim3(1024 / 128, MROWS / 128), dim3(256), 0, stream, MB, DM, WMKV, DM, (void*)KV2, 1024, DM, (const bf16*)nullptr, 0); break;
        case 2: hipLaunchKernelGGL(nv::dil_attn, dim3(MTOK * 8 / 4), dim3(256), 0, stream, (const bf16*)PROJ, OD, LSE);
                hipLaunchKernelGGL(nv::diff_attn, dim3(MTOK * 8 / 4), dim3(256), 0, stream, (const bf16*)PROJ, OBR, a.lq1, a.lk1, a.lq2, a.lk2); break;
        case 3: hipLaunchKernelGGL(nv::thin_mix, dim3(MTOK), dim3(256), 0, stream, (const float*)OD, (const float*)LSE, (const float*)OBR, a.subln, OA, OBN); break;
        case 4: hipLaunchKernelGGL(nv::gemm<nv::EP_GATE>, dim3(DM / 128, MTOK / 128), dim3(256), 0, stream, OA, 1024, WA, 1024, (void*)MERGED, DM, 1024, (const bf16*)(PROJ + C_GA), D_IN); break;
        case 5: hipLaunchKernelGGL(nv::gemm<nv::EP_GATE_ADD>, dim3(DM / 128, MTOK / 128), dim3(256), 0, stream, OBN, 2048, WB, 2048, (void*)MERGED, DM, 2048, (const bf16*)(PROJ + C_GB), D_IN); break;
        case 6: hipLaunchKernelGGL(nv::gemm<nv::EP_BF16>, dim3(DM / 128, MTOK / 128), dim3(256), 0, stream, MERGED, DM, WMIX, DM, (void*)Y, DM, DM, (const bf16*)nullptr, 0); break;
        case 7: hipLaunchKernelGGL((nv::norm_res<false, true>), dim3(MTOK / 4), dim3(256), 0, stream, (const bf16*)Y, a.g_mix_post, (const void*)a.x, (void*)XR, a.g_mem_pre, H); break;
        case 8: hipLaunchKernelGGL(nv::gemm<nv::EP_BF16>, dim3(512 / 128, MTOK / 128), dim3(256), 0, stream, H, DM, WMQ, DM, (void*)Q2, 512, DM, (const bf16*)nullptr, 0); break;
        case 9: hipLaunchKernelGGL(nv::cross_attn, dim3(MTOK * 4 / 4), dim3(256), 0, stream, (const bf16*)Q2, (const bf16*)KV2, O2); break;
        case 10: hipLaunchKernelGGL(nv::gemm<nv::EP_BF16>, dim3(DM / 128, MTOK / 128), dim3(256), 0, stream, O2, 512, WMO, 512, (void*)Y, DM, 512, (const bf16*)nullptr, 0); break;
        case 11: hipLaunchKernelGGL((nv::norm_res<true, true>), dim3(MTOK / 4), dim3(256), 0, stream, (const bf16*)Y, a.g_mem_post, (const void*)XR, (void*)XR, a.g_mlp_pre, H); break;
        case 12: hipLaunchKernelGGL(nv::gemm<nv::EP_RELU2>, dim3(D_FF / 128, MTOK / 128), dim3(256), 0, stream, H, DM, WUP, DM, (void*)U, D_FF, DM, (const bf16*)nullptr, 0); break;
        case 13: hipLaunchKernelGGL(nv::gemm<nv::EP_BF16>, dim3(DM / 128, MTOK / 128), dim3(256), 0, stream, U, D_FF, WDN, D_FF, (void*)Y, DM, D_FF, (const bf16*)nullptr, 0); break;
        case 14: hipLaunchKernelGGL((nv::norm_res<true, false>), dim3(MTOK / 4), dim3(256), 0, stream, (const bf16*)Y, a.g_mlp_post, (const void*)XR, (void*)OUT, (const float*)nullptr, (bf16*)nullptr); break;
        default: break;
        }
    };
#ifdef MK_PROBE_DUP
    { a.ph_lo = 0; a.ph_hi = MK_PROBE_DUP + 1; a.li = 0; hipLaunchKernelGGL(mk_fwd, dim3(grid), dim3(NWAVES * 64), LDS_BYTES, stream, a);
      a.ph_lo = MK_PROBE_DUP; a.ph_hi = NPHASE; a.li = 1; hipLaunchKernelGGL(mk_fwd, dim3(grid), dim3(NWAVES * 64), LDS_BYTES, stream, a); return; }
#endif
    int li = 0;
    for (int k = 0; k < NPHASE;) {
        if ((FAST >> k) & 1u) { int e = k + 1; while (e < NPHASE && ((FAST >> e) & 1u)) ++e;
            a.ph_lo = k; a.ph_hi = e; a.li = li++; hipLaunchKernelGGL(mk_fwd, dim3(grid), dim3(NWAVES * 64), LDS_BYTES, stream, a); k = e; }
        else { naive(k); ++k; }
    }
    const hipError_t le = hipPeekAtLastError();
    if (le != hipSuccess) fprintf(stderr, "kernel_launch: launch failed: %s\n", hipGetErrorName(le));
}
```

```cpp
#include <hip/hip_runtime.h>
#include <cstdio>
#include <cstdint>

constexpr int DM = 4096, BATCH = 2, SEQ = 4096, MTOK = BATCH * SEQ;
constexpr int HD = 128;
constexpr int DIL_W = 3072, DIFF_QK = 2048, DIFF_V = 2048;
constexpr int C_QA = 0, C_KA = 3072, C_VA = 6144, C_QB = 9216, C_KB = 11264, C_VB = 13312, C_GA = 15360, C_GB = 19456, D_IN = 23552;
constexpr int MEM_LEN = 256, MROWS = BATCH * MEM_LEN, MEM_W = 512, D_FF = 16384;
constexpr float NORM_EPS = 1e-6f;
constexpr float ATT_SCALE = 0.088388347648318440f;

constexpr size_t MiB = 1u << 20;
constexpr size_t WS_CTL = 0, CTL_ZERO_BYTES = 1 * MiB;
constexpr size_t WS_ROPE = 2 * MiB;
constexpr size_t WS_SA = 6 * MiB;
constexpr size_t WS_SB = 6 * MiB + 64 * 1024;
constexpr size_t WS_SU = 6 * MiB + 128 * 1024;
constexpr size_t WS_SD = 6 * MiB + 160 * 1024, WS_WSUM = 6 * MiB + 176 * 1024;
constexpr size_t WS_SA0 = 6 * MiB + 192 * 1024, WS_SBIN = 6 * MiB + 256 * 1024;
constexpr size_t WS_SA4 = 6 * MiB + 384 * 1024, WS_SA5 = 6 * MiB + 416 * 1024, WS_SBA = 6 * MiB + 448 * 1024, WS_SBB = 6 * MiB + 464 * 1024;
constexpr size_t WS_SBMIX = 6 * MiB + 512 * 1024, WS_SAM = 6 * MiB + 544 * 1024;
constexpr int CW_UMAX = 65536;
constexpr size_t WS_WIN = 8 * MiB;
constexpr size_t WS_W8 = WS_WIN + 48 * MiB;
constexpr size_t WS_H8 = WS_WIN + 116 * MiB;
constexpr size_t WS_WA = WS_WIN + 184 * MiB;
constexpr size_t WS_WB = WS_WA + 8 * MiB;
constexpr size_t WS_WMIX = WS_WB + 16 * MiB;
constexpr size_t WS_WMQ = WS_WMIX + 32 * MiB;
constexpr size_t WS_WMKV = WS_WMQ + 4 * MiB;
constexpr size_t WS_WMO = WS_WMKV + 8 * MiB;
constexpr size_t WS_WUP = WS_WMO + 4 * MiB;
constexpr size_t WS_WDN = WS_WUP + 128 * MiB;
constexpr size_t WS_H = WS_WDN + 128 * MiB;
constexpr size_t WS_MB = WS_H + 64 * MiB;
constexpr size_t WS_PROJ = WS_MB + 4 * MiB;
constexpr size_t WS_U = WS_PROJ;
constexpr size_t WS_OD = WS_PROJ + 368 * MiB;
constexpr size_t WS_LSE = WS_OD + 96 * MiB;
constexpr size_t WS_OBR = WS_LSE + 1 * MiB;
constexpr size_t WS_DTMP = WS_OBR + 64 * MiB;
constexpr size_t WS_OA = WS_DTMP + 32 * MiB;
constexpr size_t WS_OBN = WS_OA + 16 * MiB;
constexpr size_t WS_MERGED = WS_OBN + 32 * MiB;
constexpr size_t WS_Y = WS_MERGED + 64 * MiB;
constexpr size_t WS_Q2 = WS_Y + 128 * MiB;
constexpr size_t WS_KV2 = WS_Q2 + 8 * MiB;
constexpr size_t WS_O2 = WS_KV2 + 1 * MiB;
constexpr size_t WS_END = WS_O2 + 8 * MiB;
constexpr int CW_TMO = 0, CW_CODE = 1, CW_BAR = 4096;

constexpr int RING_OFF = 0, RING_BYTES = 131072;
constexpr int LDSCTL_OFF = 133120, MISC_OFF = LDSCTL_OFF + 320;
constexpr int LDS_BYTES = 147456;
constexpr int NWAVES = 8;

#define GAS __attribute__((address_space(1)))
#define LAS __attribute__((address_space(3)))
typedef unsigned short bf16;
typedef unsigned v4u __attribute__((ext_vector_type(4)));
typedef unsigned v2u __attribute__((ext_vector_type(2)));
typedef float f32x4 __attribute__((ext_vector_type(4)));
typedef short bf16x8 __attribute__((ext_vector_type(8)));
typedef GAS unsigned gu32;
#define RLX_AGENT __ATOMIC_RELAXED, __HIP_MEMORY_SCOPE_AGENT
#define LDS_WAIT() asm volatile("s_waitcnt lgkmcnt(0)" ::: "memory")
#define VM_WAIT() asm volatile("s_waitcnt vmcnt(0)" ::: "memory")
__device__ __forceinline__ unsigned f2bf(float f) { unsigned u = __builtin_bit_cast(unsigned, f); return (u + 0x7fffu + ((u >> 16) & 1u)) >> 16; }
__device__ __forceinline__ unsigned pk2(float lo, float hi) { return f2bf(lo) | (f2bf(hi) << 16); }
__device__ __forceinline__ float bf2f(unsigned short b) { return __builtin_bit_cast(float, ((unsigned)b) << 16); }

__device__ const float INV_FREQ[64] = {
1.0f, 0.8659643233600653f, 0.7498942093324559f, 0.6493816315762113f, 0.5623413251903491f, 0.4869675251658631f, 0.4216965034285822f, 0.3651741272548377f,
0.31622776601683794f, 0.27384196342643613f, 0.23713737056616552f, 0.20535250264571459f, 0.1778279410038923f, 0.1539926526059492f, 0.1333521432163324f, 0.11547819846894582f,
0.1f, 0.08659643233600653f, 0.07498942093324558f, 0.06493816315762113f, 0.05623413251903491f, 0.04869675251658631f, 0.04216965034285822f, 0.03651741272548377f,
0.03162277660168379f, 0.027384196342643614f, 0.023713737056616554f, 0.02053525026457146f, 0.01778279410038923f, 0.01539926526059492f, 0.01333521432163324f, 0.011547819846894581f,
0.01f, 0.008659643233600653f, 0.007498942093324558f, 0.006493816315762113f, 0.005623413251903491f, 0.004869675251658631f, 0.004216965034285823f, 0.0036517412725483771f,
0.0031622776601683794f, 0.0027384196342643613f, 0.0023713737056616554f, 0.002053525026457146f, 0.0017782794100389228f, 0.001539926526059492f, 0.001333521432163324f, 0.0011547819846894581f,
0.001f, 0.0008659643233600653f, 0.0007498942093324559f, 0.0006493816315762113f, 0.0005623413251903491f, 0.0004869675251658631f, 0.00042169650342858224f, 0.00036517412725483773f,
0.00031622776601683794f, 0.00027384196342643613f, 0.00023713737056616554f, 0.00020535250264571459f, 0.00017782794100389227f, 0.0001539926526059492f, 0.0001333521432163324f, 0.00011547819846894582f };

#define XB_TMO      128
#define XB_XCNT(j)  (256  + 64 * (j))
#define XB_XSUB(j)  (1280 + 64 * (j))
#define XB_XGEN(j)  (2304 + 64 * (j))
#define XB_TOP      3328
#define XB_TOPGEN   3392
#define XCD_BAR_WORDS 3456
#define XB_SPIN_CAP (1u << 18)
__device__ __forceinline__ unsigned xb_ld(unsigned* p)              { return __hip_atomic_load(p, __ATOMIC_RELAXED, __HIP_MEMORY_SCOPE_AGENT); }
__device__ __forceinline__ unsigned xb_add(unsigned* p, unsigned v) { return __hip_atomic_fetch_add(p, v, __ATOMIC_RELAXED, __HIP_MEMORY_SCOPE_AGENT); }
__device__ __forceinline__ unsigned xb_xcc_id() { return (unsigned)__builtin_amdgcn_s_getreg((3 << 11) | 20) & 0xFu; }
#define XB_SPIN(cond, bar) do { unsigned _sp = 0; while (cond) { __builtin_amdgcn_s_sleep(1); \
    if ((++_sp & 255u) == 0u) { if (xb_ld(&(bar)[XB_TMO])) break; if (_sp > XB_SPIN_CAP) { atomicAdd(&(bar)[XB_TMO], 1u); break; } } } } while (0)
struct XcdBarrier { unsigned* bar; unsigned x; volatile LAS unsigned* st; };
__device__ __forceinline__ XcdBarrier xcd_barrier_post(unsigned* bar, volatile LAS unsigned* st) {
    XcdBarrier b; b.bar = bar; b.x = xb_xcc_id(); b.st = st;
    if (threadIdx.x == 0) (void)xb_add(&bar[XB_XCNT(b.x)], 1u);
    return b;
}
__device__ __forceinline__ void xcd_barrier_complete(unsigned* bar, unsigned x, unsigned& nloc, unsigned& nx) {
    const unsigned G = gridDim.x * gridDim.y * gridDim.z;
    unsigned sum, cnt, mine, sp = 0u;
    for (;;) {
        sum = 0u; cnt = 0u; mine = 0u;
#pragma unroll
        for (unsigned j = 0; j < 16; ++j) { const unsigned c = xb_ld(&bar[XB_XCNT(j)]); sum += c; cnt += (c > 0u) ? 1u : 0u; mine = (j == x) ? c : mine; }
        if (sum == G) break;
        __builtin_amdgcn_s_sleep(1);
        if ((++sp & 255u) == 0u) { if (xb_ld(&bar[XB_TMO])) break; if (sp > XB_SPIN_CAP) { atomicAdd(&bar[XB_TMO], 1u); break; } }
    }
    nloc = mine > 0u ? mine : 1u; nx = cnt > 0u ? cnt : 1u;
}
__device__ __forceinline__ void xcd_barrier(const XcdBarrier& b) {
    asm volatile("s_waitcnt vmcnt(0)" ::: "memory");
    __syncthreads();
    if (threadIdx.x == 0) {
        unsigned* bar = b.bar;
        __builtin_amdgcn_s_waitcnt(0);
        unsigned nloc = b.st[0], nx = b.st[1];
        if (nloc == 0u) { xcd_barrier_complete(bar, b.x, nloc, nx); b.st[0] = nloc; b.st[1] = nx; }
        const unsigned old = xb_add(&bar[XB_XSUB(b.x)], 1u);
        const unsigned gen = old / nloc;
        if (old + 1u == (gen + 1u) * nloc) {
            __builtin_amdgcn_fence(__ATOMIC_RELEASE, "agent");
            asm volatile("s_waitcnt vmcnt(0)" ::: "memory");
            const unsigned og = xb_add(&bar[XB_TOP], 1u);
            const unsigned tg = og / nx;
            if (og + 1u == (tg + 1u) * nx) xb_add(&bar[XB_TOPGEN], 1u);
            else XB_SPIN(xb_ld(&bar[XB_TOPGEN]) == tg, bar);
            __builtin_amdgcn_fence(__ATOMIC_ACQUIRE, "agent");
            xb_add(&bar[XB_XGEN(b.x)], 1u);
            asm volatile("s_waitcnt vmcnt(0)" ::: "memory");
        } else {
            XB_SPIN(xb_ld(&bar[XB_XGEN(b.x)]) == gen, bar);
            __builtin_amdgcn_fence(__ATOMIC_ACQUIRE, "agent");
            asm volatile("s_waitcnt vmcnt(0)" ::: "memory");
        }
    }
    __syncthreads();
}


namespace pg8 {
#define PG8_LAS __attribute__((address_space(3)))
typedef unsigned short bf16_t;
typedef short bf16x8 __attribute__((ext_vector_type(8)));
typedef float f32x4 __attribute__((ext_vector_type(4)));
typedef unsigned u32x4 __attribute__((ext_vector_type(4)));
typedef int i32x4 __attribute__((ext_vector_type(4)));
constexpr int BM = 256, BK = 64, HALF = 128, HTB = HALF * BK * 2, STAGE_BYTES = 8 * HTB, NXCD = 8, WGM = 8;
__host__ __device__ __forceinline__ int lds_byte(int r, int c) { const int st = (r >> 4) * 2 + (c >> 5), rr = r & 15, cc = c & 31, ob = rr * 64 + cc * 2; return st * 1024 + (ob ^ (((ob >> 9) & 1) << 5)); }
__host__ __device__ __forceinline__ void stage_rc(int b, int& R, int& C) { const int st = b / 1024, sb = b % 1024, swz = sb ^ (((sb >> 9) & 1) << 5); R = (st >> 1) * 16 + swz / 64; C = (st & 1) * 32 + (swz % 64) / 2; }
__host__ __device__ __forceinline__ int perm32(int rho) { const int n = rho >> 4, i = rho & 15; return 8 * (i >> 2) + 4 * n + (i & 3); }
struct Unit { int pm, pn; };
struct Gemm { const bf16_t* A; const bf16_t* Bt; int M, N, K, lda, ldb; int rlo = 0, ra0 = 0, ra1 = 0; };
struct StaticOrder {
    int nM, nN, nwg, G, c;
    __host__ __device__ void init(int M, int N, int G_, int c_) { nM = M / BM; nN = N / BM; nwg = nM * nN; G = G_; c = c_; }
    __host__ __device__ bool next(int i, Unit& u) const {
        const long L = (long)i * G + c; if (L >= nwg) return false;
        int wgid = (int)L; { const int q = nwg / NXCD, r = nwg % NXCD, xcd = wgid % NXCD, off = wgid / NXCD; wgid = (xcd < r ? xcd * (q + 1) : r * (q + 1) + (xcd - r) * q) + off; }
        const int nig = WGM * nN, gid = wgid / nig, fm = gid * WGM, gsz = (nM - fm) < WGM ? (nM - fm) : WGM;
        u.pm = fm + ((wgid % nig) % gsz); u.pn = (wgid % nig) / gsz; return true;
    }
    __device__ __forceinline__ void a_ready(const Unit&) const {}
    __device__ __forceinline__ void done(const Unit&) const {}
};
__device__ __forceinline__ unsigned cvt_pk_bf16(float lo, float hi) { unsigned r; asm volatile("v_cvt_pk_bf16_f32 %0, %1, %2" : "=v"(r) : "v"(lo), "v"(hi)); return r;}
struct EpiF32 {
    static constexpr bool PERM = false, AFTER_DRAIN = false, ROPEMAP = false;
    float* C; int ldc;
    __device__ __forceinline__ void operator()(const f32x4 (&acc)[2][2][4][2], const Unit& u, int wr, int wc, int fr, int fq) const {
        const int row0 = u.pm * BM + wr * 64 + fr, col0 = u.pn * BM + wc * 32 + 4 * fq;
#pragma unroll
        for (int ai = 0; ai < 2; ++ai)
#pragma unroll
            for (int m = 0; m < 4; ++m) { float* rowp = C + (size_t)(row0 + ai * HALF + m * 16) * ldc + col0;
#pragma unroll
                for (int bj = 0; bj < 2; ++bj)
#pragma unroll
                    for (int n = 0; n < 2; ++n) *(f32x4*)(rowp + bj * HALF + n * 16) = acc[ai][bj][m][n]; }
    }
};
template <int ACT  > struct EpiBf16 {
    static constexpr bool PERM = true, AFTER_DRAIN = false, ROPEMAP = false;
    bf16_t* O; int ldc;
    __device__ __forceinline__ void operator()(const f32x4 (&acc)[2][2][4][2], const Unit& u, int wr, int wc, int fr, int fq) const {
        const int row0 = u.pm * BM + wr * 64 + fr, col0 = u.pn * BM + wc * 32 + 8 * fq;
#pragma unroll
        for (int ai = 0; ai < 2; ++ai)
#pragma unroll
            for (int m = 0; m < 4; ++m) { bf16_t* rowp = O + (size_t)(row0 + ai * HALF + m * 16) * ldc + col0;
#pragma unroll
                for (int bj = 0; bj < 2; ++bj) { f32x4 v0 = acc[ai][bj][m][0], v1 = acc[ai][bj][m][1];
                    if (ACT == 1) {
#pragma unroll
                        for (int j = 0; j < 4; ++j) { const float a = fmaxf(v0[j], 0.f), b = fmaxf(v1[j], 0.f); v0[j] = a * a; v1[j] = b * b; } }
                    u32x4 w; w.x = cvt_pk_bf16(v0[0], v0[1]); w.y = cvt_pk_bf16(v0[2], v0[3]); w.z = cvt_pk_bf16(v1[0], v1[1]); w.w = cvt_pk_bf16(v1[2], v1[3]);
                    *(u32x4*)(rowp + bj * HALF) = w; } }
    }
};
struct EpiProjI8 {
    static constexpr bool PERM = true, AFTER_DRAIN = false, ROPEMAP = true;
    bf16_t* O; const float* rope; const float* sa; const float* sb;
    __device__ __forceinline__ void operator()(const f32x4 (&acc)[2][2][4][2], const Unit& u, int wr, int wc, int fr, int fq) const {
        const int row0 = u.pm * BM + wr * 64 + fr, cb = u.pn * BM + (wc >> 1) * 128, i0 = (wc & 1) * 32 + 8 * fq;
        const int kind = (u.pn < 24 || (u.pn >= 36 && u.pn < 52)) ? 1 : (u.pn >= 60 ? 2 : 0);
        const f32x4 sa0 = *(const f32x4*)(sb + cb + i0), sa1 = *(const f32x4*)(sb + cb + i0 + 4), sb0 = *(const f32x4*)(sb + cb + 64 + i0), sb1 = *(const f32x4*)(sb + cb + 64 + i0 + 4);
        float srv[8];
#pragma unroll
        for (int i = 0; i < 8; ++i) srv[i] = sa[(size_t)(row0 + (i >> 2) * HALF + (i & 3) * 16)];
#pragma unroll
        for (int am = 0; am < 4; ++am) { const int ai = am >> 1;
            f32x4 rt[4][4];
            if (kind == 1) {
#pragma unroll
                for (int m = 2 * (am & 1); m < 2 * (am & 1) + 2; ++m) { const f32x4* rp = (const f32x4*)(rope + ((size_t)(row0 + ai * HALF + m * 16) * 64 + i0) * 2); rt[m][0] = rp[0]; rt[m][1] = rp[1]; rt[m][2] = rp[2]; rt[m][3] = rp[3]; } }
#pragma unroll
            for (int m = 2 * (am & 1); m < 2 * (am & 1) + 2; ++m) { const size_t r = (size_t)(row0 + ai * HALF + m * 16); bf16_t* rowp = O + r * D_IN + cb + i0; const float sr = srv[ai * 4 + m];
                f32x4 a0 = __builtin_convertvector(__builtin_bit_cast(i32x4, acc[ai][0][m][0]), f32x4) * (sa0 * sr), a1 = __builtin_convertvector(__builtin_bit_cast(i32x4, acc[ai][0][m][1]), f32x4) * (sa1 * sr);
                f32x4 b0 = __builtin_convertvector(__builtin_bit_cast(i32x4, acc[ai][1][m][0]), f32x4) * (sb0 * sr), b1 = __builtin_convertvector(__builtin_bit_cast(i32x4, acc[ai][1][m][1]), f32x4) * (sb1 * sr);
                if (kind == 1) { const f32x4 t0 = rt[m][0], t1 = rt[m][1], t2 = rt[m][2], t3 = rt[m][3];
                    const f32x4 c0 = {t0[0], t0[2], t1[0], t1[2]}, s0 = {t0[1], t0[3], t1[1], t1[3]}, c1 = {t2[0], t2[2], t3[0], t3[2]}, s1 = {t2[1], t2[3], t3[1], t3[3]};
                    const f32x4 na0 = a0 * c0 - b0 * s0, nb0 = b0 * c0 + a0 * s0, na1 = a1 * c1 - b1 * s1, nb1 = b1 * c1 + a1 * s1;
                    a0 = na0; b0 = nb0; a1 = na1; b1 = nb1; }
                if (kind == 2) {
#pragma unroll
                    for (int j = 0; j < 4; ++j) { a0[j] = __builtin_amdgcn_rcpf(1.f + __expf(-a0[j])); a1[j] = __builtin_amdgcn_rcpf(1.f + __expf(-a1[j]));
                                                  b0[j] = __builtin_amdgcn_rcpf(1.f + __expf(-b0[j])); b1[j] = __builtin_amdgcn_rcpf(1.f + __expf(-b1[j])); } }
                u32x4 w; w.x = cvt_pk_bf16(a0[0], a0[1]); w.y = cvt_pk_bf16(a0[2], a0[3]); w.z = cvt_pk_bf16(a1[0], a1[1]); w.w = cvt_pk_bf16(a1[2], a1[3]);
                *(u32x4*)(rowp) = w;
                w.x = cvt_pk_bf16(b0[0], b0[1]); w.y = cvt_pk_bf16(b0[2], b0[3]); w.z = cvt_pk_bf16(b1[0], b1[1]); w.w = cvt_pk_bf16(b1[2], b1[3]);
                *(u32x4*)(rowp + 64) = w; } }
    }
};
typedef unsigned short u16x2 __attribute__((ext_vector_type(2)));
struct EpiI8Relu2 {
    static constexpr bool PERM = true, AFTER_DRAIN = false, ROPEMAP = false;
    bf16_t* O; int ldc; const float* sa; const float* sb; unsigned* umax;
    __device__ __forceinline__ void operator()(const f32x4 (&acc)[2][2][4][2], const Unit& u, int wr, int wc, int fr, int fq) const {
        const int row0 = u.pm * BM + wr * 64 + fr, col0 = u.pn * BM + wc * 32 + 8 * fq;
        f32x4 sbv[2][2];
#pragma unroll
        for (int bj = 0; bj < 2; ++bj) { sbv[bj][0] = *(const f32x4*)(sb + col0 + bj * HALF); sbv[bj][1] = *(const f32x4*)(sb + col0 + bj * HALF + 4); }
        float srv[8];
#pragma unroll
        for (int i = 0; i < 8; ++i) srv[i] = sa[(size_t)(row0 + (i >> 2) * HALF + (i & 3) * 16)];
#pragma unroll
        for (int ai = 0; ai < 2; ++ai)
#pragma unroll
            for (int m = 0; m < 4; ++m) { const size_t r = (size_t)(row0 + ai * HALF + m * 16); const float sr = srv[ai * 4 + m]; bf16_t* rowp = O + r * ldc + col0; u16x2 rp = {0, 0};
#pragma unroll
                for (int bj = 0; bj < 2; ++bj) {
                    f32x4 v0 = __builtin_convertvector(__builtin_bit_cast(i32x4, acc[ai][bj][m][0]), f32x4) * (sbv[bj][0] * sr);
                    f32x4 v1 = __builtin_convertvector(__builtin_bit_cast(i32x4, acc[ai][bj][m][1]), f32x4) * (sbv[bj][1] * sr);
#pragma unroll
                    for (int j = 0; j < 4; ++j) { const float a = fmaxf(v0[j], 0.f), b = fmaxf(v1[j], 0.f); v0[j] = a * a; v1[j] = b * b; }
                    u32x4 w; w.x = cvt_pk_bf16(v0[0], v0[1]); w.y = cvt_pk_bf16(v0[2], v0[3]); w.z = cvt_pk_bf16(v1[0], v1[1]); w.w = cvt_pk_bf16(v1[2], v1[3]);
                    *(u32x4*)(rowp + bj * HALF) = w;
#pragma unroll
                    for (int j = 0; j < 4; ++j) { const unsigned wj = w[j]; rp = __builtin_elementwise_max(rp, __builtin_bit_cast(u16x2, wj)); } }
                unsigned rmx = (unsigned)(rp.x > rp.y ? rp.x : rp.y) << 16;
                { const unsigned a = (unsigned)__shfl_xor((int)rmx, 16); rmx = rmx > a ? rmx : a; const unsigned b = (unsigned)__shfl_xor((int)rmx, 32); rmx = rmx > b ? rmx : b; }
                if (fq == 0) atomicMax(umax + r, rmx); }
    }
};
struct EpiI8Down {
    static constexpr bool PERM = true, AFTER_DRAIN = false, ROPEMAP = false;
    bf16_t* O; int ldc; const float* sa; const float* sb; const int* wsum;
    __device__ __forceinline__ void operator()(const f32x4 (&acc)[2][2][4][2], const Unit& u, int wr, int wc, int fr, int fq) const {
        const int row0 = u.pm * BM + wr * 64 + fr, col0 = u.pn * BM + wc * 32 + 8 * fq;
        f32x4 sbv[2][2], off[2][2];
#pragma unroll
        for (int bj = 0; bj < 2; ++bj)
#pragma unroll
            for (int n = 0; n < 2; ++n) { sbv[bj][n] = *(const f32x4*)(sb + col0 + bj * HALF + 4 * n); off[bj][n] = __builtin_convertvector(*(const i32x4*)(wsum + col0 + bj * HALF + 4 * n), f32x4) * 128.f; }
        float srv[8];
#pragma unroll
        for (int i = 0; i < 8; ++i) srv[i] = sa[(size_t)(row0 + (i >> 2) * HALF + (i & 3) * 16)];
#pragma unroll
        for (int ai = 0; ai < 2; ++ai)
#pragma unroll
            for (int m = 0; m < 4; ++m) { const size_t r = (size_t)(row0 + ai * HALF + m * 16); const float sr = srv[ai * 4 + m]; bf16_t* rowp = O + r * ldc + col0;
#pragma unroll
                for (int bj = 0; bj < 2; ++bj) {
                    const f32x4 v0 = (__builtin_convertvector(__builtin_bit_cast(i32x4, acc[ai][bj][m][0]), f32x4) + off[bj][0]) * (sbv[bj][0] * sr);
                    const f32x4 v1 = (__builtin_convertvector(__builtin_bit_cast(i32x4, acc[ai][bj][m][1]), f32x4) + off[bj][1]) * (sbv[bj][1] * sr);
                    u32x4 w; w.x = cvt_pk_bf16(v0[0], v0[1]); w.y = cvt_pk_bf16(v0[2], v0[3]); w.z = cvt_pk_bf16(v1[0], v1[1]); w.w = cvt_pk_bf16(v1[2], v1[3]);
                    *(u32x4*)(rowp + bj * HALF) = w; } }
    }
};
struct EpiI8Bf16 {
    static constexpr bool PERM = true, AFTER_DRAIN = false, ROPEMAP = false;
    bf16_t* O; int ldc; const float* sa; const float* sb;
    __device__ __forceinline__ void operator()(const f32x4 (&acc)[2][2][4][2], const Unit& u, int wr, int wc, int fr, int fq) const {
        const int row0 = u.pm * BM + wr * 64 + fr, col0 = u.pn * BM + wc * 32 + 8 * fq;
        f32x4 sbv[2][2];
#pragma unroll
        for (int bj = 0; bj < 2; ++bj) { sbv[bj][0] = *(const f32x4*)(sb + col0 + bj * HALF); sbv[bj][1] = *(const f32x4*)(sb + col0 + bj * HALF + 4); }
        float srv[8];
#pragma unroll
        for (int i = 0; i < 8; ++i) srv[i] = sa[(size_t)(row0 + (i >> 2) * HALF + (i & 3) * 16)];
#pragma unroll
        for (int ai = 0; ai < 2; ++ai)
#pragma unroll
            for (int m = 0; m < 4; ++m) { const size_t r = (size_t)(row0 + ai * HALF + m * 16); const float sr = srv[ai * 4 + m]; bf16_t* rowp = O + r * ldc + col0;
#pragma unroll
                for (int bj = 0; bj < 2; ++bj) {
                    const f32x4 v0 = __builtin_convertvector(__builtin_bit_cast(i32x4, acc[ai][bj][m][0]), f32x4) * (sbv[bj][0] * sr);
                    const f32x4 v1 = __builtin_convertvector(__builtin_bit_cast(i32x4, acc[ai][bj][m][1]), f32x4) * (sbv[bj][1] * sr);
                    u32x4 w; w.x = cvt_pk_bf16(v0[0], v0[1]); w.y = cvt_pk_bf16(v0[2], v0[3]); w.z = cvt_pk_bf16(v1[0], v1[1]); w.w = cvt_pk_bf16(v1[2], v1[3]);
                    *(u32x4*)(rowp + bj * HALF) = w; } }
    }
};
__device__ __forceinline__ float bfl(unsigned w) { return __builtin_bit_cast(float, w << 16); }
__device__ __forceinline__ float bfh(unsigned w) { return __builtin_bit_cast(float, w & 0xffff0000u); }
template <bool ADD> struct EpiGate {
    static constexpr bool PERM = true, AFTER_DRAIN = false, ROPEMAP = false;
    bf16_t* O; int ldc; const bf16_t* gate; int ldg;
    __device__ __forceinline__ void operator()(const f32x4 (&acc)[2][2][4][2], const Unit& u, int wr, int wc, int fr, int fq) const {
        const int row0 = u.pm * BM + wr * 64 + fr, col0 = u.pn * BM + wc * 32 + 8 * fq;
#pragma unroll
        for (int am = 0; am < 4; ++am) { const int ai = am >> 1;
            u32x4 gv[4][2], pv[4][2];
#pragma unroll
            for (int m = 2 * (am & 1); m < 2 * (am & 1) + 2; ++m) { const size_t r = (size_t)(row0 + ai * HALF + m * 16);
#pragma unroll
                for (int bj = 0; bj < 2; ++bj) { gv[m][bj] = *(const u32x4*)(gate + r * ldg + col0 + bj * HALF); if (ADD) pv[m][bj] = *(const u32x4*)(O + r * ldc + col0 + bj * HALF); } }
#pragma unroll
            for (int m = 2 * (am & 1); m < 2 * (am & 1) + 2; ++m) { const size_t r = (size_t)(row0 + ai * HALF + m * 16); bf16_t* rowp = O + r * ldc + col0;
#pragma unroll
                for (int bj = 0; bj < 2; ++bj) { f32x4 v0 = acc[ai][bj][m][0], v1 = acc[ai][bj][m][1];
                    const u32x4 g = gv[m][bj];
                    v0[0] *= bfl(g.x); v0[1] *= bfh(g.x); v0[2] *= bfl(g.y); v0[3] *= bfh(g.y); v1[0] *= bfl(g.z); v1[1] *= bfh(g.z); v1[2] *= bfl(g.w); v1[3] *= bfh(g.w);
                    if (ADD) { const u32x4 p = pv[m][bj];
                        v0[0] += bfl(p.x); v0[1] += bfh(p.x); v0[2] += bfl(p.y); v0[3] += bfh(p.y); v1[0] += bfl(p.z); v1[1] += bfh(p.z); v1[2] += bfl(p.w); v1[3] += bfh(p.w); }
                    u32x4 w; w.x = cvt_pk_bf16(v0[0], v0[1]); w.y = cvt_pk_bf16(v0[2], v0[3]); w.z = cvt_pk_bf16(v1[0], v1[1]); w.w = cvt_pk_bf16(v1[2], v1[3]);
                    *(u32x4*)(rowp + bj * HALF) = w; } } }
    }
};
template <bool ADD> struct EpiGateI8 {
    static constexpr bool PERM = true, AFTER_DRAIN = false, ROPEMAP = false;
    bf16_t* O; int ldc; const bf16_t* gate; int ldg; const float* sa; const float* sb;
    __device__ __forceinline__ void operator()(const f32x4 (&acc)[2][2][4][2], const Unit& u, int wr, int wc, int fr, int fq) const {
        const int row0 = u.pm * BM + wr * 64 + fr, col0 = u.pn * BM + wc * 32 + 8 * fq;
        f32x4 sbv[2][2];
#pragma unroll
        for (int bj = 0; bj < 2; ++bj) { sbv[bj][0] = *(const f32x4*)(sb + col0 + bj * HALF); sbv[bj][1] = *(const f32x4*)(sb + col0 + bj * HALF + 4); }
        float srv[8];
#pragma unroll
        for (int i = 0; i < 8; ++i) srv[i] = sa[(size_t)(row0 + (i >> 2) * HALF + (i & 3) * 16)];
#pragma unroll
        for (int ai = 0; ai < 2; ++ai) {
            u32x4 gv[4][2], pv[4][2];
#pragma unroll
            for (int m = 0; m < 4; ++m) { const size_t r = (size_t)(row0 + ai * HALF + m * 16);
#pragma unroll
                for (int bj = 0; bj < 2; ++bj) { gv[m][bj] = *(const u32x4*)(gate + r * ldg + col0 + bj * HALF); if (ADD) pv[m][bj] = *(const u32x4*)(O + r * ldc + col0 + bj * HALF); } }
#pragma unroll
            for (int m = 0; m < 4; ++m) { const size_t r = (size_t)(row0 + ai * HALF + m * 16); bf16_t* rowp = O + r * ldc + col0; const float sr = srv[ai * 4 + m];
#pragma unroll
                for (int bj = 0; bj < 2; ++bj) {
                    f32x4 v0 = __builtin_convertvector(__builtin_bit_cast(i32x4, acc[ai][bj][m][0]), f32x4) * (sbv[bj][0] * sr);
                    f32x4 v1 = __builtin_convertvector(__builtin_bit_cast(i32x4, acc[ai][bj][m][1]), f32x4) * (sbv[bj][1] * sr);
                    const u32x4 g = gv[m][bj];
                    v0[0] *= bfl(g.x); v0[1] *= bfh(g.x); v0[2] *= bfl(g.y); v0[3] *= bfh(g.y); v1[0] *= bfl(g.z); v1[1] *= bfh(g.z); v1[2] *= bfl(g.w); v1[3] *= bfh(g.w);
                    if (ADD) { const u32x4 p = pv[m][bj];
                        v0[0] += bfl(p.x); v0[1] += bfh(p.x); v0[2] += bfl(p.y); v0[3] += bfh(p.y); v1[0] += bfl(p.z); v1[1] += bfh(p.z); v1[2] += bfl(p.w); v1[3] += bfh(p.w); }
                    u32x4 w; w.x = cvt_pk_bf16(v0[0], v0[1]); w.y = cvt_pk_bf16(v0[2], v0[3]); w.z = cvt_pk_bf16(v1[0], v1[1]); w.w = cvt_pk_bf16(v1[2], v1[3]);
                    *(u32x4*)(rowp + bj * HALF) = w; } } }
    }
};
template <bool NOROPE = false> struct EpiProj {
    static constexpr bool PERM = true, AFTER_DRAIN = false, ROPEMAP = true;
    bf16_t* O; const float* rope; float sc;
    __device__ __forceinline__ void operator()(const f32x4 (&acc)[2][2][4][2], const Unit& u, int wr, int wc, int fr, int fq) const {
        const int row0 = u.pm * BM + wr * 64 + fr, cb = u.pn * BM + (wc >> 1) * 128, i0 = (wc & 1) * 32 + 8 * fq;
        const int kind = NOROPE ? (u.pn >= 60 ? 2 : 0) : ((u.pn < 24 || (u.pn >= 36 && u.pn < 52)) ? 1 : (u.pn >= 60 ? 2 : 0));
#pragma unroll
        for (int am = 0; am < 4; ++am) { const int ai = am >> 1;
            f32x4 rt[4][4];
            if (!NOROPE && kind == 1) {
#pragma unroll
                for (int m = 2 * (am & 1); m < 2 * (am & 1) + 2; ++m) { const f32x4* rp = (const f32x4*)(rope + ((size_t)(row0 + ai * HALF + m * 16) * 64 + i0) * 2); rt[m][0] = rp[0]; rt[m][1] = rp[1]; rt[m][2] = rp[2]; rt[m][3] = rp[3]; } }
#pragma unroll
            for (int m = 2 * (am & 1); m < 2 * (am & 1) + 2; ++m) { const size_t r = (size_t)(row0 + ai * HALF + m * 16); bf16_t* rowp = O + r * D_IN + cb + i0;
                f32x4 a0 = acc[ai][0][m][0] * sc, a1 = acc[ai][0][m][1] * sc, b0 = acc[ai][1][m][0] * sc, b1 = acc[ai][1][m][1] * sc;
                if (!NOROPE && kind == 1) { const f32x4 t0 = rt[m][0], t1 = rt[m][1], t2 = rt[m][2], t3 = rt[m][3];
                    const f32x4 c0 = {t0[0], t0[2], t1[0], t1[2]}, s0 = {t0[1], t0[3], t1[1], t1[3]}, c1 = {t2[0], t2[2], t3[0], t3[2]}, s1 = {t2[1], t2[3], t3[1], t3[3]};
                    const f32x4 na0 = a0 * c0 - b0 * s0, nb0 = b0 * c0 + a0 * s0, na1 = a1 * c1 - b1 * s1, nb1 = b1 * c1 + a1 * s1;
                    a0 = na0; b0 = nb0; a1 = na1; b1 = nb1; }
                if (kind == 2) {
#pragma unroll
                    for (int j = 0; j < 4; ++j) { a0[j] = __builtin_amdgcn_rcpf(1.f + __expf(-a0[j])); a1[j] = __builtin_amdgcn_rcpf(1.f + __expf(-a1[j]));
                                                  b0[j] = __builtin_amdgcn_rcpf(1.f + __expf(-b0[j])); b1[j] = __builtin_amdgcn_rcpf(1.f + __expf(-b1[j])); } }
                u32x4 w; w.x = cvt_pk_bf16(a0[0], a0[1]); w.y = cvt_pk_bf16(a0[2], a0[3]); w.z = cvt_pk_bf16(a1[0], a1[1]); w.w = cvt_pk_bf16(a1[2], a1[3]);
                *(u32x4*)(rowp) = w;
                w.x = cvt_pk_bf16(b0[0], b0[1]); w.y = cvt_pk_bf16(b0[2], b0[3]); w.z = cvt_pk_bf16(b1[0], b1[1]); w.w = cvt_pk_bf16(b1[2], b1[3]);
                *(u32x4*)(rowp + 64) = w; } }
    }
};

typedef int i32x8 __attribute__((ext_vector_type(8)));
typedef float f32x8 __attribute__((ext_vector_type(8)));
template <class Epi, class Sched, bool ALIGN_EPI = false, bool SP2 = false, bool FP8 = false, bool I8 = false>
__device__ __forceinline__ void gemm_phase(PG8_LAS unsigned char* lds, const Gemm g, const Sched& S, const Epi& E) {
    int tid = threadIdx.x; asm volatile("" : "+v"(tid));
    const int wid = __builtin_amdgcn_readfirstlane(tid >> 6), lane = tid & 63, wr = wid >> 2, wc = wid & 3, fr = lane & 15, fq = lane >> 4;
    constexpr int ESZ = (FP8 || I8) ? 1 : 2;
    const int K = g.K, nt = K / ((FP8 || I8) ? 2 * BK : BK);
    unsigned voffA[2], voffB[2];
#pragma unroll
    for (int i = 0; i < 2; ++i) { int R, C; stage_rc(tid * 16 + i * 8192, R, C); int Rb = Epi::PERM ? ((R & ~31) + perm32(R & 31)) : R;
        if (Epi::ROPEMAP) Rb = (Rb >> 6) * 128 + (Rb & 63);
        voffA[i] = (unsigned)(R * g.lda * ESZ + C * 2); voffB[i] = (unsigned)(Rb * g.ldb * ESZ + C * 2); }
    const size_t kstep = (size_t)(BK * 2);
    const size_t hstepA = (size_t)HALF * g.lda * ESZ, hstepB = (size_t)(Epi::ROPEMAP ? 64 : HALF) * g.ldb * ESZ;
    const size_t tstepA = (size_t)BM * g.lda * ESZ, tstepB = (size_t)BM * g.ldb * ESZ;
    const unsigned ldsw = (unsigned)wid * 1024u;
    const int aoff = lds_byte(wr * 64 + fr, fq * 8), boff = lds_byte(wc * 32 + fr, fq * 8);
#define PG8_SA(b, h) (((b) * 2 + (h)) * HTB)
#define PG8_SB(b, h) ((4 + (b) * 2 + (h)) * HTB)
#define PG8_STAGE(bufoff, gbase, voff) do { if constexpr (FP8) { int t_ = tid; asm volatile("" : "+v"(t_));     \
            _Pragma("unroll") for (int _i = 0; _i < 2; ++_i) { int R_, C_; stage_rc(t_ * 16 + _i * 8192, R_, C_); int Rb_ = ((&(voff)[0] == &voffB[0]) && Epi::PERM) ? ((R_ & ~31) + perm32(R_ & 31)) : R_; \
                if ((&(voff)[0] == &voffB[0]) && Epi::ROPEMAP) Rb_ = (Rb_ >> 6) * 128 + (Rb_ & 63); const unsigned o_ = (unsigned)(Rb_ * ((&(voff)[0] == &voffB[0]) ? g.ldb : g.lda) * ESZ + C_ * 2); \
                __builtin_amdgcn_global_load_lds((const unsigned*)((const char*)(gbase) + o_), (PG8_LAS unsigned*)(lds + (bufoff) + ldsw + _i * 8192), 16, 0, 0); } } \
        else { _Pragma("unroll") for (int _i = 0; _i < 2; ++_i) \
        __builtin_amdgcn_global_load_lds((const unsigned*)((const char*)(gbase) + (voff)[_i]), (PG8_LAS unsigned*)(lds + (bufoff) + ldsw + _i * 8192), 16, 0, 0); } } while (0)
#define PG8_LD8(X) __builtin_shufflevector(__builtin_bit_cast(f32x4, X[0]), __builtin_bit_cast(f32x4, X[1]), 0, 1, 2, 3, 4, 5, 6, 7)
#define PG8_LDA(dst, b, h) do { _Pragma("unroll") for (int m = 0; m < 4; ++m) _Pragma("unroll") for (int k = 0; k < 2; ++k) dst[m][k] = *(const PG8_LAS bf16x8*)(lds + PG8_SA(b, h) + aoff + m * 2048 + k * 1024); \
        if constexpr (FP8) { _Pragma("unroll") for (int m = 0; m < 4; ++m) dst##8[m] = PG8_LD8(dst[m]); } } while (0)
#define PG8_LDB(dst, b, h) do { _Pragma("unroll") for (int n = 0; n < 2; ++n) _Pragma("unroll") for (int k = 0; k < 2; ++k) dst[n][k] = *(const PG8_LAS bf16x8*)(lds + PG8_SB(b, h) + boff + n * 2048 + k * 1024); \
        if constexpr (FP8) { _Pragma("unroll") for (int n = 0; n < 2; ++n) dst##8[n] = PG8_LD8(dst[n]); } } while (0)
#define PG8_MMA(ai, bj, At, Bt) do { __builtin_amdgcn_s_setprio(1); _Pragma("unroll") for (int m = 0; m < 4; ++m) _Pragma("unroll") for (int n = 0; n < 2; ++n) { \
        if constexpr (FP8) acc[ai][bj][m][n] = __builtin_amdgcn_mfma_scale_f32_16x16x128_f8f6f4(__builtin_bit_cast(i32x8, Bt##8[n]), __builtin_bit_cast(i32x8, At##8[m]), acc[ai][bj][m][n], 0, 0, 0, 0, 0, 0); \
        else if constexpr (I8) { _Pragma("unroll") for (int k = 0; k < 2; ++k) acc[ai][bj][m][n] = __builtin_bit_cast(f32x4, __builtin_amdgcn_mfma_i32_16x16x64_i8(__builtin_bit_cast(i32x4, Bt[n][k]), __builtin_bit_cast(i32x4, At[m][k]), __builtin_bit_cast(i32x4, acc[ai][bj][m][n]), 0, 0, 0)); } \
        else { _Pragma("unroll") for (int k = 0; k < 2; ++k) acc[ai][bj][m][n] = __builtin_amdgcn_mfma_f32_16x16x32_bf16(Bt[n][k], At[m][k], acc[ai][bj][m][n], 0, 0, 0); } } __builtin_amdgcn_s_setprio(0); } while (0)
#define PG8_WAIT_V(n) asm volatile("s_waitcnt vmcnt(" #n ")" ::: "memory")
#define PG8_WAIT_L(n) asm volatile("s_waitcnt lgkmcnt(" #n ")" ::: "memory")
#define PG8_BAR __builtin_amdgcn_s_barrier()
#define PG8_SCHED __builtin_amdgcn_sched_barrier(0)
    Unit cur, nxt; int ui = 0;
    if (!S.next(0, cur)) return;
    f32x4 acc[2][2][4][2];
#pragma unroll
    for (int a = 0; a < 2; ++a)
#pragma unroll
        for (int b = 0; b < 2; ++b)
#pragma unroll
            for (int m = 0; m < 4; ++m)
#pragma unroll
                for (int n = 0; n < 2; ++n) acc[a][b][m][n] = (f32x4){0.f, 0.f, 0.f, 0.f};
    bf16x8 At[4][2], B0[2][2], B1[2][2]; f32x8 At8[4], B08[2], B18[2];
    const char* cA = (const char*)g.A + (size_t)cur.pm * tstepA; const char* cB = (const char*)g.Bt + (size_t)cur.pn * tstepB;
    S.a_ready(cur);
    if constexpr (SP2) {
        PG8_STAGE(PG8_SB(0, 0), cB, voffB); PG8_STAGE(PG8_SB(0, 1), cB + hstepB, voffB); PG8_STAGE(PG8_SA(0, 0), cA, voffA); PG8_STAGE(PG8_SA(0, 1), cA + hstepA, voffA);
        if (wr == 1) PG8_BAR;
        PG8_WAIT_V(2); PG8_BAR;
        PG8_STAGE(PG8_SB(1, 0), cB + kstep, voffB); PG8_STAGE(PG8_SA(1, 0), cA + kstep, voffA); PG8_STAGE(PG8_SB(1, 1), cB + hstepB + kstep, voffB);
        PG8_WAIT_V(6); PG8_BAR;
    } else {
        PG8_STAGE(PG8_SB(0, 0), cB, voffB); PG8_STAGE(PG8_SA(0, 0), cA, voffA); PG8_STAGE(PG8_SB(0, 1), cB + hstepB, voffB); PG8_STAGE(PG8_SA(0, 1), cA + hstepA, voffA);
        if (wr == 1) PG8_BAR;
        PG8_WAIT_V(4); PG8_BAR;
        PG8_STAGE(PG8_SB(1, 0), cB + kstep, voffB); PG8_STAGE(PG8_SA(1, 0), cA + kstep, voffA); PG8_STAGE(PG8_SB(1, 1), cB + hstepB + kstep, voffB);
        PG8_WAIT_V(6); PG8_BAR;
    }
    for (;;) {
        const bool has_next = S.next(ui + 1, nxt);
        const char* nA = has_next ? (const char*)g.A + (size_t)nxt.pm * tstepA : cA; const char* nB = has_next ? (const char*)g.Bt + (size_t)nxt.pn * tstepB : cB;
        for (int t = 0; t < nt; t += 2) {
            const bool last = (t == nt - 2);
            const char* a1 = cA + (size_t)(t + 1) * kstep;
            const char* a2 = last ? nA : cA + (size_t)(t + 2) * kstep; const char* b2 = last ? nB : cB + (size_t)(t + 2) * kstep;
            const char* a3 = a2 + kstep; const char* b3 = b2 + kstep;
            if (last && has_next) S.a_ready(nxt);
            if constexpr (SP2) {
            PG8_LDB(B0, 0, 0); PG8_LDB(B1, 0, 1); PG8_SCHED; PG8_LDA(At, 0, 0); PG8_STAGE(PG8_SA(1, 1), a1 + hstepA, voffA);
            PG8_WAIT_V(8); PG8_WAIT_L(0); PG8_BAR; PG8_MMA(0, 0, At, B0); PG8_MMA(0, 1, At, B1); PG8_BAR; PG8_SCHED;
            PG8_LDA(At, 0, 1); PG8_STAGE(PG8_SB(0, 0), b2, voffB); PG8_STAGE(PG8_SB(0, 1), b2 + hstepB, voffB); PG8_STAGE(PG8_SA(0, 0), a2, voffA);
            PG8_WAIT_V(8); PG8_WAIT_L(0); PG8_BAR; PG8_MMA(1, 0, At, B0); PG8_MMA(1, 1, At, B1); PG8_BAR; PG8_SCHED;
            PG8_LDB(B0, 1, 0); PG8_LDB(B1, 1, 1); PG8_SCHED; PG8_LDA(At, 1, 0); PG8_STAGE(PG8_SA(0, 1), a2 + hstepA, voffA);
            PG8_WAIT_V(8); PG8_WAIT_L(0); PG8_BAR; PG8_MMA(0, 0, At, B0); PG8_MMA(0, 1, At, B1); PG8_BAR; PG8_SCHED;
            PG8_LDA(At, 1, 1); PG8_STAGE(PG8_SB(1, 0), b3, voffB); PG8_STAGE(PG8_SB(1, 1), b3 + hstepB, voffB); PG8_STAGE(PG8_SA(1, 0), a3, voffA);
            PG8_WAIT_V(8); PG8_WAIT_L(0); PG8_BAR; PG8_MMA(1, 0, At, B0); PG8_MMA(1, 1, At, B1); PG8_BAR; PG8_SCHED;
            } else {
            PG8_LDB(B0, 0, 0); PG8_SCHED; PG8_LDA(At, 0, 0); PG8_STAGE(PG8_SA(1, 1), a1 + hstepA, voffA);
            PG8_WAIT_L(8); PG8_BAR; PG8_WAIT_L(0); PG8_MMA(0, 0, At, B0); PG8_BAR; PG8_SCHED;
            PG8_LDB(B1, 0, 1); PG8_STAGE(PG8_SB(0, 0), b2, voffB);
            PG8_BAR; PG8_WAIT_L(0); PG8_MMA(0, 1, At, B1); PG8_BAR;
            PG8_LDA(At, 0, 1); PG8_STAGE(PG8_SA(0, 0), a2, voffA);
            PG8_BAR; PG8_WAIT_L(0); PG8_MMA(1, 0, At, B0); PG8_BAR; PG8_SCHED;
            PG8_STAGE(PG8_SB(0, 1), b2 + hstepB, voffB);
            PG8_WAIT_V(6); PG8_BAR; PG8_MMA(1, 1, At, B1); PG8_BAR;
            PG8_LDB(B0, 1, 0); PG8_SCHED; PG8_LDA(At, 1, 0); PG8_STAGE(PG8_SA(0, 1), a2 + hstepA, voffA);
            PG8_WAIT_L(8); PG8_BAR; PG8_WAIT_L(0); PG8_MMA(0, 0, At, B0); PG8_BAR; PG8_SCHED;
            PG8_LDB(B1, 1, 1); PG8_STAGE(PG8_SB(1, 0), b3, voffB);
            PG8_BAR; PG8_WAIT_L(0); PG8_MMA(0, 1, At, B1); PG8_BAR;
            PG8_LDA(At, 1, 1); PG8_STAGE(PG8_SA(1, 0), a3, voffA);
            PG8_BAR; PG8_WAIT_L(0); PG8_MMA(1, 0, At, B0); PG8_BAR; PG8_SCHED;
            PG8_STAGE(PG8_SB(1, 1), b3 + hstepB, voffB);
            PG8_WAIT_V(6); PG8_BAR; PG8_MMA(1, 1, At, B1); PG8_BAR;
            }
        }
        if constexpr (ALIGN_EPI) { if (wr == 0) PG8_BAR; }
        { Unit eu = cur; eu.pn += (cur.pn < g.rlo) ? g.ra0 : g.ra1; int le = lane; asm volatile("" : "+v"(le));
          E(acc, eu, wr, wc, le & 15, le >> 4); } S.done(cur);
        if (!has_next) break;
#pragma unroll
        for (int a = 0; a < 2; ++a)
#pragma unroll
            for (int b = 0; b < 2; ++b)
#pragma unroll
                for (int m = 0; m < 4; ++m)
#pragma unroll
                    for (int n = 0; n < 2; ++n) acc[a][b][m][n] = (f32x4){0.f, 0.f, 0.f, 0.f};
        cur = nxt; cA = nA; cB = nB; ++ui;
        if constexpr (ALIGN_EPI) { if (wr == 1) PG8_BAR; }
    }
    PG8_WAIT_V(0);
    if constexpr (!ALIGN_EPI) { if (wr == 0) PG8_BAR; }
    PG8_BAR;
#undef PG8_SA
#undef PG8_SB
#undef PG8_STAGE
#undef PG8_LDA
#undef PG8_LDB
#undef PG8_MMA
#undef PG8_LD8
#undef PG8_WAIT_V
#undef PG8_WAIT_L
#undef PG8_BAR
#undef PG8_SCHED
}
}


namespace att {
constexpr int D = 128, NW = 8, QBLK = 32, KVBLK = 64;
constexpr float SCALE = 0.088388347648318440f;
constexpr float THR = 8.f;
constexpr float NEG_BIG = -1.2676506002282294e30f;
constexpr size_t SHM_V = KVBLK * D * 2, SHM_K = KVBLK * D * 2, SHM_Q = 2 * SHM_V + 2 * SHM_K + NW * 64 * 4  , SHM_ATTN = SHM_Q + NW * 8192;
using bf16x8 = __attribute__((ext_vector_type(8))) short;
using s16x4  = __attribute__((ext_vector_type(4))) short;
using f32x16 = __attribute__((ext_vector_type(16))) float;
using u32x4  = __attribute__((ext_vector_type(4))) unsigned;
#define KSWZ(row, colB) ((row) * 256 + ((colB) ^ (((row) & 7) << 4)))
#define SBAR() __builtin_amdgcn_sched_barrier(0)
__device__ __forceinline__ int crow(int r, int hi) { return (r & 3) + 8 * (r >> 2) + 4 * hi; }
__device__ __forceinline__ unsigned cvtpk(float lo, float hi) { unsigned r; asm volatile("v_cvt_pk_bf16_f32 %0, %1, %2" : "=v"(r) : "v"(lo), "v"(hi)); return r; }
__device__ __forceinline__ void partialSM(f32x16& p0, f32x16& p1, float& m_reg, float& mn, float& alpha) {
  constexpr float C = SCALE * 1.4426950408889634f;
  float pmax = p0[0]; for (int r = 1; r < 16; ++r) pmax = fmaxf(pmax, p0[r]); for (int r = 0; r < 16; ++r) pmax = fmaxf(pmax, p1[r]);
  { auto rr = __builtin_amdgcn_permlane32_swap(__float_as_uint(pmax), __float_as_uint(pmax), false, false);
    pmax = fmaxf(__uint_as_float(rr[0]), __uint_as_float(rr[1])); }
  if (__builtin_expect(__all(pmax - m_reg <= THR / SCALE), 1)) { mn = m_reg; alpha = 1.f; }
  else { mn = fmaxf(m_reg, pmax); alpha = __builtin_amdgcn_exp2f((m_reg - mn) * C); m_reg = mn; }
  float mnC = -mn * C;
  for (int r = 0; r < 16; ++r) p0[r] = fmaf(p0[r], C, mnC); for (int r = 0; r < 16; ++r) p1[r] = fmaf(p1[r], C, mnC);
  for (int r = 0; r < 16; ++r) p0[r] = __builtin_amdgcn_exp2f(p0[r]);
}
__device__ __forceinline__ void bandmask(f32x16& p0, f32x16& p1, int kt0, int qi, int hi) {
#pragma unroll
  for (int r = 0; r < 16; ++r) { const int d0 = kt0 + crow(r, hi) - qi, d1 = d0 + 32;
    p0[r] = (d0 > 64 || d0 < -64) ? NEG_BIG : p0[r]; p1[r] = (d1 > 64 || d1 < -64) ? NEG_BIG : p1[r]; }
}
__device__ __forceinline__ void finishSM(f32x16& p0, f32x16& p1, float alpha, float& l_reg, bf16x8& pa0, bf16x8& pa1, bf16x8& pa2, bf16x8& pa3) {
  for (int r = 0; r < 16; ++r) p1[r] = __builtin_amdgcn_exp2f(p1[r]);
  float ps = 0; for (int r = 0; r < 16; ++r) ps += p0[r]; for (int r = 0; r < 16; ++r) ps += p1[r];
  { auto rr = __builtin_amdgcn_permlane32_swap(__float_as_uint(ps), __float_as_uint(ps), false, false);
    ps = __uint_as_float(rr[0]) + __uint_as_float(rr[1]); }
  l_reg = l_reg * alpha + ps;
#define PK4(P, BASE, OUT) do { unsigned a0 = cvtpk(P[BASE + 0], P[BASE + 1]), a1 = cvtpk(P[BASE + 2], P[BASE + 3]);   \
    unsigned b0 = cvtpk(P[BASE + 4], P[BASE + 5]), b1 = cvtpk(P[BASE + 6], P[BASE + 7]);                              \
    auto r0 = __builtin_amdgcn_permlane32_swap(a0, b0, false, false); auto r1 = __builtin_amdgcn_permlane32_swap(a1, b1, false, false); \
    u32x4 w = {r0[0], r1[0], r0[1], r1[1]}; OUT = *reinterpret_cast<bf16x8*>(&w); } while (0)
  PK4(p0, 0, pa0); PK4(p0, 8, pa1); PK4(p1, 0, pa2); PK4(p1, 8, pa3);
#undef PK4
}
template <bool QREG>
__device__ __forceinline__ void qkt(f32x16& p0, f32x16& p1, const bf16* Ks, const char* qs, const bf16x8* qv, int r32, int hi) {
  p0 = f32x16{}; p1 = f32x16{};
#pragma unroll
  for (int d0 = 0; d0 < 8; ++d0) { int cb = (d0 * 16 + hi * 8) * 2;
    bf16x8 b0 = *reinterpret_cast<const bf16x8*>((const char*)Ks + KSWZ(r32, cb));
    bf16x8 b1 = *reinterpret_cast<const bf16x8*>((const char*)Ks + KSWZ(32 + r32, cb));
    bf16x8 q; if (QREG) q = qv[d0]; else q = *reinterpret_cast<const bf16x8*>(qs + d0 * 1024);
    p0 = __builtin_amdgcn_mfma_f32_32x32x16_bf16(b0, q, p0, 0, 0, 0);
    p1 = __builtin_amdgcn_mfma_f32_32x32x16_bf16(b1, q, p1, 0, 0, 0); }
}
__device__ __forceinline__ int v_st(int k, int c) { const int kk = (k & ~0xC) | ((k & 4) << 1) | ((k & 8) >> 1); return ((kk >> 3) * 4 + (c >> 5)) * 512 + ((kk & 7) * 32 + (c & 31)) * 2; }
__device__ __forceinline__ int v_rd_base(int lane) { return ((lane & 3) << 3) | (((lane >> 2) & 3) << 6) | (((lane >> 4) & 1) << 5) | (((lane >> 5) & 1) << 8); }
constexpr int v_rd_off(int d0, int ks, int half) { return d0 * 512 + ks * 4096 + half * 2048; }
template <int OFF> __device__ __forceinline__ s16x4 tr_read(int vb) {
  s16x4 r; asm volatile("ds_read_b64_tr_b16 %0, %1 offset:%2" : "=&v"(r) : "v"(vb), "i"(OFF) : "memory"); return r;
}
template <int D0> __device__ __forceinline__ void pv_one(f32x16& od, int vb, bf16x8 pa0, bf16x8 pa1, bf16x8 pa2, bf16x8 pa3) {
  const s16x4 l0 = tr_read<v_rd_off(D0, 0, 0)>(vb), h0 = tr_read<v_rd_off(D0, 0, 1)>(vb), l1 = tr_read<v_rd_off(D0, 1, 0)>(vb), h1 = tr_read<v_rd_off(D0, 1, 1)>(vb);
  const s16x4 l2 = tr_read<v_rd_off(D0, 2, 0)>(vb), h2 = tr_read<v_rd_off(D0, 2, 1)>(vb), l3 = tr_read<v_rd_off(D0, 3, 0)>(vb), h3 = tr_read<v_rd_off(D0, 3, 1)>(vb);
  asm volatile("s_waitcnt lgkmcnt(0)" ::: "memory"); SBAR();
#define PK(L, H) (bf16x8){L[0], L[1], L[2], L[3], H[0], H[1], H[2], H[3]}
  od = __builtin_amdgcn_mfma_f32_32x32x16_bf16(pa0, PK(l0, h0), od, 0, 0, 0);
  od = __builtin_amdgcn_mfma_f32_32x32x16_bf16(pa1, PK(l1, h1), od, 0, 0, 0);
  od = __builtin_amdgcn_mfma_f32_32x32x16_bf16(pa2, PK(l2, h2), od, 0, 0, 0);
  od = __builtin_amdgcn_mfma_f32_32x32x16_bf16(pa3, PK(l3, h3), od, 0, 0, 0);
#undef PK
}
__device__ __forceinline__ void pv_d0(f32x16* o, int vb, bf16x8 pa0, bf16x8 pa1, bf16x8 pa2, bf16x8 pa3) {
  pv_one<0>(o[0], vb, pa0, pa1, pa2, pa3); pv_one<1>(o[1], vb, pa0, pa1, pa2, pa3); pv_one<2>(o[2], vb, pa0, pa1, pa2, pa3); pv_one<3>(o[3], vb, pa0, pa1, pa2, pa3);
}
template <bool BAND, bool QREG>
__device__ __forceinline__ void body(const bf16* __restrict__ Qb, long ldq, const bf16* __restrict__ Kh, const bf16* __restrict__ Vh, long ldk, int NT, int qrel,
                                     char* lds, f32x16 (&o)[4], float& m_reg, float& l_reg) {
  const int tid = threadIdx.x, wid = tid >> 6, lane = tid & 63, r32 = lane & 31, hi = lane >> 5;
  bf16* V_lds = (bf16*)lds; bf16* K_lds = (bf16*)(lds + 2 * SHM_V);
  float* ws = (float*)(lds + 2 * SHM_V + 2 * SHM_K) + wid * 64; float* al_l = ws + 32;
  m_reg = NEG_BIG; l_reg = 0;
#pragma unroll
  for (int d = 0; d < 4; ++d) o[d] = f32x16{};
  char* qr = lds + SHM_Q + wid * 8192 + lane * 16;
  bf16x8 qv[8];
  { int tq = tid; asm volatile("" : "+v"(tq));
    const unsigned qo = (unsigned)((((tq >> 6) << 5) | (tq & 31)) * (int)ldq + ((tq >> 5) & 1) * 8) * 2u;
#pragma unroll
    for (int d0 = 0; d0 < 8; ++d0) { const bf16x8 t = *reinterpret_cast<const bf16x8*>((const char*)Qb + qo + d0 * 32); if (QREG) qv[d0] = t; else *reinterpret_cast<bf16x8*>(qr + d0 * 1024) = t; } }
  const int qi = qrel + wid * QBLK + r32;
  const int sr = tid >> 4, sc = (tid & 15) * 8, vst0 = v_st(sr, sc), vst1 = v_st(32 + sr, sc);
  const int vb0 = (int)(uintptr_t)V_lds + v_rd_base(lane);
  const unsigned ko0 = (unsigned)(sr * (int)ldk + sc) * 2u, ko1 = ko0 + (unsigned)(64 * (int)ldk);
  struct { bf16x8 vs0, vs1, ks0, ks1; } sr_[2];
#define SLOAD(i, k0) do { const long _t = (long)(k0) * ldk * 2; const char* _kt = (const char*)Kh + _t; const char* _vt = (const char*)Vh + _t; \
    sr_[i].vs0 = *reinterpret_cast<const bf16x8*>(_vt + ko0); sr_[i].vs1 = *reinterpret_cast<const bf16x8*>(_vt + ko1); \
    sr_[i].ks0 = *reinterpret_cast<const bf16x8*>(_kt + ko0); sr_[i].ks1 = *reinterpret_cast<const bf16x8*>(_kt + ko1); } while (0)
#define SWRITE(b, i) do { *(bf16x8*)((char*)V_lds + (b) * SHM_V + vst0) = sr_[i].vs0;          \
    *(bf16x8*)((char*)V_lds + (b) * SHM_V + vst1) = sr_[i].vs1; int kc = sc * 2;               \
    *(bf16x8*)((char*)K_lds + (b) * SHM_K + KSWZ(sr, kc)) = sr_[i].ks0;                       \
    *(bf16x8*)((char*)K_lds + (b) * SHM_K + KSWZ(32 + sr, kc)) = sr_[i].ks1; } while (0)
#define SWAIT() asm volatile("s_waitcnt vmcnt(4)" ::: "memory")
#define RESC(a) do { if (__any((a) < 1.f)) { if (hi == 0) al_l[r32] = (a); asm volatile("s_waitcnt lgkmcnt(0)" ::: "memory"); \
    for (int d = 0; d < 4; ++d) for (int r = 0; r < 16; ++r) o[d][r] *= al_l[crow(r, hi)]; } } while (0)
  f32x16 pA0, pA1, pB0, pB1; float mnA, mnB, alA, alB; bf16x8 pa0, pa1, pa2, pa3;
  constexpr int SE = 0, SO = 1;
  SLOAD(SE, 0); asm volatile("s_waitcnt vmcnt(0)" ::: "memory"); SWRITE(0, SE); __syncthreads();
  qkt<QREG>(pA0, pA1, K_lds, qr, qv, r32, hi); if (BAND) bandmask(pA0, pA1, 0, qi, hi); partialSM(pA0, pA1, m_reg, mnA, alA);
  SLOAD(SO, KVBLK); if (2 < NT) SLOAD(SE, 2 * KVBLK);
  SWAIT(); SWRITE(1, SO); __syncthreads();
  for (int j = 1; j + 1 < NT; j += 2) {
    SBAR(); qkt<QREG>(pB0, pB1, (bf16*)((char*)K_lds + SHM_K), qr, qv, r32, hi); if (BAND) bandmask(pB0, pB1, 64 * j, qi, hi);
    finishSM(pA0, pA1, alA, l_reg, pa0, pa1, pa2, pa3); SBAR();
    SLOAD(SO, (j + 2) * KVBLK); SBAR();
    pv_d0(o, vb0, pa0, pa1, pa2, pa3); partialSM(pB0, pB1, m_reg, mnB, alB);
    __syncthreads(); SWAIT(); SWRITE(0, SE);
    RESC(alB); __syncthreads();
    SBAR(); qkt<QREG>(pA0, pA1, K_lds, qr, qv, r32, hi); if (BAND) bandmask(pA0, pA1, 64 * (j + 1), qi, hi);
    finishSM(pB0, pB1, alB, l_reg, pa0, pa1, pa2, pa3); SBAR();
    if (j + 3 < NT) SLOAD(SE, (j + 3) * KVBLK); SBAR();
    pv_d0(o, vb0 + (int)SHM_V, pa0, pa1, pa2, pa3); partialSM(pA0, pA1, m_reg, mnA, alA);
    __syncthreads(); SWAIT(); SWRITE(1, SO);
    RESC(alA); __syncthreads();
  }
  SBAR(); qkt<QREG>(pB0, pB1, (bf16*)((char*)K_lds + SHM_K), qr, qv, r32, hi); if (BAND) bandmask(pB0, pB1, 64 * (NT - 1), qi, hi);
  finishSM(pA0, pA1, alA, l_reg, pa0, pa1, pa2, pa3); SBAR();
  pv_d0(o, vb0, pa0, pa1, pa2, pa3); partialSM(pB0, pB1, m_reg, mnB, alB);
  __syncthreads(); RESC(alB);
  finishSM(pB0, pB1, alB, l_reg, pa0, pa1, pa2, pa3); SBAR();
  pv_d0(o, vb0 + (int)SHM_V, pa0, pa1, pa2, pa3);
#undef SLOAD
#undef SWRITE
#undef SWAIT
#undef RESC
}

struct VFrag { s16x4 l0, h0, l1, h1, l2, h2, l3, h3; };
template <int D> __device__ __forceinline__ void vf_load(VFrag& f, int vb) {
  constexpr int B = (D >> 2) * 16384 + (D & 3) * 512;
  f.l0 = tr_read<B + 0 * 4096>(vb); f.h0 = tr_read<B + 0 * 4096 + 2048>(vb); f.l1 = tr_read<B + 1 * 4096>(vb); f.h1 = tr_read<B + 1 * 4096 + 2048>(vb);
  f.l2 = tr_read<B + 2 * 4096>(vb); f.h2 = tr_read<B + 2 * 4096 + 2048>(vb); f.l3 = tr_read<B + 3 * 4096>(vb); f.h3 = tr_read<B + 3 * 4096 + 2048>(vb);
}
__device__ __forceinline__ void vf_mma(f32x16& od, const VFrag& f, bf16x8 pa0, bf16x8 pa1, bf16x8 pa2, bf16x8 pa3) {
#define PK(L, H) (bf16x8){L[0], L[1], L[2], L[3], H[0], H[1], H[2], H[3]}
  od = __builtin_amdgcn_mfma_f32_32x32x16_bf16(pa0, PK(f.l0, f.h0), od, 0, 0, 0);
  od = __builtin_amdgcn_mfma_f32_32x32x16_bf16(pa1, PK(f.l1, f.h1), od, 0, 0, 0);
  od = __builtin_amdgcn_mfma_f32_32x32x16_bf16(pa2, PK(f.l2, f.h2), od, 0, 0, 0);
  od = __builtin_amdgcn_mfma_f32_32x32x16_bf16(pa3, PK(f.l3, f.h3), od, 0, 0, 0);
#undef PK
}
__device__ __forceinline__ void pv_wide(f32x16* o, int vb, bf16x8 pa0, bf16x8 pa1, bf16x8 pa2, bf16x8 pa3) {
  VFrag A, B;
#define VW(n) do { asm volatile("s_waitcnt lgkmcnt(" #n ")" ::: "memory"); SBAR(); } while (0)
  vf_load<0>(A, vb);
  vf_load<1>(B, vb); VW(8); vf_mma(o[0], A, pa0, pa1, pa2, pa3); SBAR();
  vf_load<2>(A, vb); VW(8); vf_mma(o[1], B, pa0, pa1, pa2, pa3); SBAR();
  vf_load<3>(B, vb); VW(8); vf_mma(o[2], A, pa0, pa1, pa2, pa3); SBAR();
  vf_load<4>(A, vb); VW(8); vf_mma(o[3], B, pa0, pa1, pa2, pa3); SBAR();
  vf_load<5>(B, vb); VW(8); vf_mma(o[4], A, pa0, pa1, pa2, pa3); SBAR();
  vf_load<6>(A, vb); VW(8); vf_mma(o[5], B, pa0, pa1, pa2, pa3); SBAR();
  vf_load<7>(B, vb); VW(8); vf_mma(o[6], A, pa0, pa1, pa2, pa3); SBAR();
  VW(0); vf_mma(o[7], B, pa0, pa1, pa2, pa3);
#undef VW
}
constexpr int DP_K = 0, DP_V = 32768, DP_P = 98304, DP_X = 131072;
#define DP_BAR() do { asm volatile("s_waitcnt vmcnt(0) lgkmcnt(0)" ::: "memory"); __builtin_amdgcn_s_barrier(); asm volatile("" ::: "memory"); } while (0)
__device__ __forceinline__ void diff_pass(const bf16* __restrict__ Qb, const bf16* __restrict__ Kh, const bf16* __restrict__ Vh, int ld, int NT, char* lds, bf16* Ob, int pfq) {
  int tid = threadIdx.x; asm volatile("" : "+v"(tid));
  const int wid = __builtin_amdgcn_readfirstlane(tid >> 6), lane = tid & 63, r32 = lane & 31, hi = lane >> 5, g = wid & 3;
  const bool prod = wid < 4;
  unsigned koff[2], voff[4];
#pragma unroll
  for (int i = 0; i < 2; ++i) { const int p = wid * 2 + i, row = p * 4 + (lane >> 4), cpos = (lane & 15) * 16; koff[i] = (unsigned)(row * ld * 2 + (cpos ^ ((row & 7) << 4))); }
#pragma unroll
  for (int i = 0; i < 4; ++i) { const int p = wid * 4 + i, hf = p >> 4, sub = (p & 15) * 2 + (lane >> 5), kk = (sub >> 2) * 8 + ((lane & 31) >> 2);
    const int k = (kk & ~0xC) | ((kk & 4) << 1) | ((kk & 8) >> 1), col = hf * 128 + (sub & 3) * 32 + (lane & 3) * 8; voff[i] = (unsigned)(k * ld * 2 + col * 2); }
  const long tstep = (long)64 * ld * 2;
  typedef __attribute__((address_space(3))) unsigned lds_u32;
#define DP_DMA_K(t, b) do { const char* _s = (const char*)Kh + (long)(t) * tstep; _Pragma("unroll") for (int _i = 0; _i < 2; ++_i) \
    __builtin_amdgcn_global_load_lds((const unsigned*)(_s + koff[_i]), (lds_u32*)(lds + DP_K + (b) * 16384 + (wid * 2 + _i) * 1024), 16, 0, 0); } while (0)
#define DP_DMA_V(t, b) do { const char* _s = (const char*)Vh + (long)(t) * tstep; _Pragma("unroll") for (int _i = 0; _i < 4; ++_i) \
    __builtin_amdgcn_global_load_lds((const unsigned*)(_s + voff[_i]), (lds_u32*)(lds + DP_V + (b) * 32768 + (wid * 4 + _i) * 1024), 16, 0, 0); } while (0)
  float* xg = (float*)(lds + DP_X) + g * 64;
  char* pg = lds + DP_P + g * 4096 + lane * 16;
  DP_DMA_K(0, 0); DP_DMA_V(0, 0); DP_DMA_K(1, 1);
#define DP_ISSUE(s) do { if ((s) + 2 < NT) DP_DMA_K((s) + 2, (s) & 1); if ((s) + 1 < NT) DP_DMA_V((s) + 1, ((s) + 1) & 1); } while (0)
  const int pl = 12 * pfq + lane; const unsigned pfo = pl < 128 ? (unsigned)((pl >> 1) * ld * 2 + (pl & 1) * 128) : (unsigned)(((pl - 128) >> 2) * ld * 2 + ((pl - 128) & 3) * 128);
  const char* pfb = pl < 128 ? (const char*)Kh : (const char*)Vh;
#define DP_PF(s) do { if (lane < 12) { const int _t = ((s) + 4 < NT) ? (s) + 4 : NT - 1; \
    __builtin_amdgcn_global_load_lds((const unsigned*)(pfb + (long)_t * tstep + pfo), (lds_u32*)(lds + 143360), 4, 0, 0); } } while (0)
#define DP_BAR1() do { asm volatile("s_waitcnt vmcnt(1) lgkmcnt(0)" ::: "memory"); __builtin_amdgcn_s_barrier(); asm volatile("" ::: "memory"); } while (0)
  if (prod) {
    float m_reg = NEG_BIG, l_reg = 0.f; bf16x8 qv[8];
    { const unsigned qo = (unsigned)((g * 32 + r32) * ld + hi * 8) * 2u;
#pragma unroll
      for (int d0 = 0; d0 < 8; ++d0) qv[d0] = *reinterpret_cast<const bf16x8*>((const char*)Qb + qo + d0 * 32); }
    DP_BAR();
#define DP_SCORE(j) do { f32x16 p0, p1; float mn, al; bf16x8 pa0, pa1, pa2, pa3; \
    qkt<true>(p0, p1, (const bf16*)(lds + DP_K + ((j) & 1) * 16384), nullptr, qv, r32, hi); partialSM(p0, p1, m_reg, mn, al); finishSM(p0, p1, al, l_reg, pa0, pa1, pa2, pa3); \
    char* _p = pg + ((j) & 1) * 16384; *reinterpret_cast<bf16x8*>(_p) = pa0; *reinterpret_cast<bf16x8*>(_p + 1024) = pa1; *reinterpret_cast<bf16x8*>(_p + 2048) = pa2; *reinterpret_cast<bf16x8*>(_p + 3072) = pa3; \
    float* _x = xg + ((j) & 1) * 256; const bool _any = __any(al < 1.f); if (hi == 0) _x[r32] = al; if (lane == 0) _x[32] = _any ? 1.f : 0.f; } while (0)
    DP_SCORE(0);
    DP_BAR();
    for (int s = 0; s < NT; ++s) { DP_ISSUE(s); if (s + 1 < NT) DP_SCORE(s + 1); DP_BAR(); }
    if (hi == 0) xg[r32] = l_reg;
    DP_BAR();
  } else {
    f32x16 o[8];
#pragma unroll
    for (int d = 0; d < 8; ++d) o[d] = f32x16{};
    DP_BAR();
    DP_BAR();
    for (int s = 0; s < NT; ++s) {
      DP_ISSUE(s); if (wid == 7) DP_PF(s);
      const float* x = xg + (s & 1) * 256;
      if (__builtin_amdgcn_readfirstlane(__float_as_int(x[32])) != 0) {
#pragma unroll
        for (int r = 0; r < 16; ++r) { const float a = x[crow(r, hi)];
#pragma unroll
          for (int d = 0; d < 8; ++d) o[d][r] *= a; } }
      const char* p = pg + (s & 1) * 16384;
      const bf16x8 pa0 = *reinterpret_cast<const bf16x8*>(p), pa1 = *reinterpret_cast<const bf16x8*>(p + 1024), pa2 = *reinterpret_cast<const bf16x8*>(p + 2048), pa3 = *reinterpret_cast<const bf16x8*>(p + 3072);
      const int vb = (int)(uintptr_t)(lds + DP_V + (s & 1) * 32768) + v_rd_base(lane);
      asm volatile("s_waitcnt lgkmcnt(0)" ::: "memory"); SBAR();
      pv_wide(o, vb, pa0, pa1, pa2, pa3);
      if (wid == 7) DP_BAR1(); else DP_BAR();
    }
    DP_BAR();
    bf16* Ow = Ob + (size_t)(g * 32) * 2048 + r32;
#pragma unroll
    for (int r = 0; r < 16; ++r) { const float il = __builtin_amdgcn_rcpf(xg[crow(r, hi)]); bf16* pr = Ow + (size_t)crow(r, hi) * 2048;
#pragma unroll
      for (int d = 0; d < 8; ++d) pr[d * 32] = (bf16)f2bf(o[d][r] * il); }
  }
  DP_BAR();
#undef DP_ISSUE
#undef DP_PF
#undef DP_BAR1
#undef DP_DMA_K
#undef DP_DMA_V
#undef DP_SCORE
}
__device__ __forceinline__ void row_recip(char* lds, float l_reg, float (&rli)[16]) {
  const int tid = threadIdx.x, wid = tid >> 6, lane = tid & 63, r32 = lane & 31, hi = lane >> 5;
  float* li_l = (float*)(lds + 2 * SHM_V + 2 * SHM_K) + wid * 64;
  if (hi == 0) li_l[r32] = l_reg; asm volatile("s_waitcnt lgkmcnt(0)" ::: "memory");
#pragma unroll
  for (int r = 0; r < 16; ++r) rli[r] = __builtin_amdgcn_rcpf(li_l[crow(r, hi)]);
  asm volatile("s_waitcnt lgkmcnt(0)" ::: "memory");
}
#undef KSWZ
}

struct Args {
    const float* x; const float* mem; const int* pos;
    const float *g_mix_pre, *w_in, *w_a, *w_b, *w_mix, *g_mix_post, *lq1, *lk1, *lq2, *lk2, *subln;
    const float *g_mem_pre, *g_mem_kv, *w_mq, *w_mkv, *w_mo, *g_mem_post, *g_mlp_pre, *w_up, *w_dn, *g_mlp_post;
    float* out; unsigned char* ws; int ph_lo, ph_hi, li, pad;
};
struct Frame {
    LAS unsigned char* lds; volatile LAS unsigned* MISC; gu32* ctl;
    int tid, lane, wave, vcu, G;
};
__device__ __forceinline__ float wave_sum(float v) {
#pragma unroll
    for (int o = 1; o < 64; o <<= 1) v += __shfl_xor(v, o);
    return v;
}
__device__ __forceinline__ float wave_max(float v) {
#pragma unroll
    for (int o = 1; o < 64; o <<= 1) v = fmaxf(v, __shfl_xor(v, o));
    return v;
}
__device__ __forceinline__ void p0_transpose_cols(const float* W, int K, int N, int scol, bf16* WT, int drow, LAS float* scr, int kb, int lane);
__device__ __forceinline__ void p0_transpose_item(const float* W, int K, int N, bf16* WT, LAS float* scr, int item, int lane) {
    const int nblk = N / 32, kb = item / nblk, nb = item % nblk, k0 = 64 * kb, n0 = 32 * nb;
    const int lr = lane >> 3, lc = (lane & 7) * 4;
    const GAS float* src = (const GAS float*)W + (size_t)(k0 + lr) * N + n0 + lc;
    f32x4 v[8];
#pragma unroll
    for (int i = 0; i < 8; ++i) v[i] = __builtin_nontemporal_load((const GAS f32x4*)(src + (size_t)(8 * i) * N));
#pragma unroll
    for (int i = 0; i < 8; ++i) { LAS float* d = scr + (8 * i + lr) * 33 + lc; d[0] = v[i].x; d[1] = v[i].y; d[2] = v[i].z; d[3] = v[i].w; }
    LDS_WAIT(); asm volatile("" ::: "memory");
    const int c = lane & 7;
#pragma unroll
    for (int j = 0; j < 4; ++j) { const int n = (lane >> 3) + 8 * j; const LAS float* s = scr + (8 * c) * 33 + n;
        v4u o; o.x = pk2(s[0 * 33], s[1 * 33]); o.y = pk2(s[2 * 33], s[3 * 33]); o.z = pk2(s[4 * 33], s[5 * 33]); o.w = pk2(s[6 * 33], s[7 * 33]);
        __builtin_nontemporal_store(o, (GAS v4u*)(WT + (size_t)(n0 + n) * K + k0 + 8 * c)); }
    LDS_WAIT(); asm volatile("" ::: "memory");
}
__device__ __forceinline__ void p0_transpose_cols(const float* W, int K, int N, int scol, bf16* WT, int drow, LAS float* scr, int kb, int lane) {
    const int k0 = 64 * kb;
    const int lr = lane >> 3, lc = (lane & 7) * 4;
    const GAS float* src = (const GAS float*)W + (size_t)(k0 + lr) * N + scol + lc;
    f32x4 v[8];
#pragma unroll
    for (int i = 0; i < 8; ++i) v[i] = __builtin_nontemporal_load((const GAS f32x4*)(src + (size_t)(8 * i) * N));
#pragma unroll
    for (int i = 0; i < 8; ++i) { LAS float* d = scr + (8 * i + lr) * 33 + lc; d[0] = v[i].x; d[1] = v[i].y; d[2] = v[i].z; d[3] = v[i].w; }
    LDS_WAIT(); asm volatile("" ::: "memory");
    const int c = lane & 7;
#pragma unroll
    for (int j = 0; j < 4; ++j) { const int n = (lane >> 3) + 8 * j; const LAS float* s = scr + (8 * c) * 33 + n;
        v4u o; o.x = pk2(s[0 * 33], s[1 * 33]); o.y = pk2(s[2 * 33], s[3 * 33]); o.z = pk2(s[4 * 33], s[5 * 33]); o.w = pk2(s[6 * 33], s[7 * 33]);
        __builtin_nontemporal_store(o, (GAS v4u*)(WT + (size_t)(drow + n) * K + k0 + 8 * c)); }
    LDS_WAIT(); asm volatile("" ::: "memory");
}
__device__ __forceinline__ unsigned pk4_fp8(float a, float b, float c, float d) { int w = 0; w = __builtin_amdgcn_cvt_pk_fp8_f32(a, b, w, false); w = __builtin_amdgcn_cvt_pk_fp8_f32(c, d, w, true); return (unsigned)w; }
__device__ __forceinline__ void p0_transpose_item_fp8(const float* W, int K, int N, int ncol0, unsigned char* W8, int row0, float scale, LAS float* scr, int kb, int nb, int lane) {
    const int k0 = 64 * kb, n0 = 32 * nb;
    const int lr = lane >> 3, lc = (lane & 7) * 4;
    const GAS float* src = (const GAS float*)W + (size_t)(k0 + lr) * N + ncol0 + n0 + lc;
    f32x4 v[8];
#pragma unroll
    for (int i = 0; i < 8; ++i) v[i] = __builtin_nontemporal_load((const GAS f32x4*)(src + (size_t)(8 * i) * N));
#pragma unroll
    for (int i = 0; i < 8; ++i) { LAS float* d = scr + (8 * i + lr) * 33 + lc; d[0] = v[i].x; d[1] = v[i].y; d[2] = v[i].z; d[3] = v[i].w; }
    LDS_WAIT(); asm volatile("" ::: "memory");
    const int c = lane & 7;
#pragma unroll
    for (int j = 0; j < 4; ++j) { const int n = (lane >> 3) + 8 * j; const LAS float* s = scr + (8 * c) * 33 + n;
        v2u o; o.x = pk4_fp8(s[0 * 33] * scale, s[1 * 33] * scale, s[2 * 33] * scale, s[3 * 33] * scale); o.y = pk4_fp8(s[4 * 33] * scale, s[5 * 33] * scale, s[6 * 33] * scale, s[7 * 33] * scale);
        __builtin_nontemporal_store(o, (GAS v2u*)(W8 + (size_t)(row0 + n0 + n) * K + k0 + 8 * c)); }
    LDS_WAIT(); asm volatile("" ::: "memory");
}
__device__ __forceinline__ void rms_row_to_bf16(const float* xrow, const float* g, bf16* orow, int lane, unsigned char* o8row = nullptr) {
    const GAS f32x4* xr = (const GAS f32x4*)xrow + lane; const GAS f32x4* gr = (const GAS f32x4*)g + lane;
    f32x4 v[16]; float s = 0.f;
#pragma unroll
    for (int j = 0; j < 16; ++j) { v[j] = __builtin_nontemporal_load(xr + 64 * j); s += (v[j].x * v[j].x + v[j].y * v[j].y) + (v[j].z * v[j].z + v[j].w * v[j].w); }
    const float rstd = 1.f / sqrtf(wave_sum(s) * (1.f / DM) + NORM_EPS);
    GAS v2u* o8 = (GAS v2u*)orow + lane;
#pragma unroll
    for (int j = 0; j < 16; ++j) { const f32x4 gg = gr[64 * j]; const f32x4 y = {v[j].x * rstd * gg.x, v[j].y * rstd * gg.y, v[j].z * rstd * gg.z, v[j].w * rstd * gg.w};
        v2u o; o.x = pk2(y.x, y.y); o.y = pk2(y.z, y.w); o8[64 * j] = o;
        if (o8row) ((GAS unsigned*)o8row + lane)[64 * j] = pk4_fp8(y.x, y.y, y.z, y.w); }
}
__device__ __forceinline__ void rms_row_to_i8(const float* xrow, const float* g, unsigned char* qrow, float* scale, int lane, bf16* hrow = nullptr) {
    const GAS f32x4* xr = (const GAS f32x4*)xrow + lane; const GAS f32x4* gr = (const GAS f32x4*)g + lane;
    f32x4 v[16]; float s = 0.f;
#pragma unroll
    for (int j = 0; j < 16; ++j) { v[j] = __builtin_nontemporal_load(xr + 64 * j); s += (v[j].x * v[j].x + v[j].y * v[j].y) + (v[j].z * v[j].z + v[j].w * v[j].w); }
    const float rstd = 1.f / sqrtf(wave_sum(s) * (1.f / DM) + NORM_EPS); float am = 0.f;
#pragma unroll
    for (int j = 0; j < 16; ++j) { const f32x4 gg = gr[64 * j]; v[j].x *= rstd * gg.x; v[j].y *= rstd * gg.y; v[j].z *= rstd * gg.z; v[j].w *= rstd * gg.w;
        am = fmaxf(fmaxf(am, fmaxf(fabsf(v[j].x), fabsf(v[j].y))), fmaxf(fabsf(v[j].z), fabsf(v[j].w))); }
    am = wave_max(am); const float inv = am > 0.f ? 127.f / am : 0.f;
    if (lane == 0) *scale = am * (1.f / 127.f);
    GAS unsigned* o4 = (GAS unsigned*)qrow + lane;
#pragma unroll
    for (int j = 0; j < 16; ++j) { const int a = (int)__builtin_rintf(v[j].x * inv), b = (int)__builtin_rintf(v[j].y * inv), c = (int)__builtin_rintf(v[j].z * inv), d = (int)__builtin_rintf(v[j].w * inv);
        o4[64 * j] = (unsigned)(a & 255) | ((unsigned)(b & 255) << 8) | ((unsigned)(c & 255) << 16) | ((unsigned)d << 24);
        if (hrow) { v2u o; o.x = pk2(v[j].x, v[j].y); o.y = pk2(v[j].z, v[j].w); ((GAS v2u*)hrow + lane)[64 * j] = o; } }
}
__device__ __forceinline__ void unpack4(const v2u w, f32x4& v) { v.x = __builtin_bit_cast(float, w.x << 16); v.y = __builtin_bit_cast(float, w.x & 0xffff0000u); v.z = __builtin_bit_cast(float, w.y << 16); v.w = __builtin_bit_cast(float, w.y & 0xffff0000u); }
template <bool BB, bool OB>
__device__ __forceinline__ void norm_res_row(const bf16* yrow, const float* g1, const void* brow, void* orow, const float* g2, bf16* hrow, int lane, unsigned char* q8row = nullptr, float* qscale = nullptr) {
    const GAS v2u* yr = (const GAS v2u*)yrow + lane; const GAS f32x4* gr = (const GAS f32x4*)g1 + lane;
    f32x4 v[16]; float s = 0.f;
    v2u yw[16], bw[BB ? 16 : 1]; f32x4 bf[BB ? 1 : 16];
#pragma unroll
    for (int j = 0; j < 16; ++j) yw[j] = __builtin_nontemporal_load(yr + 64 * j);
#pragma unroll
    for (int j = 0; j < 16; ++j) { if (BB) bw[j] = __builtin_nontemporal_load((const GAS v2u*)brow + lane + 64 * j); else bf[j] = __builtin_nontemporal_load((const GAS f32x4*)brow + lane + 64 * j); }
#pragma unroll
    for (int j = 0; j < 16; ++j) { unpack4(yw[j], v[j]); s += (v[j].x * v[j].x + v[j].y * v[j].y) + (v[j].z * v[j].z + v[j].w * v[j].w); }
    const float rstd = 1.f / sqrtf(wave_sum(s) * (1.f / DM) + NORM_EPS);
    float s2 = 0.f;
#pragma unroll
    for (int j = 0; j < 16; ++j) { const f32x4 gg = gr[64 * j]; f32x4 bb;
        if (BB) unpack4(bw[j], bb); else bb = bf[j];
        v[j] = bb + v[j] * rstd * gg;
        if (OB) { v2u o; o.x = pk2(v[j].x, v[j].y); o.y = pk2(v[j].z, v[j].w); ((GAS v2u*)orow + lane)[64 * j] = o; unpack4(o, v[j]); }
        else __builtin_nontemporal_store(v[j], (GAS f32x4*)orow + lane + 64 * j);
        s2 += (v[j].x * v[j].x + v[j].y * v[j].y) + (v[j].z * v[j].z + v[j].w * v[j].w); }
    if (g2) {
        const float rstd2 = 1.f / sqrtf(wave_sum(s2) * (1.f / DM) + NORM_EPS);
        const GAS f32x4* g2r = (const GAS f32x4*)g2 + lane;
        if (q8row) {
            float am = 0.f;
#pragma unroll
            for (int j = 0; j < 16; ++j) { const f32x4 gg = g2r[64 * j]; v[j].x *= rstd2 * gg.x; v[j].y *= rstd2 * gg.y; v[j].z *= rstd2 * gg.z; v[j].w *= rstd2 * gg.w;
                am = fmaxf(fmaxf(am, fmaxf(fabsf(v[j].x), fabsf(v[j].y))), fmaxf(fabsf(v[j].z), fabsf(v[j].w))); }
            am = wave_max(am); const float inv = am > 0.f ? 127.f / am : 0.f;
            if (lane == 0) *qscale = am * (1.f / 127.f);
            GAS unsigned* o4 = (GAS unsigned*)q8row + lane;
#pragma unroll
            for (int j = 0; j < 16; ++j) { const int a = (int)__builtin_rintf(v[j].x * inv), b = (int)__builtin_rintf(v[j].y * inv), c = (int)__builtin_rintf(v[j].z * inv), d = (int)__builtin_rintf(v[j].w * inv);
                o4[64 * j] = (unsigned)(a & 255) | ((unsigned)(b & 255) << 8) | ((unsigned)(c & 255) << 16) | ((unsigned)d << 24); }
        } else {
            GAS v2u* o8 = (GAS v2u*)hrow + lane;
#pragma unroll
            for (int j = 0; j < 16; ++j) { const f32x4 gg = g2r[64 * j]; v2u o; o.x = pk2(v[j].x * rstd2 * gg.x, v[j].y * rstd2 * gg.y); o.y = pk2(v[j].z * rstd2 * gg.z, v[j].w * rstd2 * gg.w); o8[64 * j] = o; }
        }
    }
}
__device__ __forceinline__ void quant_row_wdn(const bf16* xrow, unsigned char* qrow, float* scale, int* rsum, int lane) {
    float am = 0.f;
    for (int sgm = 0; sgm < D_FF / DM; ++sgm) { const GAS v4u* xr = (const GAS v4u*)(xrow + sgm * DM) + lane;
#pragma unroll
        for (int i = 0; i < 8; ++i) { const v4u w = xr[64 * i];
#pragma unroll
            for (int j = 0; j < 4; ++j) am = fmaxf(am, fmaxf(fabsf(__builtin_bit_cast(float, w[j] << 16)), fabsf(__builtin_bit_cast(float, w[j] & 0xffff0000u)))); } }
    am = wave_max(am); const float inv = am > 0.f ? 127.f / am : 0.f; int sum = 0;
    for (int sgm = 0; sgm < D_FF / DM; ++sgm) { const GAS v4u* xr = (const GAS v4u*)(xrow + sgm * DM) + lane; GAS v2u* o = (GAS v2u*)(qrow + sgm * DM) + lane;
#pragma unroll
        for (int i = 0; i < 8; ++i) { const v4u w = xr[64 * i]; unsigned q[8];
#pragma unroll
            for (int j = 0; j < 4; ++j) { const int a = (int)__builtin_rintf(__builtin_bit_cast(float, w[j] << 16) * inv), b = (int)__builtin_rintf(__builtin_bit_cast(float, w[j] & 0xffff0000u) * inv); sum += a + b; q[2 * j] = (unsigned)a & 255u; q[2 * j + 1] = (unsigned)b & 255u; }
            v2u ov; ov.x = q[0] | (q[1] << 8) | (q[2] << 16) | (q[3] << 24); ov.y = q[4] | (q[5] << 8) | (q[6] << 16) | (q[7] << 24); o[64 * i] = ov; } }
#pragma unroll
    for (int o = 1; o < 64; o <<= 1) sum += __shfl_xor(sum, o);
    if (lane == 0) { *scale = am * (1.f / 127.f); *rsum = sum; }
}
template <int NCH = 8>
__device__ __forceinline__ void quant_row_bf16_i8(const bf16* xrow, unsigned char* qrow, float* scale, int lane) {
    const GAS v4u* xr = (const GAS v4u*)xrow + lane; v4u w[NCH]; float am = 0.f;
#pragma unroll
    for (int i = 0; i < NCH; ++i) { w[i] = xr[64 * i];
#pragma unroll
        for (int j = 0; j < 4; ++j) am = fmaxf(am, fmaxf(fabsf(__builtin_bit_cast(float, w[i][j] << 16)), fabsf(__builtin_bit_cast(float, w[i][j] & 0xffff0000u)))); }
    am = wave_max(am); const float inv = am > 0.f ? 127.f / am : 0.f;
    if (lane == 0) *scale = am * (1.f / 127.f);
    GAS v2u* o = (GAS v2u*)qrow + lane;
#pragma unroll
    for (int i = 0; i < NCH; ++i) { unsigned q[8];
#pragma unroll
        for (int j = 0; j < 4; ++j) { q[2 * j] = (unsigned)((int)__builtin_rintf(__builtin_bit_cast(float, w[i][j] << 16) * inv)) & 255u; q[2 * j + 1] = (unsigned)((int)__builtin_rintf(__builtin_bit_cast(float, w[i][j] & 0xffff0000u) * inv)) & 255u; }
        v2u ov; ov.x = q[0] | (q[1] << 8) | (q[2] << 16) | (q[3] << 24); ov.y = q[4] | (q[5] << 8) | (q[6] << 16) | (q[7] << 24); o[64 * i] = ov; }
}

template <bool SPLITK>
__device__ __forceinline__ void colblock32_i8(const float* W, int N, int c0, int k0, unsigned char* qrows, int qpitch, float* scales, LAS unsigned char* img, int tid_,
                                              unsigned* gmax = nullptr, unsigned* gcnt = nullptr, int* gsum = nullptr) {
    int tid = tid_; asm volatile("" : "+v"(tid));
    const int w = tid >> 6, l = tid & 63, g = l & 7, s = w * 8 + (l >> 3);
    LAS unsigned* red = (LAS unsigned*)(img + 131072);
    if (tid < 64) red[tid] = 0u;
    const unsigned voff = (unsigned)((4 * s) * N + 4 * g) * 4u;
    const size_t rowB = (size_t)N * 4;
    const char* pb = (const char*)(W + (size_t)k0 * N + c0);
    unsigned d[16][8]; float mx[4] = {0.f, 0.f, 0.f, 0.f};
    f32x4 v[3][4];
#define CB_LOAD(b) do { _Pragma("unroll") for (int i = 0; i < 4; ++i) v[(b) % 3][i] = __builtin_nontemporal_load((const GAS f32x4*)(pb + (size_t)i * rowB + voff)); pb += 256 * rowB; } while (0)
    CB_LOAD(0); CB_LOAD(1);
#pragma unroll
    for (int j = 0; j < 16; ++j) {
        if (j + 2 < 16) CB_LOAD(j + 2);
#pragma unroll
        for (int q = 0; q < 4; ++q) { const float a0 = v[j % 3][0][q], a1 = v[j % 3][1][q], a2 = v[j % 3][2][q], a3 = v[j % 3][3][q];
            d[j][2 * q] = att::cvtpk(a0, a1); d[j][2 * q + 1] = att::cvtpk(a2, a3);
            mx[q] = fmaxf(fmaxf(mx[q], fmaxf(fabsf(a0), fabsf(a1))), fmaxf(fabsf(a2), fabsf(a3))); }
        __builtin_amdgcn_sched_barrier(0);
    }
#undef CB_LOAD
    __syncthreads();
#pragma unroll
    for (int q = 0; q < 4; ++q) __hip_atomic_fetch_max(red + 4 * g + q, __builtin_bit_cast(unsigned, mx[q]), __ATOMIC_RELAXED, __HIP_MEMORY_SCOPE_WORKGROUP);
    __syncthreads();
    if constexpr (SPLITK) {
        if (tid < 64) {
            if (tid < 32) __hip_atomic_fetch_max(gmax + tid, red[tid], __ATOMIC_RELAXED, __HIP_MEMORY_SCOPE_AGENT);
            __builtin_amdgcn_fence(__ATOMIC_RELEASE, "agent");
            if (tid == 0) { __hip_atomic_fetch_add(gcnt, 1u, __ATOMIC_RELEASE, __HIP_MEMORY_SCOPE_AGENT);
                while (__hip_atomic_load(gcnt, __ATOMIC_ACQUIRE, __HIP_MEMORY_SCOPE_AGENT) < 4u) __builtin_amdgcn_s_sleep(2); }
            __builtin_amdgcn_fence(__ATOMIC_ACQUIRE, "agent");
            if (tid < 32) red[tid] = __hip_atomic_load(gmax + tid, __ATOMIC_RELAXED, __HIP_MEMORY_SCOPE_AGENT); }
        __syncthreads();
    }
    float inv[4];
#pragma unroll
    for (int q = 0; q < 4; ++q) { float m = __builtin_bit_cast(float, red[4 * g + q]);
        m = __builtin_bit_cast(float, f2bf(m) << 16);
        inv[q] = m > 0.f ? 127.f / m : 0.f;
        if (s == 0 && k0 == 0) scales[4 * g + q] = m * (1.f / 127.f); }
    LAS unsigned char* wb = img + (4 * g) * 4096 + (((s >> 2) ^ g) << 4) + ((s & 3) << 2);
    int sq[4] = {0, 0, 0, 0};
#pragma unroll
    for (int j = 0; j < 16; ++j)
#pragma unroll
        for (int q = 0; q < 4; ++q) { const unsigned p0 = d[j][2 * q], p1 = d[j][2 * q + 1];
            const int i0 = (int)__builtin_rintf(__builtin_bit_cast(float, p0 << 16) * inv[q]), i1 = (int)__builtin_rintf(__builtin_bit_cast(float, p0 & 0xffff0000u) * inv[q]);
            const int i2 = (int)__builtin_rintf(__builtin_bit_cast(float, p1 << 16) * inv[q]), i3 = (int)__builtin_rintf(__builtin_bit_cast(float, p1 & 0xffff0000u) * inv[q]);
            if constexpr (SPLITK) sq[q] += (i0 + i1) + (i2 + i3);
            *(LAS unsigned*)(wb + q * 4096 + j * 256) = ((unsigned)i0 & 255u) | (((unsigned)i1 & 255u) << 8) | (((unsigned)i2 & 255u) << 16) | ((unsigned)i3 << 24); }
    if constexpr (SPLITK) {
#pragma unroll
        for (int q = 0; q < 4; ++q) __hip_atomic_fetch_add((LAS int*)red + 32 + 4 * g + q, sq[q], __ATOMIC_RELAXED, __HIP_MEMORY_SCOPE_WORKGROUP); }
    __syncthreads();
    if constexpr (SPLITK) { if (tid < 32) __hip_atomic_fetch_add(gsum + tid, ((LAS int*)red)[32 + tid], __ATOMIC_RELAXED, __HIP_MEMORY_SCOPE_AGENT); }
    { const LAS unsigned char* rb = img + (4 * w) * 4096 + ((l ^ w) << 4); GAS unsigned char* ob = (GAS unsigned char*)qrows + (size_t)(4 * w) * qpitch + 16 * l;
#pragma unroll
      for (int r = 0; r < 4; ++r)
#pragma unroll
        for (int i = 0; i < 4; ++i) { const v4u x = *(const LAS v4u*)(rb + r * 4096 + i * 1024); *(GAS v4u*)(ob + (size_t)r * qpitch + i * 1024) = x; } }
    __syncthreads();
}
__device__ __forceinline__ void q_drain(Frame& F, const Args& a, int q, int cw, int n);
constexpr int CW_Q0 = 256;
constexpr int Q0_QK = (DM / 64) * (4096 / 32), Q0_MKV = (DM / 64) * (1024 / 32), Q0_N = Q0_QK + Q0_MKV + MTOK + MROWS;
__device__ __forceinline__ void p0_prologue(Frame& F, const Args& a) {
    unsigned char* ws = a.ws;
    for (int job = F.vcu; job < (D_IN - 4096) / 32; job += F.G) { const int vr0 = 32 * job, n0 = vr0 < C_QB ? vr0 : vr0 + 4096;
        colblock32_i8<false>(a.w_in, D_IN, n0, 0, ws + WS_OD + (size_t)vr0 * DM, DM, (float*)(ws + WS_SBIN) + n0, F.lds + RING_OFF, F.tid); }
    q_drain(F, a, 0, CW_Q0, Q0_N);
}

constexpr int QI_A = (1024 / 64) * (DM / 32), QI_B = (2048 / 64) * (DM / 32), QI_MIX = (DM / 64) * (DM / 32), QI_MQ = (DM / 64) * (512 / 32), QI_MO = (512 / 64) * (DM / 32),
              QI_UP = (DM / 64) * (D_FF / 32), QI_DN = (D_FF / 64) * (DM / 32);
constexpr int Q1_N = QI_A + QI_B + QI_MIX + QI_MQ + QI_MO;
constexpr int CW_QJ = 320;
constexpr int CW_DMAX = 81920, CW_DSUM = 86016, CW_DCNT = 90112;
constexpr int CW_Q1 = 64, CW_Q2 = 128, CW_Q3 = 192;
__device__ __forceinline__ void q_item(const Args& a, int q, int r, LAS float* scr, int lane) {
    unsigned char* ws = a.ws;
    if (q == 0) {
        if (r < Q0_QK) { const int kb = r / 128, nb = r % 128; p0_transpose_cols(a.w_in, DM, D_IN, C_QB + 32 * nb, (bf16*)(ws + WS_WIN), C_QB + 32 * nb, scr, kb, lane); return; } r -= Q0_QK;
        if (r < Q0_MKV) { p0_transpose_item(a.w_mkv, DM, 1024, (bf16*)(ws + WS_WMKV), scr, r, lane); return; } r -= Q0_MKV;
        if (r < MTOK) { const int m = r;
            rms_row_to_i8(a.x + (size_t)m * DM, a.g_mix_pre, ws + WS_OBR + (size_t)m * DM, (float*)(ws + WS_SA0) + m, lane, (bf16*)(ws + WS_H) + (size_t)m * DM);
            const float ang = (float)a.pos[m] * INV_FREQ[lane];
            const double rev = (double)ang * 0.15915494309189533577;
            const float fr = (float)(rev - __builtin_floor(rev));
            float2 cs; cs.x = __builtin_amdgcn_cosf(fr); cs.y = __builtin_amdgcn_sinf(fr);
            ((float2*)(ws + WS_ROPE))[(size_t)m * 64 + lane] = cs; return; } r -= MTOK;
        rms_row_to_bf16(a.mem + (size_t)r * DM, a.g_mem_kv, (bf16*)(ws + WS_MB) + (size_t)r * DM, lane); return;
    }
    if (q == 1) {
        if (r < QI_A) { p0_transpose_item(a.w_a, 1024, DM, (bf16*)(ws + WS_WA), scr, r, lane); return; } r -= QI_A;
        if (r < QI_B) { p0_transpose_item(a.w_b, 2048, DM, (bf16*)(ws + WS_WB), scr, r, lane); return; } r -= QI_B;
        if (r < QI_MIX) { p0_transpose_item(a.w_mix, DM, DM, (bf16*)(ws + WS_WMIX), scr, r, lane); return; } r -= QI_MIX;
        if (r < QI_MQ) { p0_transpose_item(a.w_mq, DM, 512, (bf16*)(ws + WS_WMQ), scr, r, lane); return; } r -= QI_MQ;
        p0_transpose_item(a.w_mo, 512, DM, (bf16*)(ws + WS_WMO), scr, r, lane);
    }
}
__device__ __forceinline__ void q_drain(Frame& F, const Args& a, int q, int cw, int n) {
    LAS float* scr = (LAS float*)(F.lds + RING_OFF + F.wave * 16384);
    int lane = F.lane; asm volatile("" : "+v"(lane));
    constexpr int BATCH_ITEMS = 8;
    for (;;) {
        unsigned base = 0;
        if (lane == 0) base = __hip_atomic_fetch_add((unsigned*)(F.ctl + cw), (unsigned)BATCH_ITEMS, __ATOMIC_RELAXED, __HIP_MEMORY_SCOPE_AGENT);
        base = (unsigned)__builtin_amdgcn_readfirstlane((int)base);
        if (base >= (unsigned)n) break;
        const int e = ((int)base + BATCH_ITEMS < n) ? (int)base + BATCH_ITEMS : n;
        for (int it = (int)base; it < e; ++it) q_item(a, q, it, scr, lane);
    }
}
__device__ __forceinline__ unsigned pk4_i8(const f32x4 v, float inv) { const int a = (int)__builtin_rintf(v.x * inv), b = (int)__builtin_rintf(v.y * inv), c = (int)__builtin_rintf(v.z * inv), d = (int)__builtin_rintf(v.w * inv);
    return (unsigned)(a & 255) | ((unsigned)(b & 255) << 8) | ((unsigned)(c & 255) << 16) | ((unsigned)d << 24); }
__device__ __forceinline__ float amax4(const f32x4 v) { return fmaxf(fmaxf(fabsf(v.x), fabsf(v.y)), fmaxf(fabsf(v.z), fabsf(v.w))); }
__device__ __forceinline__ void thin_mix_row(const bf16* OD, const float* LSE, const bf16* OBR, const bf16* OBR2, float lam, const float* subln, unsigned char* OA8, float* sa4, unsigned char* OB8, float* sa5, int row, int lane) {
    { const int h = lane >> 3;
      const float l0 = LSE[((size_t)0 * MTOK + row) * 8 + h], l1 = LSE[((size_t)1 * MTOK + row) * 8 + h], l2 = LSE[((size_t)2 * MTOK + row) * 8 + h];
      const float mx = fmaxf(l0, fmaxf(l1, l2)); float e0 = __expf(l0 - mx), e1 = __expf(l1 - mx), e2 = __expf(l2 - mx); const float inv = 1.f / (e0 + e1 + e2); e0 *= inv; e1 *= inv; e2 *= inv;
      const GAS v2u* p0 = (const GAS v2u*)(OD + ((size_t)0 * MTOK + row) * 1024) + lane * 4; const GAS v2u* p1 = (const GAS v2u*)(OD + ((size_t)1 * MTOK + row) * 1024) + lane * 4;
      const GAS v2u* p2 = (const GAS v2u*)(OD + ((size_t)2 * MTOK + row) * 1024) + lane * 4; f32x4 v[4]; float am = 0.f;
#pragma unroll
      for (int j = 0; j < 4; ++j) { f32x4 a, b, c; unpack4(__builtin_nontemporal_load(p0 + j), a); unpack4(__builtin_nontemporal_load(p1 + j), b); unpack4(__builtin_nontemporal_load(p2 + j), c); v[j] = a * e0 + b * e1 + c * e2; am = fmaxf(am, amax4(v[j])); }
      am = wave_max(am); const float qi = am > 0.f ? 127.f / am : 0.f; if (lane == 0) sa4[row] = am * (1.f / 127.f);
      v4u w;
#pragma unroll
      for (int j = 0; j < 4; ++j) w[j] = pk4_i8(v[j], qi);
      ((GAS v4u*)(OA8 + (size_t)row * 1024))[lane] = w; }
    { const GAS v2u* p = (const GAS v2u*)(OBR + (size_t)row * 2048) + lane; const GAS v2u* p2 = (const GAS v2u*)(OBR2 + (size_t)row * 2048) + lane; const f32x4 g = ((const GAS f32x4*)subln)[lane]; f32x4 y[8]; float am = 0.f;
      v2u aw[8], bw[8];
#pragma unroll
      for (int h = 0; h < 8; ++h) { aw[h] = __builtin_nontemporal_load(p + 64 * h); bw[h] = __builtin_nontemporal_load(p2 + 64 * h); }
#pragma unroll
      for (int h = 0; h < 8; ++h) { f32x4 a, b; unpack4(aw[h], a); unpack4(bw[h], b); const f32x4 v = a - b * lam; const float s = wave_sum((v.x * v.x + v.y * v.y) + (v.z * v.z + v.w * v.w));
          const float rstd = 0.8f / sqrtf(s * (1.f / 256.f) + NORM_EPS); y[h] = (f32x4){v.x * rstd * g.x, v.y * rstd * g.y, v.z * rstd * g.z, v.w * rstd * g.w}; am = fmaxf(am, amax4(y[h])); }
      am = wave_max(am); const float qi = am > 0.f ? 127.f / am : 0.f; if (lane == 0) sa5[row] = am * (1.f / 127.f);
      GAS unsigned* o = (GAS unsigned*)(OB8 + (size_t)row * 2048) + lane;
#pragma unroll
      for (int h = 0; h < 8; ++h) o[64 * h] = pk4_i8(y[h], qi); }
}

#ifndef PG8_SP2
#define PG8_SP2 true
#endif
#ifndef PG8_ALIGN
#define PG8_ALIGN true
#endif
#ifndef MK_FP8_SP2
#define MK_FP8_SP2 true
#endif
#ifndef MK_FP8_ALIGN
#define MK_FP8_ALIGN true
#endif
#ifndef MK_QREG_DIFF
#define MK_QREG_DIFF true
#endif
#ifndef MK_QREG_CROSS
#define MK_QREG_CROSS true
#endif
constexpr int NPHASE = 15;
#ifndef MK_FAST
#define MK_FAST 0x7FFFu
#endif
constexpr unsigned FAST = MK_FAST;
__global__ void __launch_bounds__(NWAVES * 64, 2) mk_fwd(Args args) {
    extern __shared__ __attribute__((aligned(16))) unsigned char lds[];
    Frame F;
    F.lds = (LAS unsigned char*)lds;
    F.MISC = (volatile LAS unsigned*)(F.lds + MISC_OFF);
    F.tid = threadIdx.x; F.lane = F.tid & 63; F.wave = __builtin_amdgcn_readfirstlane(F.tid >> 6);
    F.G = gridDim.x; { const int bx = blockIdx.x; F.vcu = (F.G % 8 == 0) ? (bx % 8) * (F.G / 8) + bx / 8 : bx; }
    F.ctl = (gu32*)(args.ws + WS_CTL);
    for (int u = F.tid; u < (LDS_BYTES - LDSCTL_OFF) / 4; u += NWAVES * 64) ((LAS unsigned*)(F.lds + LDSCTL_OFF))[u] = 0u;
    __syncthreads();
    const int ph_lo_ = args.ph_lo, ph_hi_ = args.ph_hi;
    unsigned* barw = (unsigned*)(F.ctl + CW_BAR) + args.li * XCD_BAR_WORDS;
    XcdBarrier bar; bar.bar = barw; bar.x = 0; bar.st = F.MISC + 8;
    if (ph_hi_ - ph_lo_ > 1) bar = xcd_barrier_post(barw, F.MISC + 8);
#define IN(k) (ph_lo_ <= (k) && (k) < ph_hi_)
#define SEAM(k) do { if (IN(k) && IN((k) + 1)) xcd_barrier(bar); } while (0)
    if (IN(0)) { p0_prologue(F, args); SEAM(0); }
    unsigned char* ws = args.ws; asm volatile("" : "+s"(ws));
    bf16 *WIN = (bf16*)(ws + WS_WIN), *WA = (bf16*)(ws + WS_WA), *WB = (bf16*)(ws + WS_WB), *WMIX = (bf16*)(ws + WS_WMIX), *WMQ = (bf16*)(ws + WS_WMQ), *WMKV = (bf16*)(ws + WS_WMKV),
         *WMO = (bf16*)(ws + WS_WMO), *WUP = (bf16*)(ws + WS_WUP), *WDN = (bf16*)(ws + WS_WDN), *H = (bf16*)(ws + WS_H), *MB = (bf16*)(ws + WS_MB), *PROJ = (bf16*)(ws + WS_PROJ),
         *U = (bf16*)(ws + WS_U), *OA = (bf16*)(ws + WS_OA), *OBN = (bf16*)(ws + WS_OBN), *MERGED = (bf16*)(ws + WS_MERGED), *Q2 = (bf16*)(ws + WS_Q2), *KV2 = (bf16*)(ws + WS_KV2), *O2 = (bf16*)(ws + WS_O2);
    float *ROPE = (float*)(ws + WS_ROPE), *LSE = (float*)(ws + WS_LSE); bf16 *OD = (bf16*)(ws + WS_OD)  , *OBR = (bf16*)(ws + WS_OBR), *OBR2 = (bf16*)(ws + WS_OBR + 32 * MiB)  ; bf16* Y = (bf16*)(ws + WS_Y); bf16* XR = (bf16*)(ws + WS_OD + 48 * MiB);
    const int gw = F.vcu * NWAVES + F.wave, NGW = F.G * NWAVES;
    if (IN(1)) {
        { pg8::Gemm g{H, WIN + (size_t)C_QB * DM, MTOK, 4096, DM, DM, DM, 0, 0, C_QB / 256}; pg8::StaticOrder S; S.init(MTOK, 4096, F.G, (int)blockIdx.x);
          pg8::EpiProj<false> E{PROJ, ROPE, 1.f};
          pg8::gemm_phase<pg8::EpiProj<false>, pg8::StaticOrder, PG8_ALIGN, PG8_SP2>(F.lds + RING_OFF, g, S, E); }
        { pg8::Gemm g{(const bf16*)(ws + WS_OBR), (const bf16*)(ws + WS_OD), MTOK, D_IN - 4096, DM, DM, DM, C_QB / 256, 0, 16}; pg8::StaticOrder S; S.init(MTOK, D_IN - 4096, F.G, (int)blockIdx.x);
          pg8::EpiProjI8 E{PROJ, ROPE, (const float*)(ws + WS_SA0), (const float*)(ws + WS_SBIN)};
          pg8::gemm_phase<pg8::EpiProjI8, pg8::StaticOrder, PG8_ALIGN, PG8_SP2, false, true>(F.lds + RING_OFF, g, S, E); }
        { pg8::Gemm g{MB, WMKV, MROWS, 1024, DM / 2, DM, DM}; pg8::StaticOrder S; S.init(MROWS, 1024, F.G, (int)((blockIdx.x + F.G - 128) % F.G));
          pg8::EpiF32 E{(float*)(ws + WS_Y + 64 * MiB), 1024};
          pg8::gemm_phase<pg8::EpiF32, pg8::StaticOrder, PG8_ALIGN, PG8_SP2>(F.lds + RING_OFF, g, S, E); }
        { pg8::Gemm g{MB + DM / 2, WMKV + DM / 2, MROWS, 1024, DM / 2, DM, DM}; pg8::StaticOrder S; S.init(MROWS, 1024, F.G, (int)((blockIdx.x + F.G - 136) % F.G));
          pg8::EpiF32 E{(float*)(ws + WS_Y + 68 * MiB), 1024};
          pg8::gemm_phase<pg8::EpiF32, pg8::StaticOrder, PG8_ALIGN, PG8_SP2>(F.lds + RING_OFF, g, S, E); }
        q_drain(F, args, 1, CW_Q1, Q1_N);
        SEAM(1);
    }
    if (IN(2)) {
        char* alds = (char*)lds + RING_OFF;
        const int wid = F.wave;
#ifndef MK_NO_DIFF
        for (int u = F.vcu; u < BATCH * 8 * (SEQ / 128); u += F.G) {
            const int b = u / (8 * (SEQ / 128)), h = (u / (SEQ / 128)) % 8, qb = u % (SEQ / 128);
            const size_t row0 = (size_t)b * SEQ + (size_t)qb * 128;
            for (int c = 0; c < 2; ++c)
                att::diff_pass(PROJ + row0 * D_IN + C_QB + (h * 2 + c) * 128, PROJ + (size_t)b * SEQ * D_IN + C_KB + (h * 2 + c) * 128, PROJ + (size_t)b * SEQ * D_IN + C_VB + h * 256,
                               D_IN, SEQ / 64, alds, (c == 0 ? OBR : OBR2) + row0 * 2048 + h * 256, qb);
        }
#endif
#ifndef MK_NO_DIL
        for (int u = F.vcu; u < 768; u += F.G) {
            const int g = u >> 8, v = u & 255, b = v >> 7, h = (v >> 4) & 7, rq = v & 15;
            const int dil = (g == 0) ? 1 : (g == 1 ? 4 : 16), res = rq % dil, qblk = rq / dil, L = SEQ / dil;
            const int q0 = qblk * 256, NT = (g == 2) ? 4 : 6; int t0 = q0 / 64 - 1; t0 = t0 < 0 ? 0 : t0; t0 = (t0 > L / 64 - NT) ? (L / 64 - NT) : t0;
            const size_t base = ((size_t)b * SEQ + res) * D_IN + (g * 8 + h) * 128; const long ld = (long)dil * D_IN;
            att::f32x16 o[4]; float m_reg, l_reg;
            att::body<true, false>(PROJ + base + (size_t)q0 * ld + C_QA, ld, PROJ + base + (size_t)(t0 * 64) * ld + C_KA, PROJ + base + (size_t)(t0 * 64) * ld + C_VA, ld, NT, q0 - t0 * 64, alds, o, m_reg, l_reg);
            float rli[16]; att::row_recip(alds, l_reg, rli);
                int ln_ = F.lane; asm volatile("" : "+v"(ln_)); const int r32 = ln_ & 31, hi = ln_ >> 5;
            const size_t tok0 = (size_t)b * SEQ + res + (size_t)(q0 + wid * 32) * dil;
            bf16* Ow = OD + ((size_t)g * MTOK + tok0) * 1024 + h * 128 + r32;
#pragma unroll
            for (int r = 0; r < 16; ++r) { bf16* p = Ow + (size_t)att::crow(r, hi) * dil * 1024;
#pragma unroll
                for (int d0 = 0; d0 < 4; ++d0) p[d0 * 32] = (bf16)f2bf(o[d0][r] * rli[r]); }
            if (hi == 0) LSE[((size_t)g * MTOK + tok0 + (size_t)r32 * dil) * 8 + h] = m_reg * att::SCALE + __logf(l_reg);
        }
#endif
        SEAM(2);
    }
    if (IN(3)) {
        const float ld1 = wave_sum(args.lq1[F.lane] * args.lk1[F.lane] + args.lq1[F.lane + 64] * args.lk1[F.lane + 64]);
        const float ld2 = wave_sum(args.lq2[F.lane] * args.lk2[F.lane] + args.lq2[F.lane + 64] * args.lk2[F.lane + 64]);
        const float lam = __expf(ld1) - __expf(ld2) + 0.2f;
        for (int m = gw; m < MTOK; m += NGW) thin_mix_row(OD, LSE, OBR, OBR2, lam, args.subln, (unsigned char*)OA, (float*)(ws + WS_SA4), (unsigned char*)OBN, (float*)(ws + WS_SA5), m, F.lane);
        for (int n = gw; n < DM; n += NGW) { quant_row_bf16_i8<2>(WA + (size_t)n * 1024, ws + WS_DTMP + (size_t)n * 1024, (float*)(ws + WS_SBA) + n, F.lane);
            quant_row_bf16_i8<4>(WB + (size_t)n * 2048, ws + WS_DTMP + 4 * MiB + (size_t)n * 2048, (float*)(ws + WS_SBB) + n, F.lane);
            quant_row_bf16_i8(WMIX + (size_t)n * DM, ws + WS_WIN + (size_t)n * DM, (float*)(ws + WS_SBMIX) + n, F.lane); }
        { const GAS f32x4* k0 = (const GAS f32x4*)(ws + WS_Y + 64 * MiB); const GAS f32x4* k1 = (const GAS f32x4*)(ws + WS_Y + 68 * MiB); GAS v2u* ko = (GAS v2u*)KV2;
          for (int c = F.vcu * (NWAVES * 64) + F.tid; c < MROWS * 1024 / 4; c += F.G * NWAVES * 64) { const f32x4 a = k0[c], b = k1[c]; v2u o; o.x = pk2(a.x + b.x, a.y + b.y); o.y = pk2(a.z + b.z, a.w + b.w); ko[c] = o; } }
        SEAM(3); }
    if (IN(4)) { pg8::Gemm g{OA, (const bf16*)(ws + WS_DTMP), MTOK, DM, 1024, 1024, 1024}; pg8::StaticOrder S; S.init(MTOK, DM, F.G, (int)blockIdx.x);
        pg8::EpiGateI8<false> E{MERGED, DM, PROJ + C_GA, D_IN, (const float*)(ws + WS_SA4), (const float*)(ws + WS_SBA)};
        pg8::gemm_phase<pg8::EpiGateI8<false>, pg8::StaticOrder, PG8_ALIGN, PG8_SP2, false, true>(F.lds + RING_OFF, g, S, E); }
    if (IN(5)) { pg8::Gemm g{OBN, (const bf16*)(ws + WS_DTMP + 4 * MiB), MTOK, DM, 2048, 2048, 2048}; pg8::StaticOrder S; S.init(MTOK, DM, F.G, (int)blockIdx.x);
        pg8::EpiGateI8<true> E{MERGED, DM, PROJ + C_GB, D_IN, (const float*)(ws + WS_SA5), (const float*)(ws + WS_SBB)};
        pg8::gemm_phase<pg8::EpiGateI8<true>, pg8::StaticOrder, PG8_ALIGN, PG8_SP2, false, true>(F.lds + RING_OFF, g, S, E); SEAM(5); }
    if (IN(6)) { unsigned char* M8 = ws + WS_WIN + 32 * MiB;
        for (int m = gw; m < MTOK; m += NGW) quant_row_bf16_i8(MERGED + (size_t)m * DM, M8 + (size_t)m * DM, (float*)(ws + WS_SAM) + m, F.lane);
        xcd_barrier(bar);
        pg8::Gemm g{(const bf16*)M8, (const bf16*)(ws + WS_WIN), MTOK, DM, DM, DM, DM}; pg8::StaticOrder S; S.init(MTOK, DM, F.G, (int)blockIdx.x);
        pg8::EpiI8Bf16 E{Y, DM, (const float*)(ws + WS_SAM), (const float*)(ws + WS_SBMIX)};
        pg8::gemm_phase<pg8::EpiI8Bf16, pg8::StaticOrder, PG8_ALIGN, PG8_SP2, false, true>(F.lds + RING_OFF, g, S, E); SEAM(6); }
    if (IN(7)) { for (int m = gw; m < MTOK; m += NGW) norm_res_row<false, true>(Y + (size_t)m * DM, args.g_mix_post, args.x + (size_t)m * DM, XR + (size_t)m * DM, args.g_mem_pre, H + (size_t)m * DM, F.lane); SEAM(7); }
    if (IN(8)) {
        pg8::Gemm g{H, WMQ, MTOK, 512, DM, DM, DM}; pg8::StaticOrder S; S.init(MTOK, 512, F.G, (int)blockIdx.x);
        pg8::EpiBf16<0> E{Q2, 512};
        pg8::gemm_phase<pg8::EpiBf16<0>, pg8::StaticOrder, PG8_ALIGN, PG8_SP2>(F.lds + RING_OFF, g, S, E);
#ifndef MK_NO_CROSS
        pg8::Unit u8;
        if (S.next(0, u8)) {
            VM_WAIT(); __builtin_amdgcn_fence(__ATOMIC_ACQUIRE, "agent"); VM_WAIT(); __syncthreads();
            char* alds = (char*)lds + RING_OFF; const int wid = F.wave;
            const size_t row0 = (size_t)u8.pm * 256; const int b = u8.pm / (SEQ / 256);
            for (int hh = 2 * u8.pn; hh < 2 * u8.pn + 2; ++hh) {
                att::f32x16 o[4]; float m_reg, l_reg;
                att::body<false, MK_QREG_CROSS>(Q2 + row0 * 512 + hh * 128, 512, KV2 + (size_t)b * MEM_LEN * 1024 + hh * 128, KV2 + (size_t)b * MEM_LEN * 1024 + 512 + hh * 128, 1024, MEM_LEN / 64, 0, alds, o, m_reg, l_reg);
                float rli[16]; att::row_recip(alds, l_reg, rli);
                int ln_ = F.lane; asm volatile("" : "+v"(ln_)); const int r32 = ln_ & 31, hi = ln_ >> 5;
                bf16* Ow = O2 + (row0 + wid * 32) * 512 + hh * 128 + r32;
#pragma unroll
                for (int r = 0; r < 16; ++r) { bf16* p = Ow + (size_t)att::crow(r, hi) * 512;
#pragma unroll
                    for (int d0 = 0; d0 < 4; ++d0) { const float v = o[d0][r] * rli[r]; const float nb = __shfl_xor(v, 1); if (!(ln_ & 1)) *(unsigned*)(p + d0 * 32) = pk2(v, nb); } }
            }
            __syncthreads();
        }
#endif
        for (;;) { if (F.tid == 0) F.MISC[16] = __hip_atomic_fetch_add((unsigned*)(F.ctl + CW_QJ), 1u, __ATOMIC_RELAXED, __HIP_MEMORY_SCOPE_AGENT);
            __syncthreads(); const int job = (int)F.MISC[16]; __syncthreads();
            if (job >= D_FF / 32 + 4 * (DM / 32)) break;
            if (job < D_FF / 32) colblock32_i8<false>(args.w_up, D_FF, 32 * job, 0, ws + WS_WIN + (size_t)(32 * job) * DM, DM, (float*)(ws + WS_SB) + 32 * job, F.lds + RING_OFF, F.tid);
            else { const int jd = job - D_FF / 32, cb = jd >> 2, kq = jd & 3;
                colblock32_i8<true>(args.w_dn, DM, 32 * cb, 4096 * kq, ws + WS_DTMP + (size_t)(32 * cb) * D_FF + 4096 * kq, D_FF, (float*)(ws + WS_SD) + 32 * cb, F.lds + RING_OFF, F.tid,
                                    (unsigned*)(F.ctl + CW_DMAX) + 32 * cb, (unsigned*)(F.ctl + CW_DCNT) + cb, (int*)(F.ctl + CW_DSUM) + 32 * cb); } }
        SEAM(8);
    }
    if (IN(10)) { pg8::Gemm g{O2, WMO, MTOK, DM, 512, 512, 512}; pg8::StaticOrder S; S.init(MTOK, DM, F.G, (int)blockIdx.x);
        pg8::EpiBf16<0> E{Y, DM};
        pg8::gemm_phase<pg8::EpiBf16<0>, pg8::StaticOrder, PG8_ALIGN, PG8_SP2>(F.lds + RING_OFF, g, S, E); SEAM(10); }
    if (IN(11)) { for (int m = gw; m < MTOK; m += NGW) norm_res_row<true, true>(Y + (size_t)m * DM, args.g_mem_post, XR + (size_t)m * DM, XR + (size_t)m * DM, args.g_mlp_pre, nullptr, F.lane, ws + WS_H8 + (size_t)m * DM, (float*)(ws + WS_SA) + m);
        SEAM(11); }
    if (IN(12)) { pg8::Gemm g{(const bf16*)(ws + WS_H8), (const bf16*)(ws + WS_WIN), MTOK, D_FF, DM, DM, DM}; pg8::StaticOrder S; S.init(MTOK, D_FF, F.G, (int)blockIdx.x);
        pg8::EpiI8Relu2 E{U, D_FF, (const float*)(ws + WS_SA), (const float*)(ws + WS_SB), (unsigned*)(F.ctl + CW_UMAX)};
        pg8::gemm_phase<pg8::EpiI8Relu2, pg8::StaticOrder, PG8_ALIGN, PG8_SP2, false, true>(F.lds + RING_OFF, g, S, E);
        xcd_barrier(bar);
        { const unsigned* um = (const unsigned*)(F.ctl + CW_UMAX);
          for (int m = gw; m < MTOK; m += NGW) {
              const float mx = __builtin_bit_cast(float, __hip_atomic_load(um + m, __ATOMIC_RELAXED, __HIP_MEMORY_SCOPE_AGENT)); const float inv = mx > 0.f ? 255.f / mx : 0.f;
              const GAS v4u* src = (const GAS v4u*)(U + (size_t)m * D_FF) + F.lane; GAS v2u* dst = (GAS v2u*)(ws + WS_WIN + (size_t)m * D_FF) + F.lane;
#pragma unroll
              for (int bt = 0; bt < 2; ++bt) { v4u w[16];
#pragma unroll
                  for (int i = 0; i < 16; ++i) w[i] = __builtin_nontemporal_load(src + 64 * (16 * bt + i));
#pragma unroll
                  for (int i = 0; i < 16; ++i) { unsigned q[8];
#pragma unroll
                      for (int j = 0; j < 4; ++j) { int a = (int)__builtin_rintf(__builtin_bit_cast(float, w[i][j] << 16) * inv), b = (int)__builtin_rintf(__builtin_bit_cast(float, w[i][j] & 0xffff0000u) * inv);
                          a = (a > 255 ? 255 : a) - 128; b = (b > 255 ? 255 : b) - 128; q[2 * j] = (unsigned)a & 255u; q[2 * j + 1] = (unsigned)b & 255u; }
                      v2u ov; ov.x = q[0] | (q[1] << 8) | (q[2] << 16) | (q[3] << 24); ov.y = q[4] | (q[5] << 8) | (q[6] << 16) | (q[7] << 24); dst[64 * (16 * bt + i)] = ov; } }
              if (F.lane == 0) ((float*)(ws + WS_SU))[m] = mx * (1.f / 255.f); } }
        SEAM(12); }
    if (IN(13)) { pg8::Gemm g{(const bf16*)(ws + WS_WIN), (const bf16*)(ws + WS_DTMP), MTOK, DM, D_FF, D_FF, D_FF}; pg8::StaticOrder S; S.init(MTOK, DM, F.G, (int)blockIdx.x);
        pg8::EpiI8Down E{Y, DM, (const float*)(ws + WS_SU), (const float*)(ws + WS_SD), (const int*)(F.ctl + CW_DSUM)};
        pg8::gemm_phase<pg8::EpiI8Down, pg8::StaticOrder, PG8_ALIGN, PG8_SP2, false, true>(F.lds + RING_OFF, g, S, E); SEAM(13); }
    if (IN(14)) { for (int m = gw; m < MTOK; m += NGW) norm_res_row<true, false>(Y + (size_t)m * DM, args.g_mlp_post, XR + (size_t)m * DM, args.out + (size_t)m * DM, nullptr, nullptr, F.lane); }
#undef IN
#undef SEAM
}

namespace nv {
enum { EP_BF16 = 0, EP_F32 = 1, EP_RELU2 = 2, EP_GATE = 3, EP_GATE_ADD = 4 };
template <int EP>
__global__ __launch_bounds__(256) void gemm(const bf16* __restrict__ A, int lda, const bf16* __restrict__ Bt, int ldb, void* Cv, int ldc, int K, const bf16* __restrict__ gate, int ldg) {
    __shared__ float As[16][132], Bs[16][132];
    const int tid = threadIdx.x, tx = tid & 15, ty = tid >> 4;
    const int m0 = blockIdx.y * 128, n0 = blockIdx.x * 128;
    const int lr = tid >> 1, lc = (tid & 1) * 8;
    float acc[8][8];
#pragma unroll
    for (int i = 0; i < 8; ++i)
#pragma unroll
        for (int j = 0; j < 8; ++j) acc[i][j] = 0.f;
    for (int k0 = 0; k0 < K; k0 += 16) {
        const v4u av = *(const v4u*)(A + (size_t)(m0 + lr) * lda + k0 + lc);
        const v4u bv = *(const v4u*)(Bt + (size_t)(n0 + lr) * ldb + k0 + lc);
        __syncthreads();
        As[lc + 0][lr] = __builtin_bit_cast(float, av.x << 16); As[lc + 1][lr] = __builtin_bit_cast(float, av.x & 0xffff0000u);
        As[lc + 2][lr] = __builtin_bit_cast(float, av.y << 16); As[lc + 3][lr] = __builtin_bit_cast(float, av.y & 0xffff0000u);
        As[lc + 4][lr] = __builtin_bit_cast(float, av.z << 16); As[lc + 5][lr] = __builtin_bit_cast(float, av.z & 0xffff0000u);
        As[lc + 6][lr] = __builtin_bit_cast(float, av.w << 16); As[lc + 7][lr] = __builtin_bit_cast(float, av.w & 0xffff0000u);
        Bs[lc + 0][lr] = __builtin_bit_cast(float, bv.x << 16); Bs[lc + 1][lr] = __builtin_bit_cast(float, bv.x & 0xffff0000u);
        Bs[lc + 2][lr] = __builtin_bit_cast(float, bv.y << 16); Bs[lc + 3][lr] = __builtin_bit_cast(float, bv.y & 0xffff0000u);
        Bs[lc + 4][lr] = __builtin_bit_cast(float, bv.z << 16); Bs[lc + 5][lr] = __builtin_bit_cast(float, bv.z & 0xffff0000u);
        Bs[lc + 6][lr] = __builtin_bit_cast(float, bv.w << 16); Bs[lc + 7][lr] = __builtin_bit_cast(float, bv.w & 0xffff0000u);
        __syncthreads();
#pragma unroll
        for (int kk = 0; kk < 16; ++kk) {
            float a[8], b[8];
#pragma unroll
            for (int i = 0; i < 8; ++i) a[i] = As[kk][ty * 8 + i];
#pragma unroll
            for (int j = 0; j < 8; ++j) b[j] = Bs[kk][tx * 8 + j];
#pragma unroll
            for (int i = 0; i < 8; ++i)
#pragma unroll
                for (int j = 0; j < 8; ++j) acc[i][j] += a[i] * b[j];
        }
    }
#pragma unroll
    for (int i = 0; i < 8; ++i) {
        const size_t r = (size_t)(m0 + ty * 8 + i);
#pragma unroll
        for (int j = 0; j < 8; ++j) {
            const int c = n0 + tx * 8 + j; float v = acc[i][j];
            if (EP == EP_F32) { ((float*)Cv)[r * ldc + c] = v; }
            else {
                bf16* C = (bf16*)Cv;
                if (EP == EP_RELU2) { v = v > 0.f ? v * v : 0.f; }
                if (EP == EP_GATE) { v = v * bf2f(gate[r * ldg + c]); }
                if (EP == EP_GATE_ADD) { v = v * bf2f(gate[r * ldg + c]) + bf2f(C[r * ldc + c]); }
                C[r * ldc + c] = (bf16)f2bf(v);
            }
        }
    }
}
__global__ __launch_bounds__(256) void proj_post(bf16* proj, const float* rope) {
    const int row = blockIdx.x; bf16* p = proj + (size_t)row * D_IN; const float2* rt = (const float2*)rope + (size_t)row * 64;
    for (int e = threadIdx.x; e < 80 * 64; e += 256) {
        const int ch = e >> 6, i = e & 63; const int c0 = (ch < 48 ? ch * 128 : C_QB + (ch - 48) * 128);
        const float x1 = bf2f(p[c0 + i]), x2 = bf2f(p[c0 + 64 + i]); const float2 cs = rt[i];
        p[c0 + i] = (bf16)f2bf(x1 * cs.x - x2 * cs.y); p[c0 + 64 + i] = (bf16)f2bf(x2 * cs.x + x1 * cs.y);
    }
    for (int c = C_GA + threadIdx.x; c < D_IN; c += 256) { const float g = bf2f(p[c]); p[c] = (bf16)f2bf(1.f / (1.f + __expf(-g))); }
}
template <int NV>
__device__ __forceinline__ void attn_block(const float* qs, const bf16* Kb, const bf16* Vb, size_t pitch, int myrow, float& m, float& l, float (&o)[NV], int lane) {
    float s = -INFINITY;
    if (myrow >= 0) { const bf16* kp = Kb + (size_t)myrow * pitch; float acc = 0.f;
        for (int d = 0; d < 128; d += 8) { const v4u kv = *(const v4u*)(kp + d);
            acc += qs[d + 0] * __builtin_bit_cast(float, kv.x << 16) + qs[d + 1] * __builtin_bit_cast(float, kv.x & 0xffff0000u);
            acc += qs[d + 2] * __builtin_bit_cast(float, kv.y << 16) + qs[d + 3] * __builtin_bit_cast(float, kv.y & 0xffff0000u);
            acc += qs[d + 4] * __builtin_bit_cast(float, kv.z << 16) + qs[d + 5] * __builtin_bit_cast(float, kv.z & 0xffff0000u);
            acc += qs[d + 6] * __builtin_bit_cast(float, kv.w << 16) + qs[d + 7] * __builtin_bit_cast(float, kv.w & 0xffff0000u); }
        s = acc * ATT_SCALE; }
    const float bm = wave_max(s);
    if (bm == -INFINITY) return;
    const float mn = fmaxf(m, bm), alpha = __expf(m - mn);
    const float p = (myrow >= 0) ? __expf(s - mn) : 0.f;
    l = l * alpha + wave_sum(p);
#pragma unroll
    for (int t = 0; t < NV; ++t) o[t] *= alpha;
    for (int j = 0; j < 64; ++j) {
        const float pj = __shfl(p, j); const int rj = __shfl(myrow, j);
        if (rj >= 0) { const bf16* vp = Vb + (size_t)rj * pitch;
#pragma unroll
            for (int t = 0; t < NV; ++t) o[t] += pj * bf2f(vp[lane + 64 * t]); }
    }
    m = mn;
}
__global__ __launch_bounds__(256) void dil_attn(const bf16* proj, float* OD, float* LSE) {
    __shared__ float qsm[4][128];
    const int wv = threadIdx.x >> 6, lane = threadIdx.x & 63; const int task = blockIdx.x * 4 + wv; const int row = task >> 3, h = task & 7;
    const int b = row / SEQ, s = row % SEQ; float* qs = qsm[wv];
    for (int g = 0; g < 3; ++g) {
        const int dil = (g == 0) ? 1 : (g == 1 ? 4 : 16);
        const bf16* qp = proj + (size_t)row * D_IN + C_QA + (g * 8 + h) * 128;
        qs[lane] = bf2f(qp[lane]); qs[lane + 64] = bf2f(qp[lane + 64]);
        __syncthreads();
        const bf16* Kb = proj + (size_t)b * SEQ * D_IN + C_KA + (g * 8 + h) * 128; const bf16* Vb = proj + (size_t)b * SEQ * D_IN + C_VA + (g * 8 + h) * 128;
        float m = -INFINITY, l = 0.f, o[2] = {0.f, 0.f};
        for (int blk = 0; blk < 3; ++blk) {
            const int j = blk * 64 + lane; int idx = s + (j - 64) * dil; if (j > 128 || idx < 0 || idx >= SEQ) idx = -1;
            attn_block<2>(qs, Kb, Vb, D_IN, idx, m, l, o, lane);
        }
        const float il = 1.f / l;
        OD[((size_t)g * MTOK + row) * 1024 + h * 128 + lane] = o[0] * il; OD[((size_t)g * MTOK + row) * 1024 + h * 128 + 64 + lane] = o[1] * il;
        if (lane == 0) LSE[((size_t)g * MTOK + row) * 8 + h] = m + __logf(l);
        __syncthreads();
    }
}
__global__ __launch_bounds__(256) void diff_attn(const bf16* proj, float* OBR, const float* lq1, const float* lk1, const float* lq2, const float* lk2) {
    __shared__ float qsm[4][128];
    const int wv = threadIdx.x >> 6, lane = threadIdx.x & 63; const int task = blockIdx.x * 4 + wv; const int row = task >> 3, h = task & 7;
    const int b = row / SEQ; float* qs = qsm[wv];
    const float d1 = wave_sum(lq1[lane] * lk1[lane] + lq1[lane + 64] * lk1[lane + 64]), d2 = wave_sum(lq2[lane] * lk2[lane] + lq2[lane + 64] * lk2[lane + 64]);
    const float lam = __expf(d1) - __expf(d2) + 0.2f;
    float res[4] = {0.f, 0.f, 0.f, 0.f};
    for (int c = 0; c < 2; ++c) {
        const bf16* qp = proj + (size_t)row * D_IN + C_QB + (h * 2 + c) * 128;
        qs[lane] = bf2f(qp[lane]); qs[lane + 64] = bf2f(qp[lane + 64]);
        __syncthreads();
        const bf16* Kb = proj + (size_t)b * SEQ * D_IN + C_KB + (h * 2 + c) * 128; const bf16* Vb = proj + (size_t)b * SEQ * D_IN + C_VB + h * 256;
        float m = -INFINITY, l = 0.f, o[4] = {0.f, 0.f, 0.f, 0.f};
        for (int blk = 0; blk < SEQ / 64; ++blk) attn_block<4>(qs, Kb, Vb, D_IN, blk * 64 + lane, m, l, o, lane);
        const float il = (c == 0 ? 1.f : -lam) / l;
#pragma unroll
        for (int t = 0; t < 4; ++t) res[t] += o[t] * il;
        __syncthreads();
    }
#pragma unroll
    for (int t = 0; t < 4; ++t) OBR[(size_t)row * 2048 + h * 256 + lane + 64 * t] = res[t];
}
__global__ __launch_bounds__(256) void thin_mix(const float* OD, const float* LSE, const float* OBR, const float* subln, bf16* OA, bf16* OBN) {
    const int row = blockIdx.x, tid = threadIdx.x;
    for (int c = tid; c < 1024; c += 256) { const int h = c >> 7;
        const float l0 = LSE[((size_t)0 * MTOK + row) * 8 + h], l1 = LSE[((size_t)1 * MTOK + row) * 8 + h], l2 = LSE[((size_t)2 * MTOK + row) * 8 + h];
        const float mx = fmaxf(l0, fmaxf(l1, l2)); const float e0 = __expf(l0 - mx), e1 = __expf(l1 - mx), e2 = __expf(l2 - mx); const float inv = 1.f / (e0 + e1 + e2);
        const float v = (e0 * OD[((size_t)0 * MTOK + row) * 1024 + c] + e1 * OD[((size_t)1 * MTOK + row) * 1024 + c] + e2 * OD[((size_t)2 * MTOK + row) * 1024 + c]) * inv;
        OA[(size_t)row * 1024 + c] = (bf16)f2bf(v); }
    const int wv = tid >> 6, lane = tid & 63;
    for (int hh = 0; hh < 2; ++hh) { const int h = wv * 2 + hh; float v[4]; float s = 0.f;
#pragma unroll
        for (int t = 0; t < 4; ++t) { v[t] = OBR[(size_t)row * 2048 + h * 256 + lane + 64 * t]; s += v[t] * v[t]; }
        const float rstd = 1.f / sqrtf(wave_sum(s) * (1.f / 256.f) + NORM_EPS);
#pragma unroll
        for (int t = 0; t < 4; ++t) OBN[(size_t)row * 2048 + h * 256 + lane + 64 * t] = (bf16)f2bf(v[t] * rstd * subln[lane + 64 * t] * 0.8f); }
}
template <bool BB, bool OB>
__global__ __launch_bounds__(256) void norm_res(const bf16* Y, const float* g1, const void* base, void* out, const float* g2, bf16* H) {
    const int row = blockIdx.x * 4 + (threadIdx.x >> 6);
    const size_t bo = (size_t)row * DM * (BB ? 2 : 4), oo = (size_t)row * DM * (OB ? 2 : 4);
    norm_res_row<BB, OB>(Y + (size_t)row * DM, g1, (const char*)base + bo, (char*)out + oo, g2, H ? H + (size_t)row * DM : nullptr, threadIdx.x & 63);
}
__global__ __launch_bounds__(256) void cross_attn(const bf16* Q2, const bf16* KV2, bf16* O2) {
    __shared__ float qsm[4][128];
    const int wv = threadIdx.x >> 6, lane = threadIdx.x & 63; const int task = blockIdx.x * 4 + wv; const int row = task >> 2, h = task & 3;
    const int b = row / SEQ; float* qs = qsm[wv];
    const bf16* qp = Q2 + (size_t)row * 512 + h * 128;
    qs[lane] = bf2f(qp[lane]); qs[lane + 64] = bf2f(qp[lane + 64]);
    __syncthreads();
    const bf16* Kb = KV2 + (size_t)b * MEM_LEN * 1024 + h * 128; const bf16* Vb = Kb + 512;
    float m = -INFINITY, l = 0.f, o[2] = {0.f, 0.f};
    for (int blk = 0; blk < 4; ++blk) attn_block<2>(qs, Kb, Vb, 1024, blk * 64 + lane, m, l, o, lane);
    const float il = 1.f / l;
    O2[(size_t)row * 512 + h * 128 + lane] = (bf16)f2bf(o[0] * il); O2[(size_t)row * 512 + h * 128 + 64 + lane] = (bf16)f2bf(o[1] * il);
}
}

extern "C" void kernel_launch(void* const* d_in, const int* in_sizes, int n_in, void* d_out, int out_size, void* d_ws, size_t ws_size, hipStream_t stream) {
    static int grid = 0;
    if (grid == 0) {
        if (n_in != 24 || in_sizes[0] != MTOK * DM || out_size != MTOK * DM || ws_size < WS_END) { fprintf(stderr, "kernel_launch: shape mismatch n_in %d in0 %d out %d ws %zu (need %zu)\n", n_in, n_in > 0 ? in_sizes[0] : -1, out_size, ws_size, (size_t)WS_END); grid = -1; return; }
        int dev = 0, cus = 0;
        if (hipGetDevice(&dev) != hipSuccess || hipDeviceGetAttribute(&cus, hipDeviceAttributeMultiprocessorCount, dev) != hipSuccess) { grid = -1; return; }
        if (hipFuncSetAttribute((const void*)mk_fwd, hipFuncAttributeMaxDynamicSharedMemorySize, LDS_BYTES) != hipSuccess) { fprintf(stderr, "kernel_launch: hipFuncSetAttribute failed\n"); grid = -1; return; }
        (void)hipGetLastError();
        grid = cus;
    }
    if (grid < 0) return;
    (void)hipMemsetAsync((char*)d_ws + WS_CTL, 0, CTL_ZERO_BYTES, stream);
    Args a{};
    a.x = (const float*)d_in[0]; a.mem = (const float*)d_in[1]; a.pos = (const int*)d_in[2];
    a.g_mix_pre = (const float*)d_in[3]; a.w_in = (const float*)d_in[4]; a.w_a = (const float*)d_in[5]; a.w_b = (const float*)d_in[6]; a.w_mix = (const float*)d_in[7];
    a.g_mix_post = (const float*)d_in[8]; a.lq1 = (const float*)d_in[9]; a.lk1 = (const float*)d_in[10]; a.lq2 = (const float*)d_in[11]; a.lk2 = (const float*)d_in[12];
    a.subln = (const float*)d_in[13]; a.g_mem_pre = (const float*)d_in[14]; a.g_mem_kv = (const float*)d_in[15]; a.w_mq = (const float*)d_in[16]; a.w_mkv = (const float*)d_in[17];
    a.w_mo = (const float*)d_in[18]; a.g_mem_post = (const float*)d_in[19]; a.g_mlp_pre = (const float*)d_in[20]; a.w_up = (const float*)d_in[21]; a.w_dn = (const float*)d_in[22];
    a.g_mlp_post = (const float*)d_in[23];
    a.out = (float*)d_out; a.ws = (unsigned char*)d_ws;
    unsigned char* ws = (unsigned char*)d_ws;
    bf16 *WIN = (bf16*)(ws + WS_WIN), *WA = (bf16*)(ws + WS_WA), *WB = (bf16*)(ws + WS_WB), *WMIX = (bf16*)(ws + WS_WMIX), *WMQ = (bf16*)(ws + WS_WMQ), *WMKV = (bf16*)(ws + WS_WMKV),
         *WMO = (bf16*)(ws + WS_WMO), *WUP = (bf16*)(ws + WS_WUP), *WDN = (bf16*)(ws + WS_WDN), *H = (bf16*)(ws + WS_H), *MB = (bf16*)(ws + WS_MB), *PROJ = (bf16*)(ws + WS_PROJ),
         *U = (bf16*)(ws + WS_U), *OA = (bf16*)(ws + WS_OA), *OBN = (bf16*)(ws + WS_OBN), *MERGED = (bf16*)(ws + WS_MERGED), *Q2 = (bf16*)(ws + WS_Q2), *KV2 = (bf16*)(ws + WS_KV2), *O2 = (bf16*)(ws + WS_O2);
    float *ROPE = (float*)(ws + WS_ROPE), *OD = (float*)(ws + WS_OD), *LSE = (float*)(ws + WS_LSE), *OBR = (float*)(ws + WS_OBR); bf16* Y = (bf16*)(ws + WS_Y); float* OBR2 = (float*)(ws + WS_Y)  ; bf16* XR = (bf16*)(ws + WS_OD);
    float* OUT = (float*)d_out;
    auto naive = [&](int k) {
        switch (k) {
        case 1: hipLaunchKernelGGL(nv::gemm<nv::EP_BF16>, dim3(D_IN / 128, MTOK / 128), dim3(256), 0, stream, H, DM, WIN, DM, (void*)PROJ, D_IN, DM, (const bf16*)nullptr, 0);
                hipLaunchKernelGGL(nv::proj_post, dim3(MTOK), dim3(256), 0, stream, PROJ, (const float*)ROPE);
                hipLaunchKernelGGL(nv::gemm<nv::EP_BF16>, dim3(1024 / 128, MROWS / 128), dim3(256), 0, stream, MB, DM, WMKV, DM, (void*)KV2, 1024, DM, (const bf16*)nullptr, 0); break;
        case 2: hipLaunchKernelGGL(nv::dil_attn, dim3(MTOK * 8 / 4), dim3(256), 0, stream, (const bf16*)PROJ, OD, LSE);
                hipLaunchKernelGGL(nv::diff_attn, dim3(MTOK * 8 / 4), dim3(256), 0, stream, (const bf16*)PROJ, OBR, a.lq1, a.lk1, a.lq2, a.lk2); break;
        case 3: hipLaunchKernelGGL(nv::thin_mix, dim3(MTOK), dim3(256), 0, stream, (const float*)OD, (const float*)LSE, (const float*)OBR, a.subln, OA, OBN); break;
        case 4: hipLaunchKernelGGL(nv::gemm<nv::EP_GATE>, dim3(DM / 128, MTOK / 128), dim3(256), 0, stream, OA, 1024, WA, 1024, (void*)MERGED, DM, 1024, (const bf16*)(PROJ + C_GA), D_IN); break;
        case 5: hipLaunchKernelGGL(nv::gemm<nv::EP_GATE_ADD>, dim3(DM / 128, MTOK / 128), dim3(256), 0, stream, OBN, 2048, WB, 2048, (void*)MERGED, DM, 2048, (const bf16*)(PROJ + C_GB), D_IN); break;
        case 6: hipLaunchKernelGGL(nv::gemm<nv::EP_BF16>, dim3(DM / 128, MTOK / 128), dim3(256), 0, stream, MERGED, DM, WMIX, DM, (void*)Y, DM, DM, (const bf16*)nullptr, 0); break;
        case 7: hipLaunchKernelGGL((nv::norm_res<false, true>), dim3(MTOK / 4), dim3(256), 0, stream, (const bf16*)Y, a.g_mix_post, (const void*)a.x, (void*)XR, a.g_mem_pre, H); break;
        case 8: hipLaunchKernelGGL(nv::gemm<nv::EP_BF16>, dim3(512 / 128, MTOK / 128), dim3(256), 0, stream, H, DM, WMQ, DM, (void*)Q2, 512, DM, (const bf16*)nullptr, 0); break;
        case 9: hipLaunchKernelGGL(nv::cross_attn, dim3(MTOK * 4 / 4), dim3(256), 0, stream, (const bf16*)Q2, (const bf16*)KV2, O2); break;
        case 10: hipLaunchKernelGGL(nv::gemm<nv::EP_BF16>, dim3(DM / 128, MTOK / 128), dim3(256), 0, stream, O2, 512, WMO, 512, (void*)Y, DM, 512, (const bf16*)nullptr, 0); break;
        case 11: hipLaunchKernelGGL((nv::norm_res<true, true>), dim3(MTOK / 4), dim3(256), 0, stream, (const bf16*)Y, a.g_mem_post, (const void*)XR, (void*)XR, a.g_mlp_pre, H); break;
        case 12: hipLaunchKernelGGL(nv::gemm<nv::EP_RELU2>, dim3(D_FF / 128, MTOK / 128), dim3(256), 0, stream, H, DM, WUP, DM, (void*)U, D_FF, DM, (const bf16*)nullptr, 0); break;
        case 13: hipLaunchKernelGGL(nv::gemm<nv::EP_BF16>, dim3(DM / 128, MTOK / 128), dim3(256), 0, stream, U, D_FF, WDN, D_FF, (void*)Y, DM, D_FF, (const bf16*)nullptr, 0); break;
        case 14: hipLaunchKernelGGL((nv::norm_res<true, false>), dim3(MTOK / 4), dim3(256), 0, stream, (const bf16*)Y, a.g_mlp_post, (const void*)XR, (void*)OUT, (const float*)nullptr, (bf16*)nullptr); break;
        default: break;
        }
    };
#ifdef MK_PROBE_DUP
    { a.ph_lo = 0; a.ph_hi = MK_PROBE_DUP + 1; a.li = 0; hipLaunchKernelGGL(mk_fwd, dim3(grid), dim3(NWAVES * 64), LDS_BYTES, stream, a);
      a.ph_lo = MK_PROBE_DUP; a.ph_hi = NPHASE; a.li = 1; hipLaunchKernelGGL(mk_fwd, dim3(grid), dim3(NWAVES * 64), LDS_BYTES, stream, a); return; }
#endif
    int li = 0;
    for (int k = 0; k < NPHASE;) {
        if ((FAST >> k) & 1u) { int e = k + 1; while (e < NPHASE && ((FAST >> e) & 1u)) ++e;
            a.ph_lo = k; a.ph_hi = e; a.li = li++; hipLaunchKernelGGL(mk_fwd, dim3(grid), dim3(NWAVES * 64), LDS_BYTES, stream, a); k = e; }
        else { naive(k); ++k; }
    }
    const hipError_t le = hipPeekAtLastError();
    if (le != hipSuccess) fprintf(stderr, "kernel_launch: launch failed: %s\n", hipGetErrorName(le));
}
```

```cpp
#include <hip/hip_runtime.h>
#include <cstdio>
#include <cstdint>

constexpr int DM = 4096, BATCH = 2, SEQ = 4096, MTOK = BATCH * SEQ;
constexpr int HD = 128;
constexpr int DIL_W = 3072, DIFF_QK = 2048, DIFF_V = 2048;
constexpr int C_QA = 0, C_KA = 3072, C_VA = 6144, C_QB = 9216, C_KB = 11264, C_VB = 13312, C_GA = 15360, C_GB = 19456, D_IN = 23552;
constexpr int MEM_LEN = 256, MROWS = BATCH * MEM_LEN, MEM_W = 512, D_FF = 16384;
constexpr float NORM_EPS = 1e-6f;
constexpr float ATT_SCALE = 0.088388347648318440f;

constexpr size_t MiB = 1u << 20;
constexpr size_t WS_CTL = 0, CTL_ZERO_BYTES = 1 * MiB;
constexpr size_t WS_ROPE = 2 * MiB;
constexpr size_t WS_SA = 6 * MiB;
constexpr size_t WS_SB = 6 * MiB + 64 * 1024;
constexpr size_t WS_SU = 6 * MiB + 128 * 1024;
constexpr size_t WS_SD = 6 * MiB + 160 * 1024, WS_WSUM = 6 * MiB + 176 * 1024;
constexpr size_t WS_SA0 = 6 * MiB + 192 * 1024, WS_SBIN = 6 * MiB + 256 * 1024;
constexpr size_t WS_SA4 = 6 * MiB + 384 * 1024, WS_SA5 = 6 * MiB + 416 * 1024, WS_SBA = 6 * MiB + 448 * 1024, WS_SBB = 6 * MiB + 464 * 1024;
constexpr size_t WS_SBMIX = 6 * MiB + 512 * 1024, WS_SAM = 6 * MiB + 544 * 1024;
constexpr int CW_UMAX = 65536;
constexpr size_t WS_WIN = 8 * MiB;
constexpr size_t WS_W8 = WS_WIN + 48 * MiB;
constexpr size_t WS_H8 = WS_WIN + 116 * MiB;
constexpr size_t WS_WA = WS_WIN + 184 * MiB;
constexpr size_t WS_WB = WS_WA + 8 * MiB;
constexpr size_t WS_WMIX = WS_WB + 16 * MiB;
constexpr size_t WS_WMQ = WS_WMIX + 32 * MiB;
constexpr size_t WS_WMKV = WS_WMQ + 4 * MiB;
constexpr size_t WS_WMO = WS_WMKV + 8 * MiB;
constexpr size_t WS_WUP = WS_WMO + 4 * MiB;
constexpr size_t WS_WDN = WS_WUP + 128 * MiB;
constexpr size_t WS_H = WS_WDN + 128 * MiB;
constexpr size_t WS_MB = WS_H + 64 * MiB;
constexpr size_t WS_PROJ = WS_MB + 4 * MiB;
constexpr size_t WS_U = WS_PROJ;
constexpr size_t WS_OD = WS_PROJ + 368 * MiB;
constexpr size_t WS_LSE = WS_OD + 96 * MiB;
constexpr size_t WS_OBR = WS_LSE + 1 * MiB;
constexpr size_t WS_DTMP = WS_OBR + 64 * MiB;
constexpr size_t WS_OA = WS_DTMP + 32 * MiB;
constexpr size_t WS_OBN = WS_OA + 16 * MiB;
constexpr size_t WS_MERGED = WS_OBN + 32 * MiB;
constexpr size_t WS_Y = WS_MERGED + 64 * MiB;
constexpr size_t WS_Q2 = WS_Y + 128 * MiB;
constexpr size_t WS_KV2 = WS_Q2 + 8 * MiB;
constexpr size_t WS_O2 = WS_KV2 + 1 * MiB;
constexpr size_t WS_END = WS_O2 + 8 * MiB;
constexpr int CW_TMO = 0, CW_CODE = 1, CW_BAR = 4096;

constexpr int RING_OFF = 0, RING_BYTES = 131072;
constexpr int LDSCTL_OFF = 133120, MISC_OFF = LDSCTL_OFF + 320;
constexpr int LDS_BYTES = 147456;
constexpr int NWAVES = 8;

#define GAS __attribute__((address_space(1)))
#define LAS __attribute__((address_space(3)))
typedef unsigned short bf16;
typedef unsigned v4u __attribute__((ext_vector_type(4)));
typedef unsigned v2u __attribute__((ext_vector_type(2)));
typedef float f32x4 __attribute__((ext_vector_type(4)));
typedef short bf16x8 __attribute__((ext_vector_type(8)));
typedef GAS unsigned gu32;
#define RLX_AGENT __ATOMIC_RELAXED, __HIP_MEMORY_SCOPE_AGENT
#define LDS_WAIT() asm volatile("s_waitcnt lgkmcnt(0)" ::: "memory")
#define VM_WAIT() asm volatile("s_waitcnt vmcnt(0)" ::: "memory")
__device__ __forceinline__ unsigned f2bf(float f) { unsigned u = __builtin_bit_cast(unsigned, f); return (u + 0x7fffu + ((u >> 16) & 1u)) >> 16; }
__device__ __forceinline__ unsigned pk2(float lo, float hi) { return f2bf(lo) | (f2bf(hi) << 16); }
__device__ __forceinline__ float bf2f(unsigned short b) { return __builtin_bit_cast(float, ((unsigned)b) << 16); }

__device__ const float INV_FREQ[64] = {
1.0f, 0.8659643233600653f, 0.7498942093324559f, 0.6493816315762113f, 0.5623413251903491f, 0.4869675251658631f, 0.4216965034285822f, 0.3651741272548377f,
0.31622776601683794f, 0.27384196342643613f, 0.23713737056616552f, 0.20535250264571459f, 0.1778279410038923f, 0.1539926526059492f, 0.1333521432163324f, 0.11547819846894582f,
0.1f, 0.08659643233600653f, 0.07498942093324558f, 0.06493816315762113f, 0.05623413251903491f, 0.04869675251658631f, 0.04216965034285822f, 0.03651741272548377f,
0.03162277660168379f, 0.027384196342643614f, 0.023713737056616554f, 0.02053525026457146f, 0.01778279410038923f, 0.01539926526059492f, 0.01333521432163324f, 0.011547819846894581f,
0.01f, 0.008659643233600653f, 0.007498942093324558f, 0.006493816315762113f, 0.005623413251903491f, 0.004869675251658631f, 0.004216965034285823f, 0.0036517412725483771f,
0.0031622776601683794f, 0.0027384196342643613f, 0.0023713737056616554f, 0.002053525026457146f, 0.0017782794100389228f, 0.001539926526059492f, 0.001333521432163324f, 0.0011547819846894581f,
0.001f, 0.0008659643233600653f, 0.0007498942093324559f, 0.0006493816315762113f, 0.0005623413251903491f, 0.0004869675251658631f, 0.00042169650342858224f, 0.00036517412725483773f,
0.00031622776601683794f, 0.00027384196342643613f, 0.00023713737056616554f, 0.00020535250264571459f, 0.00017782794100389227f, 0.0001539926526059492f, 0.0001333521432163324f, 0.00011547819846894582f };

#define XB_TMO      128
#define XB_XCNT(j)  (256  + 64 * (j))
#define XB_XSUB(j)  (1280 + 64 * (j))
#define XB_XGEN(j)  (2304 + 64 * (j))
#define XB_TOP      3328
#define XB_TOPGEN   3392
#define XCD_BAR_WORDS 3456
#define XB_SPIN_CAP (1u << 18)
__device__ __forceinline__ unsigned xb_ld(unsigned* p)              { return __hip_atomic_load(p, __ATOMIC_RELAXED, __HIP_MEMORY_SCOPE_AGENT); }
__device__ __forceinline__ unsigned xb_add(unsigned* p, unsigned v) { return __hip_atomic_fetch_add(p, v, __ATOMIC_RELAXED, __HIP_MEMORY_SCOPE_AGENT); }
__device__ __forceinline__ unsigned xb_xcc_id() { return (unsigned)__builtin_amdgcn_s_getreg((3 << 11) | 20) & 0xFu; }
#define XB_SPIN(cond, bar) do { unsigned _sp = 0; while (cond) { __builtin_amdgcn_s_sleep(1); \
    if ((++_sp & 255u) == 0u) { if (xb_ld(&(bar)[XB_TMO])) break; if (_sp > XB_SPIN_CAP) { atomicAdd(&(bar)[XB_TMO], 1u); break; } } } } while (0)
struct XcdBarrier { unsigned* bar; unsigned x; volatile LAS unsigned* st; };
__device__ __forceinline__ XcdBarrier xcd_barrier_post(unsigned* bar, volatile LAS unsigned* st) {
    XcdBarrier b; b.bar = bar; b.x = xb_xcc_id(); b.st = st;
    if (threadIdx.x == 0) (void)xb_add(&bar[XB_XCNT(b.x)], 1u);
    return b;
}
__device__ __forceinline__ void xcd_barrier_complete(unsigned* bar, unsigned x, unsigned& nloc, unsigned& nx) {
    const unsigned G = gridDim.x * gridDim.y * gridDim.z;
    unsigned sum, cnt, mine, sp = 0u;
    for (;;) {
        sum = 0u; cnt = 0u; mine = 0u;
#pragma unroll
        for (unsigned j = 0; j < 16; ++j) { const unsigned c = xb_ld(&bar[XB_XCNT(j)]); sum += c; cnt += (c > 0u) ? 1u : 0u; mine = (j == x) ? c : mine; }
        if (sum == G) break;
        __builtin_amdgcn_s_sleep(1);
        if ((++sp & 255u) == 0u) { if (xb_ld(&bar[XB_TMO])) break; if (sp > XB_SPIN_CAP) { atomicAdd(&bar[XB_TMO], 1u); break; } }
    }
    nloc = mine > 0u ? mine : 1u; nx = cnt > 0u ? cnt : 1u;
}
__device__ __forceinline__ void xcd_barrier(const XcdBarrier& b) {
    asm volatile("s_waitcnt vmcnt(0)" ::: "memory");
    __syncthreads();
    if (threadIdx.x == 0) {
        unsigned* bar = b.bar;
        __builtin_amdgcn_s_waitcnt(0);
        unsigned nloc = b.st[0], nx = b.st[1];
        if (nloc == 0u) { xcd_barrier_complete(bar, b.x, nloc, nx); b.st[0] = nloc; b.st[1] = nx; }
        const unsigned old = xb_add(&bar[XB_XSUB(b.x)], 1u);
        const unsigned gen = old / nloc;
        if (old + 1u == (gen + 1u) * nloc) {
            __builtin_amdgcn_fence(__ATOMIC_RELEASE, "agent");
            asm volatile("s_waitcnt vmcnt(0)" ::: "memory");
            const unsigned og = xb_add(&bar[XB_TOP], 1u);
            const unsigned tg = og / nx;
            if (og + 1u == (tg + 1u) * nx) xb_add(&bar[XB_TOPGEN], 1u);
            else XB_SPIN(xb_ld(&bar[XB_TOPGEN]) == tg, bar);
            __builtin_amdgcn_fence(__ATOMIC_ACQUIRE, "agent");
            xb_add(&bar[XB_XGEN(b.x)], 1u);
            asm volatile("s_waitcnt vmcnt(0)" ::: "memory");
        } else {
            XB_SPIN(xb_ld(&bar[XB_XGEN(b.x)]) == gen, bar);
            __builtin_amdgcn_fence(__ATOMIC_ACQUIRE, "agent");
            asm volatile("s_waitcnt vmcnt(0)" ::: "memory");
        }
    }
    __syncthreads();
}


namespace pg8 {
#define PG8_LAS __attribute__((address_space(3)))
typedef unsigned short bf16_t;
typedef short bf16x8 __attribute__((ext_vector_type(8)));
typedef float f32x4 __attribute__((ext_vector_type(4)));
typedef unsigned u32x4 __attribute__((ext_vector_type(4)));
typedef int i32x4 __attribute__((ext_vector_type(4)));
constexpr int BM = 256, BK = 64, HALF = 128, HTB = HALF * BK * 2, STAGE_BYTES = 8 * HTB, NXCD = 8, WGM = 8;
__host__ __device__ __forceinline__ int lds_byte(int r, int c) { const int st = (r >> 4) * 2 + (c >> 5), rr = r & 15, cc = c & 31, ob = rr * 64 + cc * 2; return st * 1024 + (ob ^ (((ob >> 9) & 1) << 5)); }
__host__ __device__ __forceinline__ void stage_rc(int b, int& R, int& C) { const int st = b / 1024, sb = b % 1024, swz = sb ^ (((sb >> 9) & 1) << 5); R = (st >> 1) * 16 + swz / 64; C = (st & 1) * 32 + (swz % 64) / 2; }
__host__ __device__ __forceinline__ int perm32(int rho) { const int n = rho >> 4, i = rho & 15; return 8 * (i >> 2) + 4 * n + (i & 3); }
struct Unit { int pm, pn; };
struct Gemm { const bf16_t* A; const bf16_t* Bt; int M, N, K, lda, ldb; int rlo = 0, ra0 = 0, ra1 = 0; };
struct StaticOrder {
    int nM, nN, nwg, G, c;
    __host__ __device__ void init(int M, int N, int G_, int c_) { nM = M / BM; nN = N / BM; nwg = nM * nN; G = G_; c = c_; }
    __host__ __device__ bool next(int i, Unit& u) const {
        const long L = (long)i * G + c; if (L >= nwg) return false;
        int wgid = (int)L; { const int q = nwg / NXCD, r = nwg % NXCD, xcd = wgid % NXCD, off = wgid / NXCD; wgid = (xcd < r ? xcd * (q + 1) : r * (q + 1) + (xcd - r) * q) + off; }
        const int nig = WGM * nN, gid = wgid / nig, fm = gid * WGM, gsz = (nM - fm) < WGM ? (nM - fm) : WGM;
        u.pm = fm + ((wgid % nig) % gsz); u.pn = (wgid % nig) / gsz; return true;
    }
    __device__ __forceinline__ void a_ready(const Unit&) const {}
    __device__ __forceinline__ void done(const Unit&) const {}
};
__device__ __forceinline__ unsigned cvt_pk_bf16(float lo, float hi) { unsigned r; asm volatile("v_cvt_pk_bf16_f32 %0, %1, %2" : "=v"(r) : "v"(lo), "v"(hi)); return r;}
struct EpiF32 {
    static constexpr bool PERM = false, AFTER_DRAIN = false, ROPEMAP = false;
    float* C; int ldc;
    __device__ __forceinline__ void operator()(const f32x4 (&acc)[2][2][4][2], const Unit& u, int wr, int wc, int fr, int fq) const {
        const int row0 = u.pm * BM + wr * 64 + fr, col0 = u.pn * BM + wc * 32 + 4 * fq;
#pragma unroll
        for (int ai = 0; ai < 2; ++ai)
#pragma unroll
            for (int m = 0; m < 4; ++m) { float* rowp = C + (size_t)(row0 + ai * HALF + m * 16) * ldc + col0;
#pragma unroll
                for (int bj = 0; bj < 2; ++bj)
#pragma unroll
                    for (int n = 0; n < 2; ++n) *(f32x4*)(rowp + bj * HALF + n * 16) = acc[ai][bj][m][n]; }
    }
};
template <int ACT  > struct EpiBf16 {
    static constexpr bool PERM = true, AFTER_DRAIN = false, ROPEMAP = false;
    bf16_t* O; int ldc;
    __device__ __forceinline__ void operator()(const f32x4 (&acc)[2][2][4][2], const Unit& u, int wr, int wc, int fr, int fq) const {
        const int row0 = u.pm * BM + wr * 64 + fr, col0 = u.pn * BM + wc * 32 + 8 * fq;
#pragma unroll
        for (int ai = 0; ai < 2; ++ai)
#pragma unroll
            for (int m = 0; m < 4; ++m) { bf16_t* rowp = O + (size_t)(row0 + ai * HALF + m * 16) * ldc + col0;
#pragma unroll
                for (int bj = 0; bj < 2; ++bj) { f32x4 v0 = acc[ai][bj][m][0], v1 = acc[ai][bj][m][1];
                    if (ACT == 1) {
#pragma unroll
                        for (int j = 0; j < 4; ++j) { const float a = fmaxf(v0[j], 0.f), b = fmaxf(v1[j], 0.f); v0[j] = a * a; v1[j] = b * b; } }
                    u32x4 w; w.x = cvt_pk_bf16(v0[0], v0[1]); w.y = cvt_pk_bf16(v0[2], v0[3]); w.z = cvt_pk_bf16(v1[0], v1[1]); w.w = cvt_pk_bf16(v1[2], v1[3]);
                    *(u32x4*)(rowp + bj * HALF) = w; } }
    }
};
struct EpiProjI8 {
    static constexpr bool PERM = true, AFTER_DRAIN = false, ROPEMAP = true;
    bf16_t* O; const float* rope; const float* sa; const float* sb;
    __device__ __forceinline__ void operator()(const f32x4 (&acc)[2][2][4][2], const Unit& u, int wr, int wc, int fr, int fq) const {
        const int row0 = u.pm * BM + wr * 64 + fr, cb = u.pn * BM + (wc >> 1) * 128, i0 = (wc & 1) * 32 + 8 * fq;
        const int kind = (u.pn < 24 || (u.pn >= 36 && u.pn < 52)) ? 1 : (u.pn >= 60 ? 2 : 0);
        const f32x4 sa0 = *(const f32x4*)(sb + cb + i0), sa1 = *(const f32x4*)(sb + cb + i0 + 4), sb0 = *(const f32x4*)(sb + cb + 64 + i0), sb1 = *(const f32x4*)(sb + cb + 64 + i0 + 4);
        float srv[8];
#pragma unroll
        for (int i = 0; i < 8; ++i) srv[i] = sa[(size_t)(row0 + (i >> 2) * HALF + (i & 3) * 16)];
#pragma unroll
        for (int am = 0; am < 4; ++am) { const int ai = am >> 1;
            f32x4 rt[4][4];
            if (kind == 1) {
#pragma unroll
                for (int m = 2 * (am & 1); m < 2 * (am & 1) + 2; ++m) { const f32x4* rp = (const f32x4*)(rope + ((size_t)(row0 + ai * HALF + m * 16) * 64 + i0) * 2); rt[m][0] = rp[0]; rt[m][1] = rp[1]; rt[m][2] = rp[2]; rt[m][3] = rp[3]; } }
#pragma unroll
            for (int m = 2 * (am & 1); m < 2 * (am & 1) + 2; ++m) { const size_t r = (size_t)(row0 + ai * HALF + m * 16); bf16_t* rowp = O + r * D_IN + cb + i0; const float sr = srv[ai * 4 + m];
                f32x4 a0 = __builtin_convertvector(__builtin_bit_cast(i32x4, acc[ai][0][m][0]), f32x4) * (sa0 * sr), a1 = __builtin_convertvector(__builtin_bit_cast(i32x4, acc[ai][0][m][1]), f32x4) * (sa1 * sr);
                f32x4 b0 = __builtin_convertvector(__builtin_bit_cast(i32x4, acc[ai][1][m][0]), f32x4) * (sb0 * sr), b1 = __builtin_convertvector(__builtin_bit_cast(i32x4, acc[ai][1][m][1]), f32x4) * (sb1 * sr);
                if (kind == 1) { const f32x4 t0 = rt[m][0], t1 = rt[m][1], t2 = rt[m][2], t3 = rt[m][3];
                    const f32x4 c0 = {t0[0], t0[2], t1[0], t1[2]}, s0 = {t0[1], t0[3], t1[1], t1[3]}, c1 = {t2[0], t2[2], t3[0], t3[2]}, s1 = {t2[1], t2[3], t3[1], t3[3]};
                    const f32x4 na0 = a0 * c0 - b0 * s0, nb0 = b0 * c0 + a0 * s0, na1 = a1 * c1 - b1 * s1, nb1 = b1 * c1 + a1 * s1;
                    a0 = na0; b0 = nb0; a1 = na1; b1 = nb1; }
                if (kind == 2) {
#pragma unroll
                    for (int j = 0; j < 4; ++j) { a0[j] = __builtin_amdgcn_rcpf(1.f + __expf(-a0[j])); a1[j] = __builtin_amdgcn_rcpf(1.f + __expf(-a1[j]));
                                                  b0[j] = __builtin_amdgcn_rcpf(1.f + __expf(-b0[j])); b1[j] = __builtin_amdgcn_rcpf(1.f + __expf(-b1[j])); } }
                u32x4 w; w.x = cvt_pk_bf16(a0[0], a0[1]); w.y = cvt_pk_bf16(a0[2], a0[3]); w.z = cvt_pk_bf16(a1[0], a1[1]); w.w = cvt_pk_bf16(a1[2], a1[3]);
                *(u32x4*)(rowp) = w;
                w.x = cvt_pk_bf16(b0[0], b0[1]); w.y = cvt_pk_bf16(b0[2], b0[3]); w.z = cvt_pk_bf16(b1[0], b1[1]); w.w = cvt_pk_bf16(b1[2], b1[3]);
                *(u32x4*)(rowp + 64) = w; } }
    }
};
typedef unsigned short u16x2 __attribute__((ext_vector_type(2)));
struct EpiI8Relu2 {
    static constexpr bool PERM = true, AFTER_DRAIN = false, ROPEMAP = false;
    bf16_t* O; int ldc; const float* sa; const float* sb; unsigned* umax;
    __device__ __forceinline__ void operator()(const f32x4 (&acc)[2][2][4][2], const Unit& u, int wr, int wc, int fr, int fq) const {
        const int row0 = u.pm * BM + wr * 64 + fr, col0 = u.pn * BM + wc * 32 + 8 * fq;
        f32x4 sbv[2][2];
#pragma unroll
        for (int bj = 0; bj < 2; ++bj) { sbv[bj][0] = *(const f32x4*)(sb + col0 + bj * HALF); sbv[bj][1] = *(const f32x4*)(sb + col0 + bj * HALF + 4); }
        float srv[8];
#pragma unroll
        for (int i = 0; i < 8; ++i) srv[i] = sa[(size_t)(row0 + (i >> 2) * HALF + (i & 3) * 16)];
#pragma unroll
        for (int ai = 0; ai < 2; ++ai)
#pragma unroll
            for (int m = 0; m < 4; ++m) { const size_t r = (size_t)(row0 + ai * HALF + m * 16); const float sr = srv[ai * 4 + m]; bf16_t* rowp = O + r * ldc + col0; u16x2 rp = {0, 0};
#pragma unroll
                for (int bj = 0; bj < 2; ++bj) {
                    f32x4 v0 = __builtin_convertvector(__builtin_bit_cast(i32x4, acc[ai][bj][m][0]), f32x4) * (sbv[bj][0] * sr);
                    f32x4 v1 = __builtin_convertvector(__builtin_bit_cast(i32x4, acc[ai][bj][m][1]), f32x4) * (sbv[bj][1] * sr);
#pragma unroll
                    for (int j = 0; j < 4; ++j) { const float a = fmaxf(v0[j], 0.f), b = fmaxf(v1[j], 0.f); v0[j] = a * a; v1[j] = b * b; }
                    u32x4 w; w.x = cvt_pk_bf16(v0[0], v0[1]); w.y = cvt_pk_bf16(v0[2], v0[3]); w.z = cvt_pk_bf16(v1[0], v1[1]); w.w = cvt_pk_bf16(v1[2], v1[3]);
                    *(u32x4*)(rowp + bj * HALF) = w;
#pragma unroll
                    for (int j = 0; j < 4; ++j) { const unsigned wj = w[j]; rp = __builtin_elementwise_max(rp, __builtin_bit_cast(u16x2, wj)); } }
                unsigned rmx = (unsigned)(rp.x > rp.y ? rp.x : rp.y) << 16;
                { const unsigned a = (unsigned)__shfl_xor((int)rmx, 16); rmx = rmx > a ? rmx : a; const unsigned b = (unsigned)__shfl_xor((int)rmx, 32); rmx = rmx > b ? rmx : b; }
                if (fq == 0) atomicMax(umax + r, rmx); }
    }
};
struct EpiI8Down {
    static constexpr bool PERM = true, AFTER_DRAIN = false, ROPEMAP = false;
    bf16_t* O; int ldc; const float* sa; const float* sb; const int* wsum;
    __device__ __forceinline__ void operator()(const f32x4 (&acc)[2][2][4][2], const Unit& u, int wr, int wc, int fr, int fq) const {
        const int row0 = u.pm * BM + wr * 64 + fr, col0 = u.pn * BM + wc * 32 + 8 * fq;
        f32x4 sbv[2][2], off[2][2];
#pragma unroll
        for (int bj = 0; bj < 2; ++bj)
#pragma unroll
            for (int n = 0; n < 2; ++n) { sbv[bj][n] = *(const f32x4*)(sb + col0 + bj * HALF + 4 * n); off[bj][n] = __builtin_convertvector(*(const i32x4*)(wsum + col0 + bj * HALF + 4 * n), f32x4) * 128.f; }
        float srv[8];
#pragma unroll
        for (int i = 0; i < 8; ++i) srv[i] = sa[(size_t)(row0 + (i >> 2) * HALF + (i & 3) * 16)];
#pragma unroll
        for (int ai = 0; ai < 2; ++ai)
#pragma unroll
            for (int m = 0; m < 4; ++m) { const size_t r = (size_t)(row0 + ai * HALF + m * 16); const float sr = srv[ai * 4 + m]; bf16_t* rowp = O + r * ldc + col0;
#pragma unroll
                for (int bj = 0; bj < 2; ++bj) {
                    const f32x4 v0 = (__builtin_convertvector(__builtin_bit_cast(i32x4, acc[ai][bj][m][0]), f32x4) + off[bj][0]) * (sbv[bj][0] * sr);
                    const f32x4 v1 = (__builtin_convertvector(__builtin_bit_cast(i32x4, acc[ai][bj][m][1]), f32x4) + off[bj][1]) * (sbv[bj][1] * sr);
                    u32x4 w; w.x = cvt_pk_bf16(v0[0], v0[1]); w.y = cvt_pk_bf16(v0[2], v0[3]); w.z = cvt_pk_bf16(v1[0], v1[1]); w.w = cvt_pk_bf16(v1[2], v1[3]);
                    *(u32x4*)(rowp + bj * HALF) = w; } }
    }
};
struct EpiI8Bf16 {
    static constexpr bool PERM = true, AFTER_DRAIN = false, ROPEMAP = false;
    bf16_t* O; int ldc; const float* sa; const float* sb;
    __device__ __forceinline__ void operator()(const f32x4 (&acc)[2][2][4][2], const Unit& u, int wr, int wc, int fr, int fq) const {
        const int row0 = u.pm * BM + wr * 64 + fr, col0 = u.pn * BM + wc * 32 + 8 * fq;
        f32x4 sbv[2][2];
#pragma unroll
        for (int bj = 0; bj < 2; ++bj) { sbv[bj][0] = *(const f32x4*)(sb + col0 + bj * HALF); sbv[bj][1] = *(const f32x4*)(sb + col0 + bj * HALF + 4); }
        float srv[8];
#pragma unroll
        for (int i = 0; i < 8; ++i) srv[i] = sa[(size_t)(row0 + (i >> 2) * HALF + (i & 3) * 16)];
#pragma unroll
        for (int ai = 0; ai < 2; ++ai)
#pragma unroll
            for (int m = 0; m < 4; ++m) { const size_t r = (size_t)(row0 + ai * HALF + m * 16); const float sr = srv[ai * 4 + m]; bf16_t* rowp = O + r * ldc + col0;
#pragma unroll
                for (int bj = 0; bj < 2; ++bj) {
                    const f32x4 v0 = __builtin_convertvector(__builtin_bit_cast(i32x4, acc[ai][bj][m][0]), f32x4) * (sbv[bj][0] * sr);
                    const f32x4 v1 = __builtin_convertvector(__builtin_bit_cast(i32x4, acc[ai][bj][m][1]), f32x4) * (sbv[bj][1] * sr);
                    u32x4 w; w.x = cvt_pk_bf16(v0[0], v0[1]); w.y = cvt_pk_bf16(v0[2], v0[3]); w.z = cvt_pk_bf16(v1[0], v1[1]); w.w = cvt_pk_bf16(v1[2], v1[3]);
                    *(u32x4*)(rowp + bj * HALF) = w; } }
    }
};
__device__ __forceinline__ float bfl(unsigned w) { return __builtin_bit_cast(float, w << 16); }
__device__ __forceinline__ float bfh(unsigned w) { return __builtin_bit_cast(float, w & 0xffff0000u); }
template <bool ADD> struct EpiGate {
    static constexpr bool PERM = true, AFTER_DRAIN = false, ROPEMAP = false;
    bf16_t* O; int ldc; const bf16_t* gate; int ldg;
    __device__ __forceinline__ void operator()(const f32x4 (&acc)[2][2][4][2], const Unit& u, int wr, int wc, int fr, int fq) const {
        const int row0 = u.pm * BM + wr * 64 + fr, col0 = u.pn * BM + wc * 32 + 8 * fq;
#pragma unroll
        for (int am = 0; am < 4; ++am) { const int ai = am >> 1;
            u32x4 gv[4][2], pv[4][2];
#pragma unroll
            for (int m = 2 * (am & 1); m < 2 * (am & 1) + 2; ++m) { const size_t r = (size_t)(row0 + ai * HALF + m * 16);
#pragma unroll
                for (int bj = 0; bj < 2; ++bj) { gv[m][bj] = *(const u32x4*)(gate + r * ldg + col0 + bj * HALF); if (ADD) pv[m][bj] = *(const u32x4*)(O + r * ldc + col0 + bj * HALF); } }
#pragma unroll
            for (int m = 2 * (am & 1); m < 2 * (am & 1) + 2; ++m) { const size_t r = (size_t)(row0 + ai * HALF + m * 16); bf16_t* rowp = O + r * ldc + col0;
#pragma unroll
                for (int bj = 0; bj < 2; ++bj) { f32x4 v0 = acc[ai][bj][m][0], v1 = acc[ai][bj][m][1];
                    const u32x4 g = gv[m][bj];
                    v0[0] *= bfl(g.x); v0[1] *= bfh(g.x); v0[2] *= bfl(g.y); v0[3] *= bfh(g.y); v1[0] *= bfl(g.z); v1[1] *= bfh(g.z); v1[2] *= bfl(g.w); v1[3] *= bfh(g.w);
                    if (ADD) { const u32x4 p = pv[m][bj];
                        v0[0] += bfl(p.x); v0[1] += bfh(p.x); v0[2] += bfl(p.y); v0[3] += bfh(p.y); v1[0] += bfl(p.z); v1[1] += bfh(p.z); v1[2] += bfl(p.w); v1[3] += bfh(p.w); }
                    u32x4 w; w.x = cvt_pk_bf16(v0[0], v0[1]); w.y = cvt_pk_bf16(v0[2], v0[3]); w.z = cvt_pk_bf16(v1[0], v1[1]); w.w = cvt_pk_bf16(v1[2], v1[3]);
                    *(u32x4*)(rowp + bj * HALF) = w; } } }
    }
};
template <bool ADD> struct EpiGateI8 {
    static constexpr bool PERM = true, AFTER_DRAIN = false, ROPEMAP = false;
    bf16_t* O; int ldc; const bf16_t* gate; int ldg; const float* sa; const float* sb;
    __device__ __forceinline__ void operator()(const f32x4 (&acc)[2][2][4][2], const Unit& u, int wr, int wc, int fr, int fq) const {
        const int row0 = u.pm * BM + wr * 64 + fr, col0 = u.pn * BM + wc * 32 + 8 * fq;
        f32x4 sbv[2][2];
#pragma unroll
        for (int bj = 0; bj < 2; ++bj) { sbv[bj][0] = *(const f32x4*)(sb + col0 + bj * HALF); sbv[bj][1] = *(const f32x4*)(sb + col0 + bj * HALF + 4); }
        float srv[8];
#pragma unroll
        for (int i = 0; i < 8; ++i) srv[i] = sa[(size_t)(row0 + (i >> 2) * HALF + (i & 3) * 16)];
#pragma unroll
        for (int ai = 0; ai < 2; ++ai) {
            u32x4 gv[4][2], pv[4][2];
#pragma unroll
            for (int m = 0; m < 4; ++m) { const size_t r = (size_t)(row0 + ai * HALF + m * 16);
#pragma unroll
                for (int bj = 0; bj < 2; ++bj) { gv[m][bj] = *(const u32x4*)(gate + r * ldg + col0 + bj * HALF); if (ADD) pv[m][bj] = *(const u32x4*)(O + r * ldc + col0 + bj * HALF); } }
#pragma unroll
            for (int m = 0; m < 4; ++m) { const size_t r = (size_t)(row0 + ai * HALF + m * 16); bf16_t* rowp = O + r * ldc + col0; const float sr = srv[ai * 4 + m];
#pragma unroll
                for (int bj = 0; bj < 2; ++bj) {
                    f32x4 v0 = __builtin_convertvector(__builtin_bit_cast(i32x4, acc[ai][bj][m][0]), f32x4) * (sbv[bj][0] * sr);
                    f32x4 v1 = __builtin_convertvector(__builtin_bit_cast(i32x4, acc[ai][bj][m][1]), f32x4) * (sbv[bj][1] * sr);
                    const u32x4 g = gv[m][bj];
                    v0[0] *= bfl(g.x); v0[1] *= bfh(g.x); v0[2] *= bfl(g.y); v0[3] *= bfh(g.y); v1[0] *= bfl(g.z); v1[1] *= bfh(g.z); v1[2] *= bfl(g.w); v1[3] *= bfh(g.w);
                    if (ADD) { const u32x4 p = pv[m][bj];
                        v0[0] += bfl(p.x); v0[1] += bfh(p.x); v0[2] += bfl(p.y); v0[3] += bfh(p.y); v1[0] += bfl(p.z); v1[1] += bfh(p.z); v1[2] += bfl(p.w); v1[3] += bfh(p.w); }
                    u32x4 w; w.x = cvt_pk_bf16(v0[0], v0[1]); w.y = cvt_pk_bf16(v0[2], v0[3]); w.z = cvt_pk_bf16(v1[0], v1[1]); w.w = cvt_pk_bf16(v1[2], v1[3]);
                    *(u32x4*)(rowp + bj * HALF) = w; } } }
    }
};
template <bool NOROPE = false> struct EpiProj {
    static constexpr bool PERM = true, AFTER_DRAIN = false, ROPEMAP = true;
    bf16_t* O; const float* rope; float sc;
    __device__ __forceinline__ void operator()(const f32x4 (&acc)[2][2][4][2], const Unit& u, int wr, int wc, int fr, int fq) const {
        const int row0 = u.pm * BM + wr * 64 + fr, cb = u.pn * BM + (wc >> 1) * 128, i0 = (wc & 1) * 32 + 8 * fq;
        const int kind = NOROPE ? (u.pn >= 60 ? 2 : 0) : ((u.pn < 24 || (u.pn >= 36 && u.pn < 52)) ? 1 : (u.pn >= 60 ? 2 : 0));
#pragma unroll
        for (int am = 0; am < 4; ++am) { const int ai = am >> 1;
            f32x4 rt[4][4];
            if (!NOROPE && kind == 1) {
#pragma unroll
                for (int m = 2 * (am & 1); m < 2 * (am & 1) + 2; ++m) { const f32x4* rp = (const f32x4*)(rope + ((size_t)(row0 + ai * HALF + m * 16) * 64 + i0) * 2); rt[m][0] = rp[0]; rt[m][1] = rp[1]; rt[m][2] = rp[2]; rt[m][3] = rp[3]; } }
#pragma unroll
            for (int m = 2 * (am & 1); m < 2 * (am & 1) + 2; ++m) { const size_t r = (size_t)(row0 + ai * HALF + m * 16); bf16_t* rowp = O + r * D_IN + cb + i0;
                f32x4 a0 = acc[ai][0][m][0] * sc, a1 = acc[ai][0][m][1] * sc, b0 = acc[ai][1][m][0] * sc, b1 = acc[ai][1][m][1] * sc;
                if (!NOROPE && kind == 1) { const f32x4 t0 = rt[m][0], t1 = rt[m][1], t2 = rt[m][2], t3 = rt[m][3];
                    const f32x4 c0 = {t0[0], t0[2], t1[0], t1[2]}, s0 = {t0[1], t0[3], t1[1], t1[3]}, c1 = {t2[0], t2[2], t3[0], t3[2]}, s1 = {t2[1], t2[3], t3[1], t3[3]};
                    const f32x4 na0 = a0 * c0 - b0 * s0, nb0 = b0 * c0 + a0 * s0, na1 = a1 * c1 - b1 * s1, nb1 = b1 * c1 + a1 * s1;
                    a0 = na0; b0 = nb0; a1 = na1; b1 = nb1; }
                if (kind == 2) {
#pragma unroll
                    for (int j = 0; j < 4; ++j) { a0[j] = __builtin_amdgcn_rcpf(1.f + __expf(-a0[j])); a1[j] = __builtin_amdgcn_rcpf(1.f + __expf(-a1[j]));
                                                  b0[j] = __builtin_amdgcn_rcpf(1.f + __expf(-b0[j])); b1[j] = __builtin_amdgcn_rcpf(1.f + __expf(-b1[j])); } }
                u32x4 w; w.x = cvt_pk_bf16(a0[0], a0[1]); w.y = cvt_pk_bf16(a0[2], a0[3]); w.z = cvt_pk_bf16(a1[0], a1[1]); w.w = cvt_pk_bf16(a1[2], a1[3]);
                *(u32x4*)(rowp) = w;
                w.x = cvt_pk_bf16(b0[0], b0[1]); w.y = cvt_pk_bf16(b0[2], b0[3]); w.z = cvt_pk_bf16(b1[0], b1[1]); w.w = cvt_pk_bf16(b1[2], b1[3]);
                *(u32x4*)(rowp + 64) = w; } }
    }
};

typedef int i32x8 __attribute__((ext_vector_type(8)));
typedef float f32x8 __attribute__((ext_vector_type(8)));
template <class Epi, class Sched, bool ALIGN_EPI = false, bool SP2 = false, bool FP8 = false, bool I8 = false>
__device__ __forceinline__ void gemm_phase(PG8_LAS unsigned char* lds, const Gemm g, const Sched& S, const Epi& E) {
    int tid = threadIdx.x; asm volatile("" : "+v"(tid));
    const int wid = __builtin_amdgcn_readfirstlane(tid >> 6), lane = tid & 63, wr = wid >> 2, wc = wid & 3, fr = lane & 15, fq = lane >> 4;
    constexpr int ESZ = (FP8 || I8) ? 1 : 2;
    const int K = g.K, nt = K / ((FP8 || I8) ? 2 * BK : BK);
    unsigned voffA[2], voffB[2];
#pragma unroll
    for (int i = 0; i < 2; ++i) { int R, C; stage_rc(tid * 16 + i * 8192, R, C); int Rb = Epi::PERM ? ((R & ~31) + perm32(R & 31)) : R;
        if (Epi::ROPEMAP) Rb = (Rb >> 6) * 128 + (Rb & 63);
        voffA[i] = (unsigned)(R * g.lda * ESZ + C * 2); voffB[i] = (unsigned)(Rb * g.ldb * ESZ + C * 2); }
    const size_t kstep = (size_t)(BK * 2);
    const size_t hstepA = (size_t)HALF * g.lda * ESZ, hstepB = (size_t)(Epi::ROPEMAP ? 64 : HALF) * g.ldb * ESZ;
    const size_t tstepA = (size_t)BM * g.lda * ESZ, tstepB = (size_t)BM * g.ldb * ESZ;
    const unsigned ldsw = (unsigned)wid * 1024u;
    const int aoff = lds_byte(wr * 64 + fr, fq * 8), boff = lds_byte(wc * 32 + fr, fq * 8);
#define PG8_SA(b, h) (((b) * 2 + (h)) * HTB)
#define PG8_SB(b, h) ((4 + (b) * 2 + (h)) * HTB)
#define PG8_STAGE(bufoff, gbase, voff) do { if constexpr (FP8) { int t_ = tid; asm volatile("" : "+v"(t_));     \
            _Pragma("unroll") for (int _i = 0; _i < 2; ++_i) { int R_, C_; stage_rc(t_ * 16 + _i * 8192, R_, C_); int Rb_ = ((&(voff)[0] == &voffB[0]) && Epi::PERM) ? ((R_ & ~31) + perm32(R_ & 31)) : R_; \
                if ((&(voff)[0] == &voffB[0]) && Epi::ROPEMAP) Rb_ = (Rb_ >> 6) * 128 + (Rb_ & 63); const unsigned o_ = (unsigned)(Rb_ * ((&(voff)[0] == &voffB[0]) ? g.ldb : g.lda) * ESZ + C_ * 2); \
                __builtin_amdgcn_global_load_lds((const unsigned*)((const char*)(gbase) + o_), (PG8_LAS unsigned*)(lds + (bufoff) + ldsw + _i * 8192), 16, 0, 0); } } \
        else { _Pragma("unroll") for (int _i = 0; _i < 2; ++_i) \
        __builtin_amdgcn_global_load_lds((const unsigned*)((const char*)(gbase) + (voff)[_i]), (PG8_LAS unsigned*)(lds + (bufoff) + ldsw + _i * 8192), 16, 0, 0); } } while (0)
#define PG8_LD8(X) __builtin_shufflevector(__builtin_bit_cast(f32x4, X[0]), __builtin_bit_cast(f32x4, X[1]), 0, 1, 2, 3, 4, 5, 6, 7)
#define PG8_LDA(dst, b, h) do { _Pragma("unroll") for (int m = 0; m < 4; ++m) _Pragma("unroll") for (int k = 0; k < 2; ++k) dst[m][k] = *(const PG8_LAS bf16x8*)(lds + PG8_SA(b, h) + aoff + m * 2048 + k * 1024); \
        if constexpr (FP8) { _Pragma("unroll") for (int m = 0; m < 4; ++m) dst##8[m] = PG8_LD8(dst[m]); } } while (0)
#define PG8_LDB(dst, b, h) do { _Pragma("unroll") for (int n = 0; n < 2; ++n) _Pragma("unroll") for (int k = 0; k < 2; ++k) dst[n][k] = *(const PG8_LAS bf16x8*)(lds + PG8_SB(b, h) + boff + n * 2048 + k * 1024); \
        if constexpr (FP8) { _Pragma("unroll") for (int n = 0; n < 2; ++n) dst##8[n] = PG8_LD8(dst[n]); } } while (0)
#define PG8_MMA(ai, bj, At, Bt) do { __builtin_amdgcn_s_setprio(1); _Pragma("unroll") for (int m = 0; m < 4; ++m) _Pragma("unroll") for (int n = 0; n < 2; ++n) { \
        if constexpr (FP8) acc[ai][bj][m][n] = __builtin_amdgcn_mfma_scale_f32_16x16x128_f8f6f4(__builtin_bit_cast(i32x8, Bt##8[n]), __builtin_bit_cast(i32x8, At##8[m]), acc[ai][bj][m][n], 0, 0, 0, 0, 0, 0); \
        else if constexpr (I8) { _Pragma("unroll") for (int k = 0; k < 2; ++k) acc[ai][bj][m][n] = __builtin_bit_cast(f32x4, __builtin_amdgcn_mfma_i32_16x16x64_i8(__builtin_bit_cast(i32x4, Bt[n][k]), __builtin_bit_cast(i32x4, At[m][k]), __builtin_bit_cast(i32x4, acc[ai][bj][m][n]), 0, 0, 0)); } \
        else { _Pragma("unroll") for (int k = 0; k < 2; ++k) acc[ai][bj][m][n] = __builtin_amdgcn_mfma_f32_16x16x32_bf16(Bt[n][k], At[m][k], acc[ai][bj][m][n], 0, 0, 0); } } __builtin_amdgcn_s_setprio(0); } while (0)
#define PG8_WAIT_V(n) asm volatile("s_waitcnt vmcnt(" #n ")" ::: "memory")
#define PG8_WAIT_L(n) asm volatile("s_waitcnt lgkmcnt(" #n ")" ::: "memory")
#define PG8_BAR __builtin_amdgcn_s_barrier()
#define PG8_SCHED __builtin_amdgcn_sched_barrier(0)
    Unit cur, nxt; int ui = 0;
    if (!S.next(0, cur)) return;
    f32x4 acc[2][2][4][2];
#pragma unroll
    for (int a = 0; a < 2; ++a)
#pragma unroll
        for (int b = 0; b < 2; ++b)
#pragma unroll
            for (int m = 0; m < 4; ++m)
#pragma unroll
                for (int n = 0; n < 2; ++n) acc[a][b][m][n] = (f32x4){0.f, 0.f, 0.f, 0.f};
    bf16x8 At[4][2], B0[2][2], B1[2][2]; f32x8 At8[4], B08[2], B18[2];
    const char* cA = (const char*)g.A + (size_t)cur.pm * tstepA; const char* cB = (const char*)g.Bt + (size_t)cur.pn * tstepB;
    S.a_ready(cur);
    if constexpr (SP2) {
        PG8_STAGE(PG8_SB(0, 0), cB, voffB); PG8_STAGE(PG8_SB(0, 1), cB + hstepB, voffB); PG8_STAGE(PG8_SA(0, 0), cA, voffA); PG8_STAGE(PG8_SA(0, 1), cA + hstepA, voffA);
        if (wr == 1) PG8_BAR;
        PG8_WAIT_V(2); PG8_BAR;
        PG8_STAGE(PG8_SB(1, 0), cB + kstep, voffB); PG8_STAGE(PG8_SA(1, 0), cA + kstep, voffA); PG8_STAGE(PG8_SB(1, 1), cB + hstepB + kstep, voffB);
        PG8_WAIT_V(6); PG8_BAR;
    } else {
        PG8_STAGE(PG8_SB(0, 0), cB, voffB); PG8_STAGE(PG8_SA(0, 0), cA, voffA); PG8_STAGE(PG8_SB(0, 1), cB + hstepB, voffB); PG8_STAGE(PG8_SA(0, 1), cA + hstepA, voffA);
        if (wr == 1) PG8_BAR;
        PG8_WAIT_V(4); PG8_BAR;
        PG8_STAGE(PG8_SB(1, 0), cB + kstep, voffB); PG8_STAGE(PG8_SA(1, 0), cA + kstep, voffA); PG8_STAGE(PG8_SB(1, 1), cB + hstepB + kstep, voffB);
        PG8_WAIT_V(6); PG8_BAR;
    }
    for (;;) {
        const bool has_next = S.next(ui + 1, nxt);
        const char* nA = has_next ? (const char*)g.A + (size_t)nxt.pm * tstepA : cA; const char* nB = has_next ? (const char*)g.Bt + (size_t)nxt.pn * tstepB : cB;
        for (int t = 0; t < nt; t += 2) {
            const bool last = (t == nt - 2);
            const char* a1 = cA + (size_t)(t + 1) * kstep;
            const char* a2 = last ? nA : cA + (size_t)(t + 2) * kstep; const char* b2 = last ? nB : cB + (size_t)(t + 2) * kstep;
            const char* a3 = a2 + kstep; const char* b3 = b2 + kstep;
            if (last && has_next) S.a_ready(nxt);
            if constexpr (SP2) {
            PG8_LDB(B0, 0, 0); PG8_LDB(B1, 0, 1); PG8_SCHED; PG8_LDA(At, 0, 0); PG8_STAGE(PG8_SA(1, 1), a1 + hstepA, voffA);
            PG8_WAIT_V(8); PG8_WAIT_L(0); PG8_BAR; PG8_MMA(0, 0, At, B0); PG8_MMA(0, 1, At, B1); PG8_BAR; PG8_SCHED;
            PG8_LDA(At, 0, 1); PG8_STAGE(PG8_SB(0, 0), b2, voffB); PG8_STAGE(PG8_SB(0, 1), b2 + hstepB, voffB); PG8_STAGE(PG8_SA(0, 0), a2, voffA);
            PG8_WAIT_V(8); PG8_WAIT_L(0); PG8_BAR; PG8_MMA(1, 0, At, B0); PG8_MMA(1, 1, At, B1); PG8_BAR; PG8_SCHED;
            PG8_LDB(B0, 1, 0); PG8_LDB(B1, 1, 1); PG8_SCHED; PG8_LDA(At, 1, 0); PG8_STAGE(PG8_SA(0, 1), a2 + hstepA, voffA);
            PG8_WAIT_V(8); PG8_WAIT_L(0); PG8_BAR; PG8_MMA(0, 0, At, B0); PG8_MMA(0, 1, At, B1); PG8_BAR; PG8_SCHED;
            PG8_LDA(At, 1, 1); PG8_STAGE(PG8_SB(1, 0), b3, voffB); PG8_STAGE(PG8_SB(1, 1), b3 + hstepB, voffB); PG8_STAGE(PG8_SA(1, 0), a3, voffA);
            PG8_WAIT_V(8); PG8_WAIT_L(0); PG8_BAR; PG8_MMA(1, 0, At, B0); PG8_MMA(1, 1, At, B1); PG8_BAR; PG8_SCHED;
            } else {
            PG8_LDB(B0, 0, 0); PG8_SCHED; PG8_LDA(At, 0, 0); PG8_STAGE(PG8_SA(1, 1), a1 + hstepA, voffA);
            PG8_WAIT_L(8); PG8_BAR; PG8_WAIT_L(0); PG8_MMA(0, 0, At, B0); PG8_BAR; PG8_SCHED;
            PG8_LDB(B1, 0, 1); PG8_STAGE(PG8_SB(0, 0), b2, voffB);
            PG8_BAR; PG8_WAIT_L(0); PG8_MMA(0, 1, At, B1); PG8_BAR;
            PG8_LDA(At, 0, 1); PG8_STAGE(PG8_SA(0, 0), a2, voffA);
            PG8_BAR; PG8_WAIT_L(0); PG8_MMA(1, 0, At, B0); PG8_BAR; PG8_SCHED;
            PG8_STAGE(PG8_SB(0, 1), b2 + hstepB, voffB);
            PG8_WAIT_V(6); PG8_BAR; PG8_MMA(1, 1, At, B1); PG8_BAR;
            PG8_LDB(B0, 1, 0); PG8_SCHED; PG8_LDA(At, 1, 0); PG8_STAGE(PG8_SA(0, 1), a2 + hstepA, voffA);
            PG8_WAIT_L(8); PG8_BAR; PG8_WAIT_L(0); PG8_MMA(0, 0, At, B0); PG8_BAR; PG8_SCHED;
            PG8_LDB(B1, 1, 1); PG8_STAGE(PG8_SB(1, 0), b3, voffB);
            PG8_BAR; PG8_WAIT_L(0); PG8_MMA(0, 1, At, B1); PG8_BAR;
            PG8_LDA(At, 1, 1); PG8_STAGE(PG8_SA(1, 0), a3, voffA);
            PG8_BAR; PG8_WAIT_L(0); PG8_MMA(1, 0, At, B0); PG8_BAR; PG8_SCHED;
            PG8_STAGE(PG8_SB(1, 1), b3 + hstepB, voffB);
            PG8_WAIT_V(6); PG8_BAR; PG8_MMA(1, 1, At, B1); PG8_BAR;
            }
        }
        if constexpr (ALIGN_EPI) { if (wr == 0) PG8_BAR; }
        { Unit eu = cur; eu.pn += (cur.pn < g.rlo) ? g.ra0 : g.ra1; int le = lane; asm volatile("" : "+v"(le));
          E(acc, eu, wr, wc, le & 15, le >> 4); } S.done(cur);
        if (!has_next) break;
#pragma unroll
        for (int a = 0; a < 2; ++a)
#pragma unroll
            for (int b = 0; b < 2; ++b)
#pragma unroll
                for (int m = 0; m < 4; ++m)
#pragma unroll
                    for (int n = 0; n < 2; ++n) acc[a][b][m][n] = (f32x4){0.f, 0.f, 0.f, 0.f};
        cur = nxt; cA = nA; cB = nB; ++ui;
        if constexpr (ALIGN_EPI) { if (wr == 1) PG8_BAR; }
    }
    PG8_WAIT_V(0);
    if constexpr (!ALIGN_EPI) { if (wr == 0) PG8_BAR; }
    PG8_BAR;
#undef PG8_SA
#undef PG8_SB
#undef PG8_STAGE
#undef PG8_LDA
#undef PG8_LDB
#undef PG8_MMA
#undef PG8_LD8
#undef PG8_WAIT_V
#undef PG8_WAIT_L
#undef PG8_BAR
#undef PG8_SCHED
}
}


namespace att {
constexpr int D = 128, NW = 8, QBLK = 32, KVBLK = 64;
constexpr float SCALE = 0.088388347648318440f;
constexpr float THR = 8.f;
constexpr float NEG_BIG = -1.2676506002282294e30f;
constexpr size_t SHM_V = KVBLK * D * 2, SHM_K = KVBLK * D * 2, SHM_Q = 2 * SHM_V + 2 * SHM_K + NW * 64 * 4  , SHM_ATTN = SHM_Q + NW * 8192;
using bf16x8 = __attribute__((ext_vector_type(8))) short;
using s16x4  = __attribute__((ext_vector_type(4))) short;
using f32x16 = __attribute__((ext_vector_type(16))) float;
using u32x4  = __attribute__((ext_vector_type(4))) unsigned;
#define KSWZ(row, colB) ((row) * 256 + ((colB) ^ (((row) & 7) << 4)))
#define SBAR() __builtin_amdgcn_sched_barrier(0)
__device__ __forceinline__ int crow(int r, int hi) { return (r & 3) + 8 * (r >> 2) + 4 * hi; }
__device__ __forceinline__ unsigned cvtpk(float lo, float hi) { unsigned r; asm volatile("v_cvt_pk_bf16_f32 %0, %1, %2" : "=v"(r) : "v"(lo), "v"(hi)); return r; }
__device__ __forceinline__ void partialSM(f32x16& p0, f32x16& p1, float& m_reg, float& mn, float& alpha) {
  constexpr float C = SCALE * 1.4426950408889634f;
  float pmax = p0[0]; for (int r = 1; r < 16; ++r) pmax = fmaxf(pmax, p0[r]); for (int r = 0; r < 16; ++r) pmax = fmaxf(pmax, p1[r]);
  { auto rr = __builtin_amdgcn_permlane32_swap(__float_as_uint(pmax), __float_as_uint(pmax), false, false);
    pmax = fmaxf(__uint_as_float(rr[0]), __uint_as_float(rr[1])); }
  if (__builtin_expect(__all(pmax - m_reg <= THR / SCALE), 1)) { mn = m_reg; alpha = 1.f; }
  else { mn = fmaxf(m_reg, pmax); alpha = __builtin_amdgcn_exp2f((m_reg - mn) * C); m_reg = mn; }
  float mnC = -mn * C;
  for (int r = 0; r < 16; ++r) p0[r] = fmaf(p0[r], C, mnC); for (int r = 0; r < 16; ++r) p1[r] = fmaf(p1[r], C, mnC);
  for (int r = 0; r < 16; ++r) p0[r] = __builtin_amdgcn_exp2f(p0[r]);
}
__device__ __forceinline__ void bandmask(f32x16& p0, f32x16& p1, int kt0, int qi, int hi) {
#pragma unroll
  for (int r = 0; r < 16; ++r) { const int d0 = kt0 + crow(r, hi) - qi, d1 = d0 + 32;
    p0[r] = (d0 > 64 || d0 < -64) ? NEG_BIG : p0[r]; p1[r] = (d1 > 64 || d1 < -64) ? NEG_BIG : p1[r]; }
}
__device__ __forceinline__ void finishSM(f32x16& p0, f32x16& p1, float alpha, float& l_reg, bf16x8& pa0, bf16x8& pa1, bf16x8& pa2, bf16x8& pa3) {
  for (int r = 0; r < 16; ++r) p1[r] = __builtin_amdgcn_exp2f(p1[r]);
  float ps = 0; for (int r = 0; r < 16; ++r) ps += p0[r]; for (int r = 0; r < 16; ++r) ps += p1[r];
  { auto rr = __builtin_amdgcn_permlane32_swap(__float_as_uint(ps), __float_as_uint(ps), false, false);
    ps = __uint_as_float(rr[0]) + __uint_as_float(rr[1]); }
  l_reg = l_reg * alpha + ps;
#define PK4(P, BASE, OUT) do { unsigned a0 = cvtpk(P[BASE + 0], P[BASE + 1]), a1 = cvtpk(P[BASE + 2], P[BASE + 3]);   \
    unsigned b0 = cvtpk(P[BASE + 4], P[BASE + 5]), b1 = cvtpk(P[BASE + 6], P[BASE + 7]);                              \
    auto r0 = __builtin_amdgcn_permlane32_swap(a0, b0, false, false); auto r1 = __builtin_amdgcn_permlane32_swap(a1, b1, false, false); \
    u32x4 w = {r0[0], r1[0], r0[1], r1[1]}; OUT = *reinterpret_cast<bf16x8*>(&w); } while (0)
  PK4(p0, 0, pa0); PK4(p0, 8, pa1); PK4(p1, 0, pa2); PK4(p1, 8, pa3);
#undef PK4
}
template <bool QREG>
__device__ __forceinline__ void qkt(f32x16& p0, f32x16& p1, const bf16* Ks, const char* qs, const bf16x8* qv, int r32, int hi) {
  p0 = f32x16{}; p1 = f32x16{};
#pragma unroll
  for (int d0 = 0; d0 < 8; ++d0) { int cb = (d0 * 16 + hi * 8) * 2;
    bf16x8 b0 = *reinterpret_cast<const bf16x8*>((const char*)Ks + KSWZ(r32, cb));
    bf16x8 b1 = *reinterpret_cast<const bf16x8*>((const char*)Ks + KSWZ(32 + r32, cb));
    bf16x8 q; if (QREG) q = qv[d0]; else q = *reinterpret_cast<const bf16x8*>(qs + d0 * 1024);
    p0 = __builtin_amdgcn_mfma_f32_32x32x16_bf16(b0, q, p0, 0, 0, 0);
    p1 = __builtin_amdgcn_mfma_f32_32x32x16_bf16(b1, q, p1, 0, 0, 0); }
}
__device__ __forceinline__ int v_st(int k, int c) { const int kk = (k & ~0xC) | ((k & 4) << 1) | ((k & 8) >> 1); return ((kk >> 3) * 4 + (c >> 5)) * 512 + ((kk & 7) * 32 + (c & 31)) * 2; }
__device__ __forceinline__ int v_rd_base(int lane) { return ((lane & 3) << 3) | (((lane >> 2) & 3) << 6) | (((lane >> 4) & 1) << 5) | (((lane >> 5) & 1) << 8); }
constexpr int v_rd_off(int d0, int ks, int half) { return d0 * 512 + ks * 4096 + half * 2048; }
template <int OFF> __device__ __forceinline__ s16x4 tr_read(int vb) {
  s16x4 r; asm volatile("ds_read_b64_tr_b16 %0, %1 offset:%2" : "=&v"(r) : "v"(vb), "i"(OFF) : "memory"); return r;
}
template <int D0> __device__ __forceinline__ void pv_one(f32x16& od, int vb, bf16x8 pa0, bf16x8 pa1, bf16x8 pa2, bf16x8 pa3) {
  const s16x4 l0 = tr_read<v_rd_off(D0, 0, 0)>(vb), h0 = tr_read<v_rd_off(D0, 0, 1)>(vb), l1 = tr_read<v_rd_off(D0, 1, 0)>(vb), h1 = tr_read<v_rd_off(D0, 1, 1)>(vb);
  const s16x4 l2 = tr_read<v_rd_off(D0, 2, 0)>(vb), h2 = tr_read<v_rd_off(D0, 2, 1)>(vb), l3 = tr_read<v_rd_off(D0, 3, 0)>(vb), h3 = tr_read<v_rd_off(D0, 3, 1)>(vb);
  asm volatile("s_waitcnt lgkmcnt(0)" ::: "memory"); SBAR();
#define PK(L, H) (bf16x8){L[0], L[1], L[2], L[3], H[0], H[1], H[2], H[3]}
  od = __builtin_amdgcn_mfma_f32_32x32x16_bf16(pa0, PK(l0, h0), od, 0, 0, 0);
  od = __builtin_amdgcn_mfma_f32_32x32x16_bf16(pa1, PK(l1, h1), od, 0, 0, 0);
  od = __builtin_amdgcn_mfma_f32_32x32x16_bf16(pa2, PK(l2, h2), od, 0, 0, 0);
  od = __builtin_amdgcn_mfma_f32_32x32x16_bf16(pa3, PK(l3, h3), od, 0, 0, 0);
#undef PK
}
__device__ __forceinline__ void pv_d0(f32x16* o, int vb, bf16x8 pa0, bf16x8 pa1, bf16x8 pa2, bf16x8 pa3) {
  pv_one<0>(o[0], vb, pa0, pa1, pa2, pa3); pv_one<1>(o[1], vb, pa0, pa1, pa2, pa3); pv_one<2>(o[2], vb, pa0, pa1, pa2, pa3); pv_one<3>(o[3], vb, pa0, pa1, pa2, pa3);
}
template <bool BAND, bool QREG>
__device__ __forceinline__ void body(const bf16* __restrict__ Qb, long ldq, const bf16* __restrict__ Kh, const bf16* __restrict__ Vh, long ldk, int NT, int qrel,
                                     char* lds, f32x16 (&o)[4], float& m_reg, float& l_reg) {
  const int tid = threadIdx.x, wid = tid >> 6, lane = tid & 63, r32 = lane & 31, hi = lane >> 5;
  bf16* V_lds = (bf16*)lds; bf16* K_lds = (bf16*)(lds + 2 * SHM_V);
  float* ws = (float*)(lds + 2 * SHM_V + 2 * SHM_K) + wid * 64; float* al_l = ws + 32;
  m_reg = NEG_BIG; l_reg = 0;
#pragma unroll
  for (int d = 0; d < 4; ++d) o[d] = f32x16{};
  char* qr = lds + SHM_Q + wid * 8192 + lane * 16;
  bf16x8 qv[8];
  { int tq = tid; asm volatile("" : "+v"(tq));
    const unsigned qo = (unsigned)((((tq >> 6) << 5) | (tq & 31)) * (int)ldq + ((tq >> 5) & 1) * 8) * 2u;
#pragma unroll
    for (int d0 = 0; d0 < 8; ++d0) { const bf16x8 t = *reinterpret_cast<const bf16x8*>((const char*)Qb + qo + d0 * 32); if (QREG) qv[d0] = t; else *reinterpret_cast<bf16x8*>(qr + d0 * 1024) = t; } }
  const int qi = qrel + wid * QBLK + r32;
  const int sr = tid >> 4, sc = (tid & 15) * 8, vst0 = v_st(sr, sc), vst1 = v_st(32 + sr, sc);
  const int vb0 = (int)(uintptr_t)V_lds + v_rd_base(lane);
  const unsigned ko0 = (unsigned)(sr * (int)ldk + sc) * 2u, ko1 = ko0 + (unsigned)(64 * (int)ldk);
  struct { bf16x8 vs0, vs1, ks0, ks1; } sr_[2];
#define SLOAD(i, k0) do { const long _t = (long)(k0) * ldk * 2; const char* _kt = (const char*)Kh + _t; const char* _vt = (const char*)Vh + _t; \
    sr_[i].vs0 = *reinterpret_cast<const bf16x8*>(_vt + ko0); sr_[i].vs1 = *reinterpret_cast<const bf16x8*>(_vt + ko1); \
    sr_[i].ks0 = *reinterpret_cast<const bf16x8*>(_kt + ko0); sr_[i].ks1 = *reinterpret_cast<const bf16x8*>(_kt + ko1); } while (0)
#define SWRITE(b, i) do { *(bf16x8*)((char*)V_lds + (b) * SHM_V + vst0) = sr_[i].vs0;          \
    *(bf16x8*)((char*)V_lds + (b) * SHM_V + vst1) = sr_[i].vs1; int kc = sc * 2;               \
    *(bf16x8*)((char*)K_lds + (b) * SHM_K + KSWZ(sr, kc)) = sr_[i].ks0;                       \
    *(bf16x8*)((char*)K_lds + (b) * SHM_K + KSWZ(32 + sr, kc)) = sr_[i].ks1; } while (0)
#define SWAIT() asm volatile("s_waitcnt vmcnt(4)" ::: "memory")
#define RESC(a) do { if (__any((a) < 1.f)) { if (hi == 0) al_l[r32] = (a); asm volatile("s_waitcnt lgkmcnt(0)" ::: "memory"); \
    for (int d = 0; d < 4; ++d) for (int r = 0; r < 16; ++r) o[d][r] *= al_l[crow(r, hi)]; } } while (0)
  f32x16 pA0, pA1, pB0, pB1; float mnA, mnB, alA, alB; bf16x8 pa0, pa1, pa2, pa3;
  constexpr int SE = 0, SO = 1;
  SLOAD(SE, 0); asm volatile("s_waitcnt vmcnt(0)" ::: "memory"); SWRITE(0, SE); __syncthreads();
  qkt<QREG>(pA0, pA1, K_lds, qr, qv, r32, hi); if (BAND) bandmask(pA0, pA1, 0, qi, hi); partialSM(pA0, pA1, m_reg, mnA, alA);
  SLOAD(SO, KVBLK); if (2 < NT) SLOAD(SE, 2 * KVBLK);
  SWAIT(); SWRITE(1, SO); __syncthreads();
  for (int j = 1; j + 1 < NT; j += 2) {
    SBAR(); qkt<QREG>(pB0, pB1, (bf16*)((char*)K_lds + SHM_K), qr, qv, r32, hi); if (BAND) bandmask(pB0, pB1, 64 * j, qi, hi);
    finishSM(pA0, pA1, alA, l_reg, pa0, pa1, pa2, pa3); SBAR();
    SLOAD(SO, (j + 2) * KVBLK); SBAR();
    pv_d0(o, vb0, pa0, pa1, pa2, pa3); partialSM(pB0, pB1, m_reg, mnB, alB);
    __syncthreads(); SWAIT(); SWRITE(0, SE);
    RESC(alB); __syncthreads();
    SBAR(); qkt<QREG>(pA0, pA1, K_lds, qr, qv, r32, hi); if (BAND) bandmask(pA0, pA1, 64 * (j + 1), qi, hi);
    finishSM(pB0, pB1, alB, l_reg, pa0, pa1, pa2, pa3); SBAR();
    if (j + 3 < NT) SLOAD(SE, (j + 3) * KVBLK); SBAR();
    pv_d0(o, vb0 + (int)SHM_V, pa0, pa1, pa2, pa3); partialSM(pA0, pA1, m_reg, mnA, alA);
    __syncthreads(); SWAIT(); SWRITE(1, SO);
    RESC(alA); __syncthreads();
  }
  SBAR(); qkt<QREG>(pB0, pB1, (bf16*)((char*)K_lds + SHM_K), qr, qv, r32, hi); if (BAND) bandmask(pB0, pB1, 64 * (NT - 1), qi, hi);
  finishSM(pA0, pA1, alA, l_reg, pa0, pa1, pa2, pa3); SBAR();
  pv_d0(o, vb0, pa0, pa1, pa2, pa3); partialSM(pB0, pB1, m_reg, mnB, alB);
  __syncthreads(); RESC(alB);
  finishSM(pB0, pB1, alB, l_reg, pa0, pa1, pa2, pa3); SBAR();
  pv_d0(o, vb0 + (int)SHM_V, pa0, pa1, pa2, pa3);
#undef SLOAD
#undef SWRITE
#undef SWAIT
#undef RESC
}

struct VFrag { s16x4 l0, h0, l1, h1, l2, h2, l3, h3; };
template <int D> __device__ __forceinline__ void vf_load(VFrag& f, int vb) {
  constexpr int B = (D >> 2) * 16384 + (D & 3) * 512;
  f.l0 = tr_read<B + 0 * 4096>(vb); f.h0 = tr_read<B + 0 * 4096 + 2048>(vb); f.l1 = tr_read<B + 1 * 4096>(vb); f.h1 = tr_read<B + 1 * 4096 + 2048>(vb);
  f.l2 = tr_read<B + 2 * 4096>(vb); f.h2 = tr_read<B + 2 * 4096 + 2048>(vb); f.l3 = tr_read<B + 3 * 4096>(vb); f.h3 = tr_read<B + 3 * 4096 + 2048>(vb);
}
__device__ __forceinline__ void vf_mma(f32x16& od, const VFrag& f, bf16x8 pa0, bf16x8 pa1, bf16x8 pa2, bf16x8 pa3) {
#define PK(L, H) (bf16x8){L[0], L[1], L[2], L[3], H[0], H[1], H[2], H[3]}
  od = __builtin_amdgcn_mfma_f32_32x32x16_bf16(pa0, PK(f.l0, f.h0), od, 0, 0, 0);
  od = __builtin_amdgcn_mfma_f32_32x32x16_bf16(pa1, PK(f.l1, f.h1), od, 0, 0, 0);
  od = __builtin_amdgcn_mfma_f32_32x32x16_bf16(pa2, PK(f.l2, f.h2), od, 0, 0, 0);
  od = __builtin_amdgcn_mfma_f32_32x32x16_bf16(pa3, PK(f.l3, f.h3), od, 0, 0, 0);
#undef PK
}
__device__ __forceinline__ void pv_wide(f32x16* o, int vb, bf16x8 pa0, bf16x8 pa1, bf16x8 pa2, bf16x8 pa3) {
  VFrag A, B;
#define VW(n) do { asm volatile("s_waitcnt lgkmcnt(" #n ")" ::: "memory"); SBAR(); } while (0)
  vf_load<0>(A, vb);
  vf_load<1>(B, vb); VW(8); vf_mma(o[0], A, pa0, pa1, pa2, pa3); SBAR();
  vf_load<2>(A, vb); VW(8); vf_mma(o[1], B, pa0, pa1, pa2, pa3); SBAR();
  vf_load<3>(B, vb); VW(8); vf_mma(o[2], A, pa0, pa1, pa2, pa3); SBAR();
  vf_load<4>(A, vb); VW(8); vf_mma(o[3], B, pa0, pa1, pa2, pa3); SBAR();
  vf_load<5>(B, vb); VW(8); vf_mma(o[4], A, pa0, pa1, pa2, pa3); SBAR();
  vf_load<6>(A, vb); VW(8); vf_mma(o[5], B, pa0, pa1, pa2, pa3); SBAR();
  vf_load<7>(B, vb); VW(8); vf_mma(o[6], A, pa0, pa1, pa2, pa3); SBAR();
  VW(0); vf_mma(o[7], B, pa0, pa1, pa2, pa3);
#undef VW
}
constexpr int DP_K = 0, DP_V = 32768, DP_P = 98304, DP_X = 131072;
#define DP_BAR() do { asm volatile("s_waitcnt vmcnt(0) lgkmcnt(0)" ::: "memory"); __builtin_amdgcn_s_barrier(); asm volatile("" ::: "memory"); } while (0)
__device__ __forceinline__ void diff_pass(const bf16* __restrict__ Qb, const bf16* __restrict__ Kh, const bf16* __restrict__ Vh, int ld, int NT, char* lds, bf16* Ob, int pfq) {
  int tid = threadIdx.x; asm volatile("" : "+v"(tid));
  const int wid = __builtin_amdgcn_readfirstlane(tid >> 6), lane = tid & 63, r32 = lane & 31, hi = lane >> 5, g = wid & 3;
  const bool prod = wid < 4;
  unsigned koff[2], voff[4];
#pragma unroll
  for (int i = 0; i < 2; ++i) { const int p = wid * 2 + i, row = p * 4 + (lane >> 4), cpos = (lane & 15) * 16; koff[i] = (unsigned)(row * ld * 2 + (cpos ^ ((row & 7) << 4))); }
#pragma unroll
  for (int i = 0; i < 4; ++i) { const int p = wid * 4 + i, hf = p >> 4, sub = (p & 15) * 2 + (lane >> 5), kk = (sub >> 2) * 8 + ((lane & 31) >> 2);
    const int k = (kk & ~0xC) | ((kk & 4) << 1) | ((kk & 8) >> 1), col = hf * 128 + (sub & 3) * 32 + (lane & 3) * 8; voff[i] = (unsigned)(k * ld * 2 + col * 2); }
  const long tstep = (long)64 * ld * 2;
  typedef __attribute__((address_space(3))) unsigned lds_u32;
#define DP_DMA_K(t, b) do { const char* _s = (const char*)Kh + (long)(t) * tstep; _Pragma("unroll") for (int _i = 0; _i < 2; ++_i) \
    __builtin_amdgcn_global_load_lds((const unsigned*)(_s + koff[_i]), (lds_u32*)(lds + DP_K + (b) * 16384 + (wid * 2 + _i) * 1024), 16, 0, 0); } while (0)
#define DP_DMA_V(t, b) do { const char* _s = (const char*)Vh + (long)(t) * tstep; _Pragma("unroll") for (int _i = 0; _i < 4; ++_i) \
    __builtin_amdgcn_global_load_lds((const unsigned*)(_s + voff[_i]), (lds_u32*)(lds + DP_V + (b) * 32768 + (wid * 4 + _i) * 1024), 16, 0, 0); } while (0)
  float* xg = (float*)(lds + DP_X) + g * 64;
  char* pg = lds + DP_P + g * 4096 + lane * 16;
  DP_DMA_K(0, 0); DP_DMA_V(0, 0); DP_DMA_K(1, 1);
#define DP_ISSUE(s) do { if ((s) + 2 < NT) DP_DMA_K((s) + 2, (s) & 1); if ((s) + 1 < NT) DP_DMA_V((s) + 1, ((s) + 1) & 1); } while (0)
  const int pl = 12 * pfq + lane; const unsigned pfo = pl < 128 ? (unsigned)((pl >> 1) * ld * 2 + (pl & 1) * 128) : (unsigned)(((pl - 128) >> 2) * ld * 2 + ((pl - 128) & 3) * 128);
  const char* pfb = pl < 128 ? (const char*)Kh : (const char*)Vh;
#define DP_PF(s) do { if (lane < 12) { const int _t = ((s) + 4 < NT) ? (s) + 4 : NT - 1; \
    __builtin_amdgcn_global_load_lds((const unsigned*)(pfb + (long)_t * tstep + pfo), (lds_u32*)(lds + 143360), 4, 0, 0); } } while (0)
#define DP_BAR1() do { asm volatile("s_waitcnt vmcnt(1) lgkmcnt(0)" ::: "memory"); __builtin_amdgcn_s_barrier(); asm volatile("" ::: "memory"); } while (0)
  if (prod) {
    float m_reg = NEG_BIG, l_reg = 0.f; bf16x8 qv[8];
    { const unsigned qo = (unsigned)((g * 32 + r32) * ld + hi * 8) * 2u;
#pragma unroll
      for (int d0 = 0; d0 < 8; ++d0) qv[d0] = *reinterpret_cast<const bf16x8*>((const char*)Qb + qo + d0 * 32); }
    DP_BAR();
#define DP_SCORE(j) do { f32x16 p0, p1; float mn, al; bf16x8 pa0, pa1, pa2, pa3; \
    qkt<true>(p0, p1, (const bf16*)(lds + DP_K + ((j) & 1) * 16384), nullptr, qv, r32, hi); partialSM(p0, p1, m_reg, mn, al); finishSM(p0, p1, al, l_reg, pa0, pa1, pa2, pa3); \
    char* _p = pg + ((j) & 1) * 16384; *reinterpret_cast<bf16x8*>(_p) = pa0; *reinterpret_cast<bf16x8*>(_p + 1024) = pa1; *reinterpret_cast<bf16x8*>(_p + 2048) = pa2; *reinterpret_cast<bf16x8*>(_p + 3072) = pa3; \
    float* _x = xg + ((j) & 1) * 256; const bool _any = __any(al < 1.f); if (hi == 0) _x[r32] = al; if (lane == 0) _x[32] = _any ? 1.f : 0.f; } while (0)
    DP_SCORE(0);
    DP_BAR();
    for (int s = 0; s < NT; ++s) { DP_ISSUE(s); if (s + 1 < NT) DP_SCORE(s + 1); DP_BAR(); }
    if (hi == 0) xg[r32] = l_reg;
    DP_BAR();
  } else {
    f32x16 o[8];
#pragma unroll
    for (int d = 0; d < 8; ++d) o[d] = f32x16{};
    DP_BAR();
    DP_BAR();
    for (int s = 0; s < NT; ++s) {
      DP_ISSUE(s); if (wid == 7) DP_PF(s);
      const float* x = xg + (s & 1) * 256;
      if (__builtin_amdgcn_readfirstlane(__float_as_int(x[32])) != 0) {
#pragma unroll
        for (int r = 0; r < 16; ++r) { const float a = x[crow(r, hi)];
#pragma unroll
          for (int d = 0; d < 8; ++d) o[d][r] *= a; } }
      const char* p = pg + (s & 1) * 16384;
      const bf16x8 pa0 = *reinterpret_cast<const bf16x8*>(p), pa1 = *reinterpret_cast<const bf16x8*>(p + 1024), pa2 = *reinterpret_cast<const bf16x8*>(p + 2048), pa3 = *reinterpret_cast<const bf16x8*>(p + 3072);
      const int vb = (int)(uintptr_t)(lds + DP_V + (s & 1) * 32768) + v_rd_base(lane);
      asm volatile("s_waitcnt lgkmcnt(0)" ::: "memory"); SBAR();
      pv_wide(o, vb, pa0, pa1, pa2, pa3);
      if (wid == 7) DP_BAR1(); else DP_BAR();
    }
    DP_BAR();
    bf16* Ow = Ob + (size_t)(g * 32) * 2048 + r32;
#pragma unroll
    for (int r = 0; r < 16; ++r) { const float il = __builtin_amdgcn_rcpf(xg[crow(r, hi)]); bf16* pr = Ow + (size_t)crow(r, hi) * 2048;
#pragma unroll
      for (int d = 0; d < 8; ++d) pr[d * 32] = (bf16)f2bf(o[d][r] * il); }
  }
  DP_BAR();
#undef DP_ISSUE
#undef DP_PF
#undef DP_BAR1
#undef DP_DMA_K
#undef DP_DMA_V
#undef DP_SCORE
}
__device__ __forceinline__ void row_recip(char* lds, float l_reg, float (&rli)[16]) {
  const int tid = threadIdx.x, wid = tid >> 6, lane = tid & 63, r32 = lane & 31, hi = lane >> 5;
  float* li_l = (float*)(lds + 2 * SHM_V + 2 * SHM_K) + wid * 64;
  if (hi == 0) li_l[r32] = l_reg; asm volatile("s_waitcnt lgkmcnt(0)" ::: "memory");
#pragma unroll
  for (int r = 0; r < 16; ++r) rli[r] = __builtin_amdgcn_rcpf(li_l[crow(r, hi)]);
  asm volatile("s_waitcnt lgkmcnt(0)" ::: "memory");
}
#undef KSWZ
}

struct Args {
    const float* x; const float* mem; const int* pos;
    const float *g_mix_pre, *w_in, *w_a, *w_b, *w_mix, *g_mix_post, *lq1, *lk1, *lq2, *lk2, *subln;
    const float *g_mem_pre, *g_mem_kv, *w_mq, *w_mkv, *w_mo, *g_mem_post, *g_mlp_pre, *w_up, *w_dn, *g_mlp_post;
    float* out; unsigned char* ws; int ph_lo, ph_hi, li, pad;
};
struct Frame {
    LAS unsigned char* lds; volatile LAS unsigned* MISC; gu32* ctl;
    int tid, lane, wave, vcu, G;
};
__device__ __forceinline__ float wave_sum(float v) {
#pragma unroll
    for (int o = 1; o < 64; o <<= 1) v += __shfl_xor(v, o);
    return v;
}
__device__ __forceinline__ float wave_max(float v) {
#pragma unroll
    for (int o = 1; o < 64; o <<= 1) v = fmaxf(v, __shfl_xor(v, o));
    return v;
}
__device__ __forceinline__ void p0_transpose_cols(const float* W, int K, int N, int scol, bf16* WT, int drow, LAS float* scr, int kb, int lane);
__device__ __forceinline__ void p0_transpose_item(const float* W, int K, int N, bf16* WT, LAS float* scr, int item, int lane) {
    const int nblk = N / 32, kb = item / nblk, nb = item % nblk, k0 = 64 * kb, n0 = 32 * nb;
    const int lr = lane >> 3, lc = (lane & 7) * 4;
    const GAS float* src = (const GAS float*)W + (size_t)(k0 + lr) * N + n0 + lc;
    f32x4 v[8];
#pragma unroll
    for (int i = 0; i < 8; ++i) v[i] = __builtin_nontemporal_load((const GAS f32x4*)(src + (size_t)(8 * i) * N));
#pragma unroll
    for (int i = 0; i < 8; ++i) { LAS float* d = scr + (8 * i + lr) * 33 + lc; d[0] = v[i].x; d[1] = v[i].y; d[2] = v[i].z; d[3] = v[i].w; }
    LDS_WAIT(); asm volatile("" ::: "memory");
    const int c = lane & 7;
#pragma unroll
    for (int j = 0; j < 4; ++j) { const int n = (lane >> 3) + 8 * j; const LAS float* s = scr + (8 * c) * 33 + n;
        v4u o; o.x = pk2(s[0 * 33], s[1 * 33]); o.y = pk2(s[2 * 33], s[3 * 33]); o.z = pk2(s[4 * 33], s[5 * 33]); o.w = pk2(s[6 * 33], s[7 * 33]);
        __builtin_nontemporal_store(o, (GAS v4u*)(WT + (size_t)(n0 + n) * K + k0 + 8 * c)); }
    LDS_WAIT(); asm volatile("" ::: "memory");
}
__device__ __forceinline__ void p0_transpose_cols(const float* W, int K, int N, int scol, bf16* WT, int drow, LAS float* scr, int kb, int lane) {
    const int k0 = 64 * kb;
    const int lr = lane >> 3, lc = (lane & 7) * 4;
    const GAS float* src = (const GAS float*)W + (size_t)(k0 + lr) * N + scol + lc;
    f32x4 v[8];
#pragma unroll
    for (int i = 0; i < 8; ++i) v[i] = __builtin_nontemporal_load((const GAS f32x4*)(src + (size_t)(8 * i) * N));
#pragma unroll
    for (int i = 0; i < 8; ++i) { LAS float* d = scr + (8 * i + lr) * 33 + lc; d[0] = v[i].x; d[1] = v[i].y; d[2] = v[i].z; d[3] = v[i].w; }
    LDS_WAIT(); asm volatile("" ::: "memory");
    const int c = lane & 7;
#pragma unroll
    for (int j = 0; j < 4; ++j) { const int n = (lane >> 3) + 8 * j; const LAS float* s = scr + (8 * c) * 33 + n;
        v4u o; o.x = pk2(s[0 * 33], s[1 * 33]); o.y = pk2(s[2 * 33], s[3 * 33]); o.z = pk2(s[4 * 33], s[5 * 33]); o.w = pk2(s[6 * 33], s[7 * 33]);
        __builtin_nontemporal_store(o, (GAS v4u*)(WT + (size_t)(drow + n) * K + k0 + 8 * c)); }
    LDS_WAIT(); asm volatile("" ::: "memory");
}
__device__ __forceinline__ unsigned pk4_fp8(float a, float b, float c, float d) { int w = 0; w = __builtin_amdgcn_cvt_pk_fp8_f32(a, b, w, false); w = __builtin_amdgcn_cvt_pk_fp8_f32(c, d, w, true); return (unsigned)w; }
__device__ __forceinline__ void p0_transpose_item_fp8(const float* W, int K, int N, int ncol0, unsigned char* W8, int row0, float scale, LAS float* scr, int kb, int nb, int lane) {
    const int k0 = 64 * kb, n0 = 32 * nb;
    const int lr = lane >> 3, lc = (lane & 7) * 4;
    const GAS float* src = (const GAS float*)W + (size_t)(k0 + lr) * N + ncol0 + n0 + lc;
    f32x4 v[8];
#pragma unroll
    for (int i = 0; i < 8; ++i) v[i] = __builtin_nontemporal_load((const GAS f32x4*)(src + (size_t)(8 * i) * N));
#pragma unroll
    for (int i = 0; i < 8; ++i) { LAS float* d = scr + (8 * i + lr) * 33 + lc; d[0] = v[i].x; d[1] = v[i].y; d[2] = v[i].z; d[3] = v[i].w; }
    LDS_WAIT(); asm volatile("" ::: "memory");
    const int c = lane & 7;
#pragma unroll
    for (int j = 0; j < 4; ++j) { const int n = (lane >> 3) + 8 * j; const LAS float* s = scr + (8 * c) * 33 + n;
        v2u o; o.x = pk4_fp8(s[0 * 33] * scale, s[1 * 33] * scale, s[2 * 33] * scale, s[3 * 33] * scale); o.y = pk4_fp8(s[4 * 33] * scale, s[5 * 33] * scale, s[6 * 33] * scale, s[7 * 33] * scale);
        __builtin_nontemporal_store(o, (GAS v2u*)(W8 + (size_t)(row0 + n0 + n) * K + k0 + 8 * c)); }
    LDS_WAIT(); asm volatile("" ::: "memory");
}
__device__ __forceinline__ void rms_row_to_bf16(const float* xrow, const float* g, bf16* orow, int lane, unsigned char* o8row = nullptr) {
    const GAS f32x4* xr = (const GAS f32x4*)xrow + lane; const GAS f32x4* gr = (const GAS f32x4*)g + lane;
    f32x4 v[16]; float s = 0.f;
#pragma unroll
    for (int j = 0; j < 16; ++j) { v[j] = __builtin_nontemporal_load(xr + 64 * j); s += (v[j].x * v[j].x + v[j].y * v[j].y) + (v[j].z * v[j].z + v[j].w * v[j].w); }
    const float rstd = 1.f / sqrtf(wave_sum(s) * (1.f / DM) + NORM_EPS);
    GAS v2u* o8 = (GAS v2u*)orow + lane;
#pragma unroll
    for (int j = 0; j < 16; ++j) { const f32x4 gg = gr[64 * j]; const f32x4 y = {v[j].x * rstd * gg.x, v[j].y * rstd * gg.y, v[j].z * rstd * gg.z, v[j].w * rstd * gg.w};
        v2u o; o.x = pk2(y.x, y.y); o.y = pk2(y.z, y.w); o8[64 * j] = o;
        if (o8row) ((GAS unsigned*)o8row + lane)[64 * j] = pk4_fp8(y.x, y.y, y.z, y.w); }
}
__device__ __forceinline__ void rms_row_to_i8(const float* xrow, const float* g, unsigned char* qrow, float* scale, int lane, bf16* hrow = nullptr) {
    const GAS f32x4* xr = (const GAS f32x4*)xrow + lane; const GAS f32x4* gr = (const GAS f32x4*)g + lane;
    f32x4 v[16]; float s = 0.f;
#pragma unroll
    for (int j = 0; j < 16; ++j) { v[j] = __builtin_nontemporal_load(xr + 64 * j); s += (v[j].x * v[j].x + v[j].y * v[j].y) + (v[j].z * v[j].z + v[j].w * v[j].w); }
    const float rstd = 1.f / sqrtf(wave_sum(s) * (1.f / DM) + NORM_EPS); float am = 0.f;
#pragma unroll
    for (int j = 0; j < 16; ++j) { const f32x4 gg = gr[64 * j]; v[j].x *= rstd * gg.x; v[j].y *= rstd * gg.y; v[j].z *= rstd * gg.z; v[j].w *= rstd * gg.w;
        am = fmaxf(fmaxf(am, fmaxf(fabsf(v[j].x), fabsf(v[j].y))), fmaxf(fabsf(v[j].z), fabsf(v[j].w))); }
    am = wave_max(am); const float inv = am > 0.f ? 127.f / am : 0.f;
    if (lane == 0) *scale = am * (1.f / 127.f);
    GAS unsigned* o4 = (GAS unsigned*)qrow + lane;
#pragma unroll
    for (int j = 0; j < 16; ++j) { const int a = (int)__builtin_rintf(v[j].x * inv), b = (int)__builtin_rintf(v[j].y * inv), c = (int)__builtin_rintf(v[j].z * inv), d = (int)__builtin_rintf(v[j].w * inv);
        o4[64 * j] = (unsigned)(a & 255) | ((unsigned)(b & 255) << 8) | ((unsigned)(c & 255) << 16) | ((unsigned)d << 24);
        if (hrow) { v2u o; o.x = pk2(v[j].x, v[j].y); o.y = pk2(v[j].z, v[j].w); ((GAS v2u*)hrow + lane)[64 * j] = o; } }
}
__device__ __forceinline__ void unpack4(const v2u w, f32x4& v) { v.x = __builtin_bit_cast(float, w.x << 16); v.y = __builtin_bit_cast(float, w.x & 0xffff0000u); v.z = __builtin_bit_cast(float, w.y << 16); v.w = __builtin_bit_cast(float, w.y & 0xffff0000u); }
template <bool BB, bool OB>
__device__ __forceinline__ void norm_res_row(const bf16* yrow, const float* g1, const void* brow, void* orow, const float* g2, bf16* hrow, int lane, unsigned char* q8row = nullptr, float* qscale = nullptr) {
    const GAS v2u* yr = (const GAS v2u*)yrow + lane; const GAS f32x4* gr = (const GAS f32x4*)g1 + lane;
    f32x4 v[16]; float s = 0.f;
    v2u yw[16], bw[BB ? 16 : 1]; f32x4 bf[BB ? 1 : 16];
#pragma unroll
    for (int j = 0; j < 16; ++j) yw[j] = __builtin_nontemporal_load(yr + 64 * j);
#pragma unroll
    for (int j = 0; j < 16; ++j) { if (BB) bw[j] = __builtin_nontemporal_load((const GAS v2u*)brow + lane + 64 * j); else bf[j] = __builtin_nontemporal_load((const GAS f32x4*)brow + lane + 64 * j); }
#pragma unroll
    for (int j = 0; j < 16; ++j) { unpack4(yw[j], v[j]); s += (v[j].x * v[j].x + v[j].y * v[j].y) + (v[j].z * v[j].z + v[j].w * v[j].w); }
    const float rstd = 1.f / sqrtf(wave_sum(s) * (1.f / DM) + NORM_EPS);
    float s2 = 0.f;
#pragma unroll
    for (int j = 0; j < 16; ++j) { const f32x4 gg = gr[64 * j]; f32x4 bb;
        if (BB) unpack4(bw[j], bb); else bb = bf[j];
        v[j] = bb + v[j] * rstd * gg;
        if (OB) { v2u o; o.x = pk2(v[j].x, v[j].y); o.y = pk2(v[j].z, v[j].w); ((GAS v2u*)orow + lane)[64 * j] = o; unpack4(o, v[j]); }
        else __builtin_nontemporal_store(v[j], (GAS f32x4*)orow + lane + 64 * j);
        s2 += (v[j].x * v[j].x + v[j].y * v[j].y) + (v[j].z * v[j].z + v[j].w * v[j].w); }
    if (g2) {
        const float rstd2 = 1.f / sqrtf(wave_sum(s2) * (1.f / DM) + NORM_EPS);
        const GAS f32x4* g2r = (const GAS f32x4*)g2 + lane;
        if (q8row) {
            float am = 0.f;
#pragma unroll
            for (int j = 0; j < 16; ++j) { const f32x4 gg = g2r[64 * j]; v[j].x *= rstd2 * gg.x; v[j].y *= rstd2 * gg.y; v[j].z *= rstd2 * gg.z; v[j].w *= rstd2 * gg.w;
                am = fmaxf(fmaxf(am, fmaxf(fabsf(v[j].x), fabsf(v[j].y))), fmaxf(fabsf(v[j].z), fabsf(v[j].w))); }
            am = wave_max(am); const float inv = am > 0.f ? 127.f / am : 0.f;
            if (lane == 0) *qscale = am * (1.f / 127.f);
            GAS unsigned* o4 = (GAS unsigned*)q8row + lane;
#pragma unroll
            for (int j = 0; j < 16; ++j) { const int a = (int)__builtin_rintf(v[j].x * inv), b = (int)__builtin_rintf(v[j].y * inv), c = (int)__builtin_rintf(v[j].z * inv), d = (int)__builtin_rintf(v[j].w * inv);
                o4[64 * j] = (unsigned)(a & 255) | ((unsigned)(b & 255) << 8) | ((unsigned)(c & 255) << 16) | ((unsigned)d << 24); }
        } else {
            GAS v2u* o8 = (GAS v2u*)hrow + lane;
#pragma unroll
            for (int j = 0; j < 16; ++j) { const f32x4 gg = g2r[64 * j]; v2u o; o.x = pk2(v[j].x * rstd2 * gg.x, v[j].y * rstd2 * gg.y); o.y = pk2(v[j].z * rstd2 * gg.z, v[j].w * rstd2 * gg.w); o8[64 * j] = o; }
        }
    }
}
__device__ __forceinline__ void quant_row_wdn(const bf16* xrow, unsigned char* qrow, float* scale, int* rsum, int lane) {
    float am = 0.f;
    for (int sgm = 0; sgm < D_FF / DM; ++sgm) { const GAS v4u* xr = (const GAS v4u*)(xrow + sgm * DM) + lane;
#pragma unroll
        for (int i = 0; i < 8; ++i) { const v4u w = xr[64 * i];
#pragma unroll
            for (int j = 0; j < 4; ++j) am = fmaxf(am, fmaxf(fabsf(__builtin_bit_cast(float, w[j] << 16)), fabsf(__builtin_bit_cast(float, w[j] & 0xffff0000u)))); } }
    am = wave_max(am); const float inv = am > 0.f ? 127.f / am : 0.f; int sum = 0;
    for (int sgm = 0; sgm < D_FF / DM; ++sgm) { const GAS v4u* xr = (const GAS v4u*)(xrow + sgm * DM) + lane; GAS v2u* o = (GAS v2u*)(qrow + sgm * DM) + lane;
#pragma unroll
        for (int i = 0; i < 8; ++i) { const v4u w = xr[64 * i]; unsigned q[8];
#pragma unroll
            for (int j = 0; j < 4; ++j) { const int a = (int)__builtin_rintf(__builtin_bit_cast(float, w[j] << 16) * inv), b = (int)__builtin_rintf(__builtin_bit_cast(float, w[j] & 0xffff0000u) * inv); sum += a + b; q[2 * j] = (unsigned)a & 255u; q[2 * j + 1] = (unsigned)b & 255u; }
            v2u ov; ov.x = q[0] | (q[1] << 8) | (q[2] << 16) | (q[3] << 24); ov.y = q[4] | (q[5] << 8) | (q[6] << 16) | (q[7] << 24); o[64 * i] = ov; } }
#pragma unroll
    for (int o = 1; o < 64; o <<= 1) sum += __shfl_xor(sum, o);
    if (lane == 0) { *scale = am * (1.f / 127.f); *rsum = sum; }
}
template <int NCH = 8>
__device__ __forceinline__ void quant_row_bf16_i8(const bf16* xrow, unsigned char* qrow, float* scale, int lane) {
    const GAS v4u* xr = (const GAS v4u*)xrow + lane; v4u w[NCH]; float am = 0.f;
#pragma unroll
    for (int i = 0; i < NCH; ++i) { w[i] = xr[64 * i];
#pragma unroll
        for (int j = 0; j < 4; ++j) am = fmaxf(am, fmaxf(fabsf(__builtin_bit_cast(float, w[i][j] << 16)), fabsf(__builtin_bit_cast(float, w[i][j] & 0xffff0000u)))); }
    am = wave_max(am); const float inv = am > 0.f ? 127.f / am : 0.f;
    if (lane == 0) *scale = am * (1.f / 127.f);
    GAS v2u* o = (GAS v2u*)qrow + lane;
#pragma unroll
    for (int i = 0; i < NCH; ++i) { unsigned q[8];
#pragma unroll
        for (int j = 0; j < 4; ++j) { q[2 * j] = (unsigned)((int)__builtin_rintf(__builtin_bit_cast(float, w[i][j] << 16) * inv)) & 255u; q[2 * j + 1] = (unsigned)((int)__builtin_rintf(__builtin_bit_cast(float, w[i][j] & 0xffff0000u) * inv)) & 255u; }
        v2u ov; ov.x = q[0] | (q[1] << 8) | (q[2] << 16) | (q[3] << 24); ov.y = q[4] | (q[5] << 8) | (q[6] << 16) | (q[7] << 24); o[64 * i] = ov; }
}

template <bool SPLITK>
__device__ __forceinline__ void colblock32_i8(const float* W, int N, int c0, int k0, unsigned char* qrows, int qpitch, float* scales, LAS unsigned char* img, int tid_,
                                              unsigned* gmax = nullptr, unsigned* gcnt = nullptr, int* gsum = nullptr) {
    int tid = tid_; asm volatile("" : "+v"(tid));
    const int w = tid >> 6, l = tid & 63, g = l & 7, s = w * 8 + (l >> 3);
    LAS unsigned* red = (LAS unsigned*)(img + 131072);
    if (tid < 64) red[tid] = 0u;
    const unsigned voff = (unsigned)((4 * s) * N + 4 * g) * 4u;
    const size_t rowB = (size_t)N * 4;
    const char* pb = (const char*)(W + (size_t)k0 * N + c0);
    unsigned d[16][8]; float mx[4] = {0.f, 0.f, 0.f, 0.f};
    f32x4 v[3][4];
#define CB_LOAD(b) do { _Pragma("unroll") for (int i = 0; i < 4; ++i) v[(b) % 3][i] = __builtin_nontemporal_load((const GAS f32x4*)(pb + (size_t)i * rowB + voff)); pb += 256 * rowB; } while (0)
    CB_LOAD(0); CB_LOAD(1);
#pragma unroll
    for (int j = 0; j < 16; ++j) {
        if (j + 2 < 16) CB_LOAD(j + 2);
#pragma unroll
        for (int q = 0; q < 4; ++q) { const float a0 = v[j % 3][0][q], a1 = v[j % 3][1][q], a2 = v[j % 3][2][q], a3 = v[j % 3][3][q];
            d[j][2 * q] = att::cvtpk(a0, a1); d[j][2 * q + 1] = att::cvtpk(a2, a3);
            mx[q] = fmaxf(fmaxf(mx[q], fmaxf(fabsf(a0), fabsf(a1))), fmaxf(fabsf(a2), fabsf(a3))); }
        __builtin_amdgcn_sched_barrier(0);
    }
#undef CB_LOAD
    __syncthreads();
#pragma unroll
    for (int q = 0; q < 4; ++q) __hip_atomic_fetch_max(red + 4 * g + q, __builtin_bit_cast(unsigned, mx[q]), __ATOMIC_RELAXED, __HIP_MEMORY_SCOPE_WORKGROUP);
    __syncthreads();
    if constexpr (SPLITK) {
        if (tid < 64) {
            if (tid < 32) __hip_atomic_fetch_max(gmax + tid, red[tid], __ATOMIC_RELAXED, __HIP_MEMORY_SCOPE_AGENT);
            __builtin_amdgcn_fence(__ATOMIC_RELEASE, "agent");
            if (tid == 0) { __hip_atomic_fetch_add(gcnt, 1u, __ATOMIC_RELEASE, __HIP_MEMORY_SCOPE_AGENT);
                while (__hip_atomic_load(gcnt, __ATOMIC_ACQUIRE, __HIP_MEMORY_SCOPE_AGENT) < 4u) __builtin_amdgcn_s_sleep(2); }
            __builtin_amdgcn_fence(__ATOMIC_ACQUIRE, "agent");
            if (tid < 32) red[tid] = __hip_atomic_load(gmax + tid, __ATOMIC_RELAXED, __HIP_MEMORY_SCOPE_AGENT); }
        __syncthreads();
    }
    float inv[4];
#pragma unroll
    for (int q = 0; q < 4; ++q) { float m = __builtin_bit_cast(float, red[4 * g + q]);
        m = __builtin_bit_cast(float, f2bf(m) << 16);
        inv[q] = m > 0.f ? 127.f / m : 0.f;
        if (s == 0 && k0 == 0) scales[4 * g + q] = m * (1.f / 127.f); }
    LAS unsigned char* wb = img + (4 * g) * 4096 + (((s >> 2) ^ g) << 4) + ((s & 3) << 2);
    int sq[4] = {0, 0, 0, 0};
#pragma unroll
    for (int j = 0; j < 16; ++j)
#pragma unroll
        for (int q = 0; q < 4; ++q) { const unsigned p0 = d[j][2 * q], p1 = d[j][2 * q + 1];
            const int i0 = (int)__builtin_rintf(__builtin_bit_cast(float, p0 << 16) * inv[q]), i1 = (int)__builtin_rintf(__builtin_bit_cast(float, p0 & 0xffff0000u) * inv[q]);
            const int i2 = (int)__builtin_rintf(__builtin_bit_cast(float, p1 << 16) * inv[q]), i3 = (int)__builtin_rintf(__builtin_bit_cast(float, p1 & 0xffff0000u) * inv[q]);
            if constexpr (SPLITK) sq[q] += (i0 + i1) + (i2 + i3);
            *(LAS unsigned*)(wb + q * 4096 + j * 256) = ((unsigned)i0 & 255u) | (((unsigned)i1 & 255u) << 8) | (((unsigned)i2 & 255u) << 16) | ((unsigned)i3 << 24); }
    if constexpr (SPLITK) {
#pragma unroll
        for (int q = 0; q < 4; ++q) __hip_atomic_fetch_add((LAS int*)red + 32 + 4 * g + q, sq[q], __ATOMIC_RELAXED, __HIP_MEMORY_SCOPE_WORKGROUP); }
    __syncthreads();
    if constexpr (SPLITK) { if (tid < 32) __hip_atomic_fetch_add(gsum + tid, ((LAS int*)red)[32 + tid], __ATOMIC_RELAXED, __HIP_MEMORY_SCOPE_AGENT); }
    { const LAS unsigned char* rb = img + (4 * w) * 4096 + ((l ^ w) << 4); GAS unsigned char* ob = (GAS unsigned char*)qrows + (size_t)(4 * w) * qpitch + 16 * l;
#pragma unroll
      for (int r = 0; r < 4; ++r)
#pragma unroll
        for (int i = 0; i < 4; ++i) { const v4u x = *(const LAS v4u*)(rb + r * 4096 + i * 1024); *(GAS v4u*)(ob + (size_t)r * qpitch + i * 1024) = x; } }
    __syncthreads();
}
__device__ __forceinline__ void q_drain(Frame& F, const Args& a, int q, int cw, int n);
constexpr int CW_Q0 = 256;
constexpr int Q0_QK = (DM / 64) * (4096 / 32), Q0_MKV = (DM / 64) * (1024 / 32), Q0_N = Q0_QK + Q0_MKV + MTOK + MROWS;
__device__ __forceinline__ void p0_prologue(Frame& F, const Args& a) {
    unsigned char* ws = a.ws;
    for (int job = F.vcu; job < (D_IN - 4096) / 32; job += F.G) { const int vr0 = 32 * job, n0 = vr0 < C_QB ? vr0 : vr0 + 4096;
        colblock32_i8<false>(a.w_in, D_IN, n0, 0, ws + WS_OD + (size_t)vr0 * DM, DM, (float*)(ws + WS_SBIN) + n0, F.lds + RING_OFF, F.tid); }
    q_drain(F, a, 0, CW_Q0, Q0_N);
}

constexpr int QI_A = (1024 / 64) * (DM / 32), QI_B = (2048 / 64) * (DM / 32), QI_MIX = (DM / 64) * (DM / 32), QI_MQ = (DM / 64) * (512 / 32), QI_MO = (512 / 64) * (DM / 32),
              QI_UP = (DM / 64) * (D_FF / 32), QI_DN = (D_FF / 64) * (DM / 32);
constexpr int Q1_N = QI_A + QI_B + QI_MIX + QI_MQ + QI_MO;
constexpr int CW_QJ = 320;
constexpr int CW_DMAX = 81920, CW_DSUM = 86016, CW_DCNT = 90112;
constexpr int CW_Q1 = 64, CW_Q2 = 128, CW_Q3 = 192;
__device__ __forceinline__ void q_item(const Args& a, int q, int r, LAS float* scr, int lane) {
    unsigned char* ws = a.ws;
    if (q == 0) {
        if (r < Q0_QK) { const int kb = r / 128, nb = r % 128; p0_transpose_cols(a.w_in, DM, D_IN, C_QB + 32 * nb, (bf16*)(ws + WS_WIN), C_QB + 32 * nb, scr, kb, lane); return; } r -= Q0_QK;
        if (r < Q0_MKV) { p0_transpose_item(a.w_mkv, DM, 1024, (bf16*)(ws + WS_WMKV), scr, r, lane); return; } r -= Q0_MKV;
        if (r < MTOK) { const int m = r;
            rms_row_to_i8(a.x + (size_t)m * DM, a.g_mix_pre, ws + WS_OBR + (size_t)m * DM, (float*)(ws + WS_SA0) + m, lane, (bf16*)(ws + WS_H) + (size_t)m * DM);
            const float ang = (float)a.pos[m] * INV_FREQ[lane];
            const double rev = (double)ang * 0.15915494309189533577;
            const float fr = (float)(rev - __builtin_floor(rev));
            float2 cs; cs.x = __builtin_amdgcn_cosf(fr); cs.y = __builtin_amdgcn_sinf(fr);
            ((float2*)(ws + WS_ROPE))[(size_t)m * 64 + lane] = cs; return; } r -= MTOK;
        rms_row_to_bf16(a.mem + (size_t)r * DM, a.g_mem_kv, (bf16*)(ws + WS_MB) + (size_t)r * DM, lane); return;
    }
    if (q == 1) {
        if (r < QI_A) { p0_transpose_item(a.w_a, 1024, DM, (bf16*)(ws + WS_WA), scr, r, lane); return; } r -= QI_A;
        if (r < QI_B) { p0_transpose_item(a.w_b, 2048, DM, (bf16*)(ws + WS_WB), scr, r, lane); return; } r -= QI_B;
        if (r < QI_MIX) { p0_transpose_item(a.w_mix, DM, DM, (bf16*)(ws + WS_WMIX), scr, r, lane); return; } r -= QI_MIX;
        if (r < QI_MQ) { p0_transpose_item(a.w_mq, DM, 512, (bf16*)(ws + WS_WMQ), scr, r, lane); return; } r -= QI_MQ;
        p0_transpose_item(a.w_mo, 512, DM, (bf16*)(ws + WS_WMO), scr, r, lane);
    }
}
__device__ __forceinline__ void q_drain(Frame& F, const Args& a, int q, int cw, int n) {
    LAS float* scr = (LAS float*)(F.lds + RING_OFF + F.wave * 16384);
    int lane = F.lane; asm volatile("" : "+v"(lane));
    constexpr int BATCH_ITEMS = 8;
    for (;;) {
        unsigned base = 0;
        if (lane == 0) base = __hip_atomic_fetch_add((unsigned*)(F.ctl + cw), (unsigned)BATCH_ITEMS, __ATOMIC_RELAXED, __HIP_MEMORY_SCOPE_AGENT);
        base = (unsigned)__builtin_amdgcn_readfirstlane((int)base);
        if (base >= (unsigned)n) break;
        const int e = ((int)base + BATCH_ITEMS < n) ? (int)base + BATCH_ITEMS : n;
        for (int it = (int)base; it < e; ++it) q_item(a, q, it, scr, lane);
    }
}
__device__ __forceinline__ unsigned pk4_i8(const f32x4 v, float inv) { const int a = (int)__builtin_rintf(v.x * inv), b = (int)__builtin_rintf(v.y * inv), c = (int)__builtin_rintf(v.z * inv), d = (int)__builtin_rintf(v.w * inv);
    return (unsigned)(a & 255) | ((unsigned)(b & 255) << 8) | ((unsigned)(c & 255) << 16) | ((unsigned)d << 24); }
__device__ __forceinline__ float amax4(const f32x4 v) { return fmaxf(fmaxf(fabsf(v.x), fabsf(v.y)), fmaxf(fabsf(v.z), fabsf(v.w))); }
__device__ __forceinline__ void thin_mix_row(const bf16* OD, const float* LSE, const bf16* OBR, const bf16* OBR2, float lam, const float* subln, unsigned char* OA8, float* sa4, unsigned char* OB8, float* sa5, int row, int lane) {
    { const int h = lane >> 3;
      const float l0 = LSE[((size_t)0 * MTOK + row) * 8 + h], l1 = LSE[((size_t)1 * MTOK + row) * 8 + h], l2 = LSE[((size_t)2 * MTOK + row) * 8 + h];
      const float mx = fmaxf(l0, fmaxf(l1, l2)); float e0 = __expf(l0 - mx), e1 = __expf(l1 - mx), e2 = __expf(l2 - mx); const float inv = 1.f / (e0 + e1 + e2); e0 *= inv; e1 *= inv; e2 *= inv;
      const GAS v2u* p0 = (const GAS v2u*)(OD + ((size_t)0 * MTOK + row) * 1024) + lane * 4; const GAS v2u* p1 = (const GAS v2u*)(OD + ((size_t)1 * MTOK + row) * 1024) + lane * 4;
      const GAS v2u* p2 = (const GAS v2u*)(OD + ((size_t)2 * MTOK + row) * 1024) + lane * 4; f32x4 v[4]; float am = 0.f;
#pragma unroll
      for (int j = 0; j < 4; ++j) { f32x4 a, b, c; unpack4(__builtin_nontemporal_load(p0 + j), a); unpack4(__builtin_nontemporal_load(p1 + j), b); unpack4(__builtin_nontemporal_load(p2 + j), c); v[j] = a * e0 + b * e1 + c * e2; am = fmaxf(am, amax4(v[j])); }
      am = wave_max(am); const float qi = am > 0.f ? 127.f / am : 0.f; if (lane == 0) sa4[row] = am * (1.f / 127.f);
      v4u w;
#pragma unroll
      for (int j = 0; j < 4; ++j) w[j] = pk4_i8(v[j], qi);
      ((GAS v4u*)(OA8 + (size_t)row * 1024))[lane] = w; }
    { const GAS v2u* p = (const GAS v2u*)(OBR + (size_t)row * 2048) + lane; const GAS v2u* p2 = (const GAS v2u*)(OBR2 + (size_t)row * 2048) + lane; const f32x4 g = ((const GAS f32x4*)subln)[lane]; f32x4 y[8]; float am = 0.f;
      v2u aw[8], bw[8];
#pragma unroll
      for (int h = 0; h < 8; ++h) { aw[h] = __builtin_nontemporal_load(p + 64 * h); bw[h] = __builtin_nontemporal_load(p2 + 64 * h); }
#pragma unroll
      for (int h = 0; h < 8; ++h) { f32x4 a, b; unpack4(aw[h], a); unpack4(bw[h], b); const f32x4 v = a - b * lam; const float s = wave_sum((v.x * v.x + v.y * v.y) + (v.z * v.z + v.w * v.w));
          const float rstd = 0.8f / sqrtf(s * (1.f / 256.f) + NORM_EPS); y[h] = (f32x4){v.x * rstd * g.x, v.y * rstd * g.y, v.z * rstd * g.z, v.w * rstd * g.w}; am = fmaxf(am, amax4(y[h])); }
      am = wave_max(am); const float qi = am > 0.f ? 127.f / am : 0.f; if (lane == 0) sa5[row] = am * (1.f / 127.f);
      GAS unsigned* o = (GAS unsigned*)(OB8 + (size_t)row * 2048) + lane;
#pragma unroll
      for (int h = 0; h < 8; ++h) o[64 * h] = pk4_i8(y[h], qi); }
}

#ifndef PG8_SP2
#define PG8_SP2 true
#endif
#ifndef PG8_ALIGN
#define PG8_ALIGN true
#endif
#ifndef MK_FP8_SP2
#define MK_FP8_SP2 true
#endif
#ifndef MK_FP8_ALIGN
#define MK_FP8_ALIGN true
#endif
#ifndef MK_QREG_DIFF
#define MK_QREG_DIFF true
#endif
#ifndef MK_QREG_CROSS
#define MK_QREG_CROSS true
#endif
constexpr int NPHASE = 15;
#ifndef MK_FAST
#define MK_FAST 0x7FFFu
#endif
constexpr unsigned FAST = MK_FAST;
__global__ void __launch_bounds__(NWAVES * 64, 2) mk_fwd(Args args) {
    extern __shared__ __attribute__((aligned(16))) unsigned char lds[];
    Frame F;
    F.lds = (LAS unsigned char*)lds;
    F.MISC = (volatile LAS unsigned*)(F.lds + MISC_OFF);
    F.tid = threadIdx.x; F.lane = F.tid & 63; F.wave = __builtin_amdgcn_readfirstlane(F.tid >> 6);
    F.G = gridDim.x; { const int bx = blockIdx.x; F.vcu = (F.G % 8 == 0) ? (bx % 8) * (F.G / 8) + bx / 8 : bx; }
    F.ctl = (gu32*)(args.ws + WS_CTL);
    for (int u = F.tid; u < (LDS_BYTES - LDSCTL_OFF) / 4; u += NWAVES * 64) ((LAS unsigned*)(F.lds + LDSCTL_OFF))[u] = 0u;
    __syncthreads();
    const int ph_lo_ = args.ph_lo, ph_hi_ = args.ph_hi;
    unsigned* barw = (unsigned*)(F.ctl + CW_BAR) + args.li * XCD_BAR_WORDS;
    XcdBarrier bar; bar.bar = barw; bar.x = 0; bar.st = F.MISC + 8;
    if (ph_hi_ - ph_lo_ > 1) bar = xcd_barrier_post(barw, F.MISC + 8);
#define IN(k) (ph_lo_ <= (k) && (k) < ph_hi_)
#define SEAM(k) do { if (IN(k) && IN((k) + 1)) xcd_barrier(bar); } while (0)
    if (IN(0)) { p0_prologue(F, args); SEAM(0); }
    unsigned char* ws = args.ws; asm volatile("" : "+s"(ws));
    bf16 *WIN = (bf16*)(ws + WS_WIN), *WA = (bf16*)(ws + WS_WA), *WB = (bf16*)(ws + WS_WB), *WMIX = (bf16*)(ws + WS_WMIX), *WMQ = (bf16*)(ws + WS_WMQ), *WMKV = (bf16*)(ws + WS_WMKV),
         *WMO = (bf16*)(ws + WS_WMO), *WUP = (bf16*)(ws + WS_WUP), *WDN = (bf16*)(ws + WS_WDN), *H = (bf16*)(ws + WS_H), *MB = (bf16*)(ws + WS_MB), *PROJ = (bf16*)(ws + WS_PROJ),
         *U = (bf16*)(ws + WS_U), *OA = (bf16*)(ws + WS_OA), *OBN = (bf16*)(ws + WS_OBN), *MERGED = (bf16*)(ws + WS_MERGED), *Q2 = (bf16*)(ws + WS_Q2), *KV2 = (bf16*)(ws + WS_KV2), *O2 = (bf16*)(ws + WS_O2);
    float *ROPE = (float*)(ws + WS_ROPE), *LSE = (float*)(ws + WS_LSE); bf16 *OD = (bf16*)(ws + WS_OD)  , *OBR = (bf16*)(ws + WS_OBR), *OBR2 = (bf16*)(ws + WS_OBR + 32 * MiB)  ; bf16* Y = (bf16*)(ws + WS_Y); bf16* XR = (bf16*)(ws + WS_OD + 48 * MiB);
    const int gw = F.vcu * NWAVES + F.wave, NGW = F.G * NWAVES;
    if (IN(1)) {
        { pg8::Gemm g{H, WIN + (size_t)C_QB * DM, MTOK, 4096, DM, DM, DM, 0, 0, C_QB / 256}; pg8::StaticOrder S; S.init(MTOK, 4096, F.G, (int)blockIdx.x);
          pg8::EpiProj<false> E{PROJ, ROPE, 1.f};
          pg8::gemm_phase<pg8::EpiProj<false>, pg8::StaticOrder, PG8_ALIGN, PG8_SP2>(F.lds + RING_OFF, g, S, E); }
        { pg8::Gemm g{(const bf16*)(ws + WS_OBR), (const bf16*)(ws + WS_OD), MTOK, D_IN - 4096, DM, DM, DM, C_QB / 256, 0, 16}; pg8::StaticOrder S; S.init(MTOK, D_IN - 4096, F.G, (int)blockIdx.x);
          pg8::EpiProjI8 E{PROJ, ROPE, (const float*)(ws + WS_SA0), (const float*)(ws + WS_SBIN)};
          pg8::gemm_phase<pg8::EpiProjI8, pg8::StaticOrder, PG8_ALIGN, PG8_SP2, false, true>(F.lds + RING_OFF, g, S, E); }
        { pg8::Gemm g{MB, WMKV, MROWS, 1024, DM / 2, DM, DM}; pg8::StaticOrder S; S.init(MROWS, 1024, F.G, (int)((blockIdx.x + F.G - 128) % F.G));
          pg8::EpiF32 E{(float*)(ws + WS_Y + 64 * MiB), 1024};
          pg8::gemm_phase<pg8::EpiF32, pg8::StaticOrder, PG8_ALIGN, PG8_SP2>(F.lds + RING_OFF, g, S, E); }
        { pg8::Gemm g{MB + DM / 2, WMKV + DM / 2, MROWS, 1024, DM / 2, DM, DM}; pg8::StaticOrder S; S.init(MROWS, 1024, F.G, (int)((blockIdx.x + F.G - 136) % F.G));
          pg8::EpiF32 E{(float*)(ws + WS_Y + 68 * MiB), 1024};
          pg8::gemm_phase<pg8::EpiF32, pg8::StaticOrder, PG8_ALIGN, PG8_SP2>(F.lds + RING_OFF, g, S, E); }
        q_drain(F, args, 1, CW_Q1, Q1_N);
        SEAM(1);
    }
    if (IN(2)) {
        char* alds = (char*)lds + RING_OFF;
        const int wid = F.wave;
#ifndef MK_NO_DIFF
        for (int u = F.vcu; u < BATCH * 8 * (SEQ / 128); u += F.G) {
            const int b = u / (8 * (SEQ / 128)), h = (u / (SEQ / 128)) % 8, qb = u % (SEQ / 128);
            const size_t row0 = (size_t)b * SEQ + (size_t)qb * 128;
            for (int c = 0; c < 2; ++c)
                att::diff_pass(PROJ + row0 * D_IN + C_QB + (h * 2 + c) * 128, PROJ + (size_t)b * SEQ * D_IN + C_KB + (h * 2 + c) * 128, PROJ + (size_t)b * SEQ * D_IN + C_VB + h * 256,
                               D_IN, SEQ / 64, alds, (c == 0 ? OBR : OBR2) + row0 * 2048 + h * 256, qb);
        }
#endif
#ifndef MK_NO_DIL
        for (int u = F.vcu; u < 768; u += F.G) {
            const int g = u >> 8, v = u & 255, b = v >> 7, h = (v >> 4) & 7, rq = v & 15;
            const int dil = (g == 0) ? 1 : (g == 1 ? 4 : 16), res = rq % dil, qblk = rq / dil, L = SEQ / dil;
            const int q0 = qblk * 256, NT = (g == 2) ? 4 : 6; int t0 = q0 / 64 - 1; t0 = t0 < 0 ? 0 : t0; t0 = (t0 > L / 64 - NT) ? (L / 64 - NT) : t0;
            const size_t base = ((size_t)b * SEQ + res) * D_IN + (g * 8 + h) * 128; const long ld = (long)dil * D_IN;
            att::f32x16 o[4]; float m_reg, l_reg;
            att::body<true, false>(PROJ + base + (size_t)q0 * ld + C_QA, ld, PROJ + base + (size_t)(t0 * 64) * ld + C_KA, PROJ + base + (size_t)(t0 * 64) * ld + C_VA, ld, NT, q0 - t0 * 64, alds, o, m_reg, l_reg);
            float rli[16]; att::row_recip(alds, l_reg, rli);
                int ln_ = F.lane; asm volatile("" : "+v"(ln_)); const int r32 = ln_ & 31, hi = ln_ >> 5;
            const size_t tok0 = (size_t)b * SEQ + res + (size_t)(q0 + wid * 32) * dil;
            bf16* Ow = OD + ((size_t)g * MTOK + tok0) * 1024 + h * 128 + r32;
#pragma unroll
            for (int r = 0; r < 16; ++r) { bf16* p = Ow + (size_t)att::crow(r, hi) * dil * 1024;
#pragma unroll
                for (int d0 = 0; d0 < 4; ++d0) p[d0 * 32] = (bf16)f2bf(o[d0][r] * rli[r]); }
            if (hi == 0) LSE[((size_t)g * MTOK + tok0 + (size_t)r32 * dil) * 8 + h] = m_reg * att::SCALE + __logf(l_reg);
        }
#endif
        for (;;) { if (F.tid == 0) F.MISC[16] = __hip_atomic_fetch_add((unsigned*)(F.ctl + 384), 48u, __ATOMIC_RELAXED, __HIP_MEMORY_SCOPE_AGENT);
            __syncthreads(); const unsigned base = F.MISC[16]; __syncthreads();
            if (base >= 3u * DM) break;
            for (unsigned it = base + 6u * F.wave; it < base + 6u * F.wave + 6u; ++it) { const int n = (int)(it & (DM - 1)), which = (int)(it >> 12);
                if (which == 0) quant_row_bf16_i8<2>(WA + (size_t)n * 1024, ws + WS_DTMP + (size_t)n * 1024, (float*)(ws + WS_SBA) + n, F.lane);
                else if (which == 1) quant_row_bf16_i8<4>(WB + (size_t)n * 2048, ws + WS_DTMP + 4 * MiB + (size_t)n * 2048, (float*)(ws + WS_SBB) + n, F.lane);
                else quant_row_bf16_i8(WMIX + (size_t)n * DM, ws + WS_WIN + (size_t)n * DM, (float*)(ws + WS_SBMIX) + n, F.lane); } }
        SEAM(2);
    }
    if (IN(3)) {
        const float ld1 = wave_sum(args.lq1[F.lane] * args.lk1[F.lane] + args.lq1[F.lane + 64] * args.lk1[F.lane + 64]);
        const float ld2 = wave_sum(args.lq2[F.lane] * args.lk2[F.lane] + args.lq2[F.lane + 64] * args.lk2[F.lane + 64]);
        const float lam = __expf(ld1) - __expf(ld2) + 0.2f;
        for (int m = gw; m < MTOK; m += NGW) thin_mix_row(OD, LSE, OBR, OBR2, lam, args.subln, (unsigned char*)OA, (float*)(ws + WS_SA4), (unsigned char*)OBN, (float*)(ws + WS_SA5), m, F.lane);
        { const GAS f32x4* k0 = (const GAS f32x4*)(ws + WS_Y + 64 * MiB); const GAS f32x4* k1 = (const GAS f32x4*)(ws + WS_Y + 68 * MiB); GAS v2u* ko = (GAS v2u*)KV2;
          for (int c = F.vcu * (NWAVES * 64) + F.tid; c < MROWS * 1024 / 4; c += F.G * NWAVES * 64) { const f32x4 a = k0[c], b = k1[c]; v2u o; o.x = pk2(a.x + b.x, a.y + b.y); o.y = pk2(a.z + b.z, a.w + b.w); ko[c] = o; } }
        SEAM(3); }
    if (IN(4)) { pg8::Gemm g{OA, (const bf16*)(ws + WS_DTMP), MTOK, DM, 1024, 1024, 1024}; pg8::StaticOrder S; S.init(MTOK, DM, F.G, (int)blockIdx.x);
        pg8::EpiGateI8<false> E{MERGED, DM, PROJ + C_GA, D_IN, (const float*)(ws + WS_SA4), (const float*)(ws + WS_SBA)};
        pg8::gemm_phase<pg8::EpiGateI8<false>, pg8::StaticOrder, PG8_ALIGN, PG8_SP2, false, true>(F.lds + RING_OFF, g, S, E); }
    if (IN(5)) { pg8::Gemm g{OBN, (const bf16*)(ws + WS_DTMP + 4 * MiB), MTOK, DM, 2048, 2048, 2048}; pg8::StaticOrder S; S.init(MTOK, DM, F.G, (int)blockIdx.x);
        pg8::EpiGateI8<true> E{MERGED, DM, PROJ + C_GB, D_IN, (const float*)(ws + WS_SA5), (const float*)(ws + WS_SBB)};
        pg8::gemm_phase<pg8::EpiGateI8<true>, pg8::StaticOrder, PG8_ALIGN, PG8_SP2, false, true>(F.lds + RING_OFF, g, S, E); SEAM(5); }
    if (IN(6)) { unsigned char* M8 = ws + WS_WIN + 32 * MiB;
        for (int m = gw; m < MTOK; m += NGW) quant_row_bf16_i8(MERGED + (size_t)m * DM, M8 + (size_t)m * DM, (float*)(ws + WS_SAM) + m, F.lane);
        xcd_barrier(bar);
        pg8::Gemm g{(const bf16*)M8, (const bf16*)(ws + WS_WIN), MTOK, DM, DM, DM, DM}; pg8::StaticOrder S; S.init(MTOK, DM, F.G, (int)blockIdx.x);
        pg8::EpiI8Bf16 E{Y, DM, (const float*)(ws + WS_SAM), (const float*)(ws + WS_SBMIX)};
        pg8::gemm_phase<pg8::EpiI8Bf16, pg8::StaticOrder, PG8_ALIGN, PG8_SP2, false, true>(F.lds + RING_OFF, g, S, E); SEAM(6); }
    if (IN(7)) { for (int m = gw; m < MTOK; m += NGW) norm_res_row<false, true>(Y + (size_t)m * DM, args.g_mix_post, args.x + (size_t)m * DM, XR + (size_t)m * DM, args.g_mem_pre, H + (size_t)m * DM, F.lane); SEAM(7); }
    if (IN(8)) {
        pg8::Gemm g{H, WMQ, MTOK, 512, DM, DM, DM}; pg8::StaticOrder S; S.init(MTOK, 512, F.G, (int)blockIdx.x);
        pg8::EpiBf16<0> E{Q2, 512};
        pg8::gemm_phase<pg8::EpiBf16<0>, pg8::StaticOrder, PG8_ALIGN, PG8_SP2>(F.lds + RING_OFF, g, S, E);
#ifndef MK_NO_CROSS
        pg8::Unit u8;
        if (S.next(0, u8)) {
            VM_WAIT(); __builtin_amdgcn_fence(__ATOMIC_ACQUIRE, "agent"); VM_WAIT(); __syncthreads();
            char* alds = (char*)lds + RING_OFF; const int wid = F.wave;
            const size_t row0 = (size_t)u8.pm * 256; const int b = u8.pm / (SEQ / 256);
            for (int hh = 2 * u8.pn; hh < 2 * u8.pn + 2; ++hh) {
                att::f32x16 o[4]; float m_reg, l_reg;
                att::body<false, MK_QREG_CROSS>(Q2 + row0 * 512 + hh * 128, 512, KV2 + (size_t)b * MEM_LEN * 1024 + hh * 128, KV2 + (size_t)b * MEM_LEN * 1024 + 512 + hh * 128, 1024, MEM_LEN / 64, 0, alds, o, m_reg, l_reg);
                float rli[16]; att::row_recip(alds, l_reg, rli);
                int ln_ = F.lane; asm volatile("" : "+v"(ln_)); const int r32 = ln_ & 31, hi = ln_ >> 5;
                bf16* Ow = O2 + (row0 + wid * 32) * 512 + hh * 128 + r32;
#pragma unroll
                for (int r = 0; r < 16; ++r) { bf16* p = Ow + (size_t)att::crow(r, hi) * 512;
#pragma unroll
                    for (int d0 = 0; d0 < 4; ++d0) { const float v = o[d0][r] * rli[r]; const float nb = __shfl_xor(v, 1); if (!(ln_ & 1)) *(unsigned*)(p + d0 * 32) = pk2(v, nb); } }
            }
            __syncthreads();
        }
#endif
        for (;;) { if (F.tid == 0) F.MISC[16] = __hip_atomic_fetch_add((unsigned*)(F.ctl + CW_QJ), 1u, __ATOMIC_RELAXED, __HIP_MEMORY_SCOPE_AGENT);
            __syncthreads(); const int job = (int)F.MISC[16]; __syncthreads();
            if (job >= D_FF / 32 + 4 * (DM / 32)) break;
            if (job < D_FF / 32) colblock32_i8<false>(args.w_up, D_FF, 32 * job, 0, ws + WS_WIN + (size_t)(32 * job) * DM, DM, (float*)(ws + WS_SB) + 32 * job, F.lds + RING_OFF, F.tid);
            else { const int jd = job - D_FF / 32, cb = jd >> 2, kq = jd & 3;
                colblock32_i8<true>(args.w_dn, DM, 32 * cb, 4096 * kq, ws + WS_DTMP + (size_t)(32 * cb) * D_FF + 4096 * kq, D_FF, (float*)(ws + WS_SD) + 32 * cb, F.lds + RING_OFF, F.tid,
                                    (unsigned*)(F.ctl + CW_DMAX) + 32 * cb, (unsigned*)(F.ctl + CW_DCNT) + cb, (int*)(F.ctl + CW_DSUM) + 32 * cb); } }
        SEAM(8);
    }
    if (IN(10)) { pg8::Gemm g{O2, WMO, MTOK, DM, 512, 512, 512}; pg8::StaticOrder S; S.init(MTOK, DM, F.G, (int)blockIdx.x);
        pg8::EpiBf16<0> E{Y, DM};
        pg8::gemm_phase<pg8::EpiBf16<0>, pg8::StaticOrder, PG8_ALIGN, PG8_SP2>(F.lds + RING_OFF, g, S, E); SEAM(10); }
    if (IN(11)) { for (int m = gw; m < MTOK; m += NGW) norm_res_row<true, true>(Y + (size_t)m * DM, args.g_mem_post, XR + (size_t)m * DM, XR + (size_t)m * DM, args.g_mlp_pre, nullptr, F.lane, ws + WS_H8 + (size_t)m * DM, (float*)(ws + WS_SA) + m);
        SEAM(11); }
    if (IN(12)) { pg8::Gemm g{(const bf16*)(ws + WS_H8), (const bf16*)(ws + WS_WIN), MTOK, D_FF, DM, DM, DM}; pg8::StaticOrder S; S.init(MTOK, D_FF, F.G, (int)blockIdx.x);
        pg8::EpiI8Relu2 E{U, D_FF, (const float*)(ws + WS_SA), (const float*)(ws + WS_SB), (unsigned*)(F.ctl + CW_UMAX)};
        pg8::gemm_phase<pg8::EpiI8Relu2, pg8::StaticOrder, PG8_ALIGN, PG8_SP2, false, true>(F.lds + RING_OFF, g, S, E);
        xcd_barrier(bar);
        { const unsigned* um = (const unsigned*)(F.ctl + CW_UMAX);
          for (int m = gw; m < MTOK; m += NGW) {
              const float mx = __builtin_bit_cast(float, __hip_atomic_load(um + m, __ATOMIC_RELAXED, __HIP_MEMORY_SCOPE_AGENT)); const float inv = mx > 0.f ? 255.f / mx : 0.f;
              const GAS v4u* src = (const GAS v4u*)(U + (size_t)m * D_FF) + F.lane; GAS v2u* dst = (GAS v2u*)(ws + WS_WIN + (size_t)m * D_FF) + F.lane;
#pragma unroll
              for (int bt = 0; bt < 2; ++bt) { v4u w[16];
#pragma unroll
                  for (int i = 0; i < 16; ++i) w[i] = __builtin_nontemporal_load(src + 64 * (16 * bt + i));
#pragma unroll
                  for (int i = 0; i < 16; ++i) { unsigned q[8];
#pragma unroll
                      for (int j = 0; j < 4; ++j) { int a = (int)__builtin_rintf(__builtin_bit_cast(float, w[i][j] << 16) * inv), b = (int)__builtin_rintf(__builtin_bit_cast(float, w[i][j] & 0xffff0000u) * inv);
                          a = (a > 255 ? 255 : a) - 128; b = (b > 255 ? 255 : b) - 128; q[2 * j] = (unsigned)a & 255u; q[2 * j + 1] = (unsigned)b & 255u; }
                      v2u ov; ov.x = q[0] | (q[1] << 8) | (q[2] << 16) | (q[3] << 24); ov.y = q[4] | (q[5] << 8) | (q[6] << 16) | (q[7] << 24); dst[64 * (16 * bt + i)] = ov; } }
              if (F.lane == 0) ((float*)(ws + WS_SU))[m] = mx * (1.f / 255.f); } }
        SEAM(12); }
    if (IN(13)) { pg8::Gemm g{(const bf16*)(ws + WS_WIN), (const bf16*)(ws + WS_DTMP), MTOK, DM, D_FF, D_FF, D_FF}; pg8::StaticOrder S; S.init(MTOK, DM, F.G, (int)blockIdx.x);
        pg8::EpiI8Down E{Y, DM, (const float*)(ws + WS_SU), (const float*)(ws + WS_SD), (const int*)(F.ctl + CW_DSUM)};
        pg8::gemm_phase<pg8::EpiI8Down, pg8::StaticOrder, PG8_ALIGN, PG8_SP2, false, true>(F.lds + RING_OFF, g, S, E); SEAM(13); }
    if (IN(14)) { for (int m = gw; m < MTOK; m += NGW) norm_res_row<true, false>(Y + (size_t)m * DM, args.g_mlp_post, XR + (size_t)m * DM, args.out + (size_t)m * DM, nullptr, nullptr, F.lane); }
#undef IN
#undef SEAM
}

namespace nv {
enum { EP_BF16 = 0, EP_F32 = 1, EP_RELU2 = 2, EP_GATE = 3, EP_GATE_ADD = 4 };
template <int EP>
__global__ __launch_bounds__(256) void gemm(const bf16* __restrict__ A, int lda, const bf16* __restrict__ Bt, int ldb, void* Cv, int ldc, int K, const bf16* __restrict__ gate, int ldg) {
    __shared__ float As[16][132], Bs[16][132];
    const int tid = threadIdx.x, tx = tid & 15, ty = tid >> 4;
    const int m0 = blockIdx.y * 128, n0 = blockIdx.x * 128;
    const int lr = tid >> 1, lc = (tid & 1) * 8;
    float acc[8][8];
#pragma unroll
    for (int i = 0; i < 8; ++i)
#pragma unroll
        for (int j = 0; j < 8; ++j) acc[i][j] = 0.f;
    for (int k0 = 0; k0 < K; k0 += 16) {
        const v4u av = *(const v4u*)(A + (size_t)(m0 + lr) * lda + k0 + lc);
        const v4u bv = *(const v4u*)(Bt + (size_t)(n0 + lr) * ldb + k0 + lc);
        __syncthreads();
        As[lc + 0][lr] = __builtin_bit_cast(float, av.x << 16); As[lc + 1][lr] = __builtin_bit_cast(float, av.x & 0xffff0000u);
        As[lc + 2][lr] = __builtin_bit_cast(float, av.y << 16); As[lc + 3][lr] = __builtin_bit_cast(float, av.y & 0xffff0000u);
        As[lc + 4][lr] = __builtin_bit_cast(float, av.z << 16); As[lc + 5][lr] = __builtin_bit_cast(float, av.z & 0xffff0000u);
        As[lc + 6][lr] = __builtin_bit_cast(float, av.w << 16); As[lc + 7][lr] = __builtin_bit_cast(float, av.w & 0xffff0000u);
        Bs[lc + 0][lr] = __builtin_bit_cast(float, bv.x << 16); Bs[lc + 1][lr] = __builtin_bit_cast(float, bv.x & 0xffff0000u);
        Bs[lc + 2][lr] = __builtin_bit_cast(float, bv.y << 16); Bs[lc + 3][lr] = __builtin_bit_cast(float, bv.y & 0xffff0000u);
        Bs[lc + 4][lr] = __builtin_bit_cast(float, bv.z << 16); Bs[lc + 5][lr] = __builtin_bit_cast(float, bv.z & 0xffff0000u);
        Bs[lc + 6][lr] = __builtin_bit_cast(float, bv.w << 16); Bs[lc + 7][lr] = __builtin_bit_cast(float, bv.w & 0xffff0000u);
        __syncthreads();
#pragma unroll
        for (int kk = 0; kk < 16; ++kk) {
            float a[8], b[8];
#pragma unroll
            for (int i = 0; i < 8; ++i) a[i] = As[kk][ty * 8 + i];
#pragma unroll
            for (int j = 0; j < 8; ++j) b[j] = Bs[kk][tx * 8 + j];
#pragma unroll
            for (int i = 0; i < 8; ++i)
#pragma unroll
                for (int j = 0; j < 8; ++j) acc[i][j] += a[i] * b[j];
        }
    }
#pragma unroll
    for (int i = 0; i < 8; ++i) {
        const size_t r = (size_t)(m0 + ty * 8 + i);
#pragma unroll
        for (int j = 0; j < 8; ++j) {
            const int c = n0 + tx * 8 + j; float v = acc[i][j];
            if (EP == EP_F32) { ((float*)Cv)[r * ldc + c] = v; }
            else {
                bf16* C = (bf16*)Cv;
                if (EP == EP_RELU2) { v = v > 0.f ? v * v : 0.f; }
                if (EP == EP_GATE) { v = v * bf2f(gate[r * ldg + c]); }
                if (EP == EP_GATE_ADD) { v = v * bf2f(gate[r * ldg + c]) + bf2f(C[r * ldc + c]); }
                C[r * ldc + c] = (bf16)f2bf(v);
            }
        }
    }
}
__global__ __launch_bounds__(256) void proj_post(bf16* proj, const float* rope) {
    const int row = blockIdx.x; bf16* p = proj + (size_t)row * D_IN; const float2* rt = (const float2*)rope + (size_t)row * 64;
    for (int e = threadIdx.x; e < 80 * 64; e += 256) {
        const int ch = e >> 6, i = e & 63; const int c0 = (ch < 48 ? ch * 128 : C_QB + (ch - 48) * 128);
        const float x1 = bf2f(p[c0 + i]), x2 = bf2f(p[c0 + 64 + i]); const float2 cs = rt[i];
        p[c0 + i] = (bf16)f2bf(x1 * cs.x - x2 * cs.y); p[c0 + 64 + i] = (bf16)f2bf(x2 * cs.x + x1 * cs.y);
    }
    for (int c = C_GA + threadIdx.x; c < D_IN; c += 256) { const float g = bf2f(p[c]); p[c] = (bf16)f2bf(1.f / (1.f + __expf(-g))); }
}
template <int NV>
__device__ __forceinline__ void attn_block(const float* qs, const bf16* Kb, const bf16* Vb, size_t pitch, int myrow, float& m, float& l, float (&o)[NV], int lane) {
    float s = -INFINITY;
    if (myrow >= 0) { const bf16* kp = Kb + (size_t)myrow * pitch; float acc = 0.f;
        for (int d = 0; d < 128; d += 8) { const v4u kv = *(const v4u*)(kp + d);
            acc += qs[d + 0] * __builtin_bit_cast(float, kv.x << 16) + qs[d + 1] * __builtin_bit_cast(float, kv.x & 0xffff0000u);
            acc += qs[d + 2] * __builtin_bit_cast(float, kv.y << 16) + qs[d + 3] * __builtin_bit_cast(float, kv.y & 0xffff0000u);
            acc += qs[d + 4] * __builtin_bit_cast(float, kv.z << 16) + qs[d + 5] * __builtin_bit_cast(float, kv.z & 0xffff0000u);
            acc += qs[d + 6] * __builtin_bit_cast(float, kv.w << 16) + qs[d + 7] * __builtin_bit_cast(float, kv.w & 0xffff0000u); }
        s = acc * ATT_SCALE; }
    const float bm = wave_max(s);
    if (bm == -INFINITY) return;
    const float mn = fmaxf(m, bm), alpha = __expf(m - mn);
    const float p = (myrow >= 0) ? __expf(s - mn) : 0.f;
    l = l * alpha + wave_sum(p);
#pragma unroll
    for (int t = 0; t < NV; ++t) o[t] *= alpha;
    for (int j = 0; j < 64; ++j) {
        const float pj = __shfl(p, j); const int rj = __shfl(myrow, j);
        if (rj >= 0) { const bf16* vp = Vb + (size_t)rj * pitch;
#pragma unroll
            for (int t = 0; t < NV; ++t) o[t] += pj * bf2f(vp[lane + 64 * t]); }
    }
    m = mn;
}
__global__ __launch_bounds__(256) void dil_attn(const bf16* proj, float* OD, float* LSE) {
    __shared__ float qsm[4][128];
    const int wv = threadIdx.x >> 6, lane = threadIdx.x & 63; const int task = blockIdx.x * 4 + wv; const int row = task >> 3, h = task & 7;
    const int b = row / SEQ, s = row % SEQ; float* qs = qsm[wv];
    for (int g = 0; g < 3; ++g) {
        const int dil = (g == 0) ? 1 : (g == 1 ? 4 : 16);
        const bf16* qp = proj + (size_t)row * D_IN + C_QA + (g * 8 + h) * 128;
        qs[lane] = bf2f(qp[lane]); qs[lane + 64] = bf2f(qp[lane + 64]);
        __syncthreads();
        const bf16* Kb = proj + (size_t)b * SEQ * D_IN + C_KA + (g * 8 + h) * 128; const bf16* Vb = proj + (size_t)b * SEQ * D_IN + C_VA + (g * 8 + h) * 128;
        float m = -INFINITY, l = 0.f, o[2] = {0.f, 0.f};
        for (int blk = 0; blk < 3; ++blk) {
            const int j = blk * 64 + lane; int idx = s + (j - 64) * dil; if (j > 128 || idx < 0 || idx >= SEQ) idx = -1;
            attn_block<2>(qs, Kb, Vb, D_IN, idx, m, l, o, lane);
        }
        const float il = 1.f / l;
        OD[((size_t)g * MTOK + row) * 1024 + h * 128 + lane] = o[0] * il; OD[((size_t)g * MTOK + row) * 1024 + h * 128 + 64 + lane] = o[1] * il;
        if (lane == 0) LSE[((size_t)g * MTOK + row) * 8 + h] = m + __logf(l);
        __syncthreads();
    }
}
__global__ __launch_bounds__(256) void diff_attn(const bf16* proj, float* OBR, const float* lq1, const float* lk1, const float* lq2, const float* lk2) {
    __shared__ float qsm[4][128];
    const int wv = threadIdx.x >> 6, lane = threadIdx.x & 63; const int task = blockIdx.x * 4 + wv; const int row = task >> 3, h = task & 7;
    const int b = row / SEQ; float* qs = qsm[wv];
    const float d1 = wave_sum(lq1[lane] * lk1[lane] + lq1[lane + 64] * lk1[lane + 64]), d2 = wave_sum(lq2[lane] * lk2[lane] + lq2[lane + 64] * lk2[lane + 64]);
    const float lam = __expf(d1) - __expf(d2) + 0.2f;
    float res[4] = {0.f, 0.f, 0.f, 0.f};
    for (int c = 0; c < 2; ++c) {
        const bf16* qp = proj + (size_t)row * D_IN + C_QB + (h * 2 + c) * 128;
        qs[lane] = bf2f(qp[lane]); qs[lane + 64] = bf2f(qp[lane + 64]);
        __syncthreads();
        const bf16* Kb = proj + (size_t)b * SEQ * D_IN + C_KB + (h * 2 + c) * 128; const bf16* Vb = proj + (size_t)b * SEQ * D_IN + C_VB + h * 256;
        float m = -INFINITY, l = 0.f, o[4] = {0.f, 0.f, 0.f, 0.f};
        for (int blk = 0; blk < SEQ / 64; ++blk) attn_block<4>(qs, Kb, Vb, D_IN, blk * 64 + lane, m, l, o, lane);
        const float il = (c == 0 ? 1.f : -lam) / l;
#pragma unroll
        for (int t = 0; t < 4; ++t) res[t] += o[t] * il;
        __syncthreads();
    }
#pragma unroll
    for (int t = 0; t < 4; ++t) OBR[(size_t)row * 2048 + h * 256 + lane + 64 * t] = res[t];
}
__global__ __launch_bounds__(256) void thin_mix(const float* OD, const float* LSE, const float* OBR, const float* subln, bf16* OA, bf16* OBN) {
    const int row = blockIdx.x, tid = threadIdx.x;
    for (int c = tid; c < 1024; c += 256) { const int h = c >> 7;
        const float l0 = LSE[((size_t)0 * MTOK + row) * 8 + h], l1 = LSE[((size_t)1 * MTOK + row) * 8 + h], l2 = LSE[((size_t)2 * MTOK + row) * 8 + h];
        const float mx = fmaxf(l0, fmaxf(l1, l2)); const float e0 = __expf(l0 - mx), e1 = __expf(l1 - mx), e2 = __expf(l2 - mx); const float inv = 1.f / (e0 + e1 + e2);
        const float v = (e0 * OD[((size_t)0 * MTOK + row) * 1024 + c] + e1 * OD[((size_t)1 * MTOK + row) * 1024 + c] + e2 * OD[((size_t)2 * MTOK + row) * 1024 + c]) * inv;
        OA[(size_t)row * 1024 + c] = (bf16)f2bf(v); }
    const int wv = tid >> 6, lane = tid & 63;
    for (int hh = 0; hh < 2; ++hh) { const int h = wv * 2 + hh; float v[4]; float s = 0.f;
#pragma unroll
        for (int t = 0; t < 4; ++t) { v[t] = OBR[(size_t)row * 2048 + h * 256 + lane + 64 * t]; s += v[t] * v[t]; }
        const float rstd = 1.f / sqrtf(wave_sum(s) * (1.f / 256.f) + NORM_EPS);
#pragma unroll
        for (int t = 0; t < 4; ++t) OBN[(size_t)row * 2048 + h * 256 + lane + 64 * t] = (bf16)f2bf(v[t] * rstd * subln[lane + 64 * t] * 0.8f); }
}
template <bool BB, bool OB>
__global__ __launch_bounds__(256) void norm_res(const bf16* Y, const float* g1, const void* base, void* out, const float* g2, bf16* H) {
    const int row = blockIdx.x * 4 + (threadIdx.x >> 6);
    const size_t bo = (size_t)row * DM * (BB ? 2 : 4), oo = (size_t)row * DM * (OB ? 2 : 4);
    norm_res_row<BB, OB>(Y + (size_t)row * DM, g1, (const char*)base + bo, (char*)out + oo, g2, H ? H + (size_t)row * DM : nullptr, threadIdx.x & 63);
}
__global__ __launch_bounds__(256) void cross_attn(const bf16* Q2, const bf16* KV2, bf16* O2) {
    __shared__ float qsm[4][128];
    const int wv = threadIdx.x >> 6, lane = threadIdx.x & 63; const int task = blockIdx.x * 4 + wv; const int row = task >> 2, h = task & 3;
    const int b = row / SEQ; float* qs = qsm[wv];
    const bf16* qp = Q2 + (size_t)row * 512 + h * 128;
    qs[lane] = bf2f(qp[lane]); qs[lane + 64] = bf2f(qp[lane + 64]);
    __syncthreads();
    const bf16* Kb = KV2 + (size_t)b * MEM_LEN * 1024 + h * 128; const bf16* Vb = Kb + 512;
    float m = -INFINITY, l = 0.f, o[2] = {0.f, 0.f};
    for (int blk = 0; blk < 4; ++blk) attn_block<2>(qs, Kb, Vb, 1024, blk * 64 + lane, m, l, o, lane);
    const float il = 1.f / l;
    O2[(size_t)row * 512 + h * 128 + lane] = (bf16)f2bf(o[0] * il); O2[(size_t)row * 512 + h * 128 + 64 + lane] = (bf16)f2bf(o[1] * il);
}
}

extern "C" void kernel_launch(void* const* d_in, const int* in_sizes, int n_in, void* d_out, int out_size, void* d_ws, size_t ws_size, hipStream_t stream) {
    static int grid = 0;
    if (grid == 0) {
        if (n_in != 24 || in_sizes[0] != MTOK * DM || out_size != MTOK * DM || ws_size < WS_END) { fprintf(stderr, "kernel_launch: shape mismatch n_in %d in0 %d out %d ws %zu (need %zu)\n", n_in, n_in > 0 ? in_sizes[0] : -1, out_size, ws_size, (size_t)WS_END); grid = -1; return; }
        int dev = 0, cus = 0;
        if (hipGetDevice(&dev) != hipSuccess || hipDeviceGetAttribute(&cus, hipDeviceAttributeMultiprocessorCount, dev) != hipSuccess) { grid = -1; return; }
        if (hipFuncSetAttribute((const void*)mk_fwd, hipFuncAttributeMaxDynamicSharedMemorySize, LDS_BYTES) != hipSuccess) { fprintf(stderr, "kernel_launch: hipFuncSetAttribute failed\n"); grid = -1; return; }
        (void)hipGetLastError();
        grid = cus;
    }
    if (grid < 0) return;
    (void)hipMemsetAsync((char*)d_ws + WS_CTL, 0, CTL_ZERO_BYTES, stream);
    Args a{};
    a.x = (const float*)d_in[0]; a.mem = (const float*)d_in[1]; a.pos = (const int*)d_in[2];
    a.g_mix_pre = (const float*)d_in[3]; a.w_in = (const float*)d_in[4]; a.w_a = (const float*)d_in[5]; a.w_b = (const float*)d_in[6]; a.w_mix = (const float*)d_in[7];
    a.g_mix_post = (const float*)d_in[8]; a.lq1 = (const float*)d_in[9]; a.lk1 = (const float*)d_in[10]; a.lq2 = (const float*)d_in[11]; a.lk2 = (const float*)d_in[12];
    a.subln = (const float*)d_in[13]; a.g_mem_pre = (const float*)d_in[14]; a.g_mem_kv = (const float*)d_in[15]; a.w_mq = (const float*)d_in[16]; a.w_mkv = (const float*)d_in[17];
    a.w_mo = (const float*)d_in[18]; a.g_mem_post = (const float*)d_in[19]; a.g_mlp_pre = (const float*)d_in[20]; a.w_up = (const float*)d_in[21]; a.w_dn = (const float*)d_in[22];
    a.g_mlp_post = (const float*)d_in[23];
    a.out = (float*)d_out; a.ws = (unsigned char*)d_ws;
    unsigned char* ws = (unsigned char*)d_ws;
    bf16 *WIN = (bf16*)(ws + WS_WIN), *WA = (bf16*)(ws + WS_WA), *WB = (bf16*)(ws + WS_WB), *WMIX = (bf16*)(ws + WS_WMIX), *WMQ = (bf16*)(ws + WS_WMQ), *WMKV = (bf16*)(ws + WS_WMKV),
         *WMO = (bf16*)(ws + WS_WMO), *WUP = (bf16*)(ws + WS_WUP), *WDN = (bf16*)(ws + WS_WDN), *H = (bf16*)(ws + WS_H), *MB = (bf16*)(ws + WS_MB), *PROJ = (bf16*)(ws + WS_PROJ),
         *U = (bf16*)(ws + WS_U), *OA = (bf16*)(ws + WS_OA), *OBN = (bf16*)(ws + WS_OBN), *MERGED = (bf16*)(ws + WS_MERGED), *Q2 = (bf16*)(ws + WS_Q2), *KV2 = (bf16*)(ws + WS_KV2), *O2 = (bf16*)(ws + WS_O2);
    float *ROPE = (float*)(ws + WS_ROPE), *OD = (float*)(ws + WS_OD), *LSE = (float*)(ws + WS_LSE), *OBR = (float*)(ws + WS_OBR); bf16* Y = (bf16*)(ws + WS_Y); float* OBR2 = (float*)(ws + WS_Y)  ; bf16* XR = (bf16*)(ws + WS_OD);
    float* OUT = (float*)d_out;
    auto naive = [&](int k) {
        switch (k) {
        case 1: hipLaunchKernelGGL(nv::gemm<nv::EP_BF16>, dim3(D_IN / 128, MTOK / 128), dim3(256), 0, stream, H, DM, WIN, DM, (void*)PROJ, D_IN, DM, (const bf16*)nullptr, 0);
                hipLaunchKernelGGL(nv::proj_post, dim3(MTOK), dim3(256), 0, stream, PROJ, (const float*)ROPE);
                hipLaunchKernelGGL(nv::gemm<nv::EP_BF16>, dim3(1024 / 128, MROWS / 128), dim3(256), 0, stream, MB, DM, WMKV, DM, (void*)KV2, 1024, DM, (const bf16*)nullptr, 0); break;
        case 2: hipLaunchKernelGGL(nv::dil_attn, dim3(MTOK * 8 / 4), dim3(256), 0, stream, (const bf16*)PROJ, OD, LSE);
                hipLaunchKernelGGL(nv::diff_attn, dim3(MTOK * 8 / 4), dim3(256), 0, stream, (const bf16*)PROJ, OBR, a.lq1, a.lk1, a.lq2, a.lk2); break;
        case 3: hipLaunchKernelGGL(nv::thin_mix, dim3(MTOK), dim3(256), 0, stream, (const float*)OD, (const float*)LSE, (const float*)OBR, a.subln, OA, OBN); break;
        case 4: hipLaunchKernelGGL(nv::gemm<nv::EP_GATE>, dim3(DM / 128, MTOK / 128), dim3(256), 0, stream, OA, 1024, WA, 1024, (void*)MERGED, DM, 1024, (const bf16*)(PROJ + C_GA), D_IN); break;
        case 5: hipLaunchKernelGGL(nv::gemm<nv::EP_GATE_ADD>, dim3(DM / 128, MTOK / 128), dim3(256), 0, stream, OBN, 2048, WB, 2048, (void*)MERGED, DM, 2048, (const bf16*)(PROJ + C_GB), D_IN); break;
        case 6: hipLaunchKernelGGL(nv::gemm<nv::EP_BF16>, dim3(DM / 128, MTOK / 128), dim3(256), 0, stream, MERGED, DM, WMIX, DM, (void*)Y, DM, DM, (const bf16*)nullptr, 0); break;
        case 7: hipLaunchKernelGGL((nv::norm_res<false, true>), dim3(MTOK / 4), dim3(256), 0, stream, (const bf16*)Y, a.g_mix_post, (const void*)a.x, (void*)XR, a.g_mem_pre, H); break;
        case 8: hipLaunchKernelGGL(nv::gemm<nv::EP_BF16>, dim3(512 / 128, MTOK / 128), dim3(256), 0, stream, H, DM, WMQ, DM, (void*)Q2, 512, DM, (const bf16*)nullptr, 0); break;
        case 9: hipLaunchKernelGGL(nv::cross_attn, dim3(MTOK * 4 / 4), dim3(256), 0, stream, (const bf16*)Q2, (const bf16*)KV2, O2); break;
        case 10: hipLaunchKernelGGL(nv::gemm<nv::EP_BF16>, dim3(DM / 128, MTOK / 128), dim3(256), 0, stream, O2, 512, WMO, 512, (void*)Y, DM, 512, (const bf16*)nullptr, 0); break;
        case 11: hipLaunchKernelGGL((nv::norm_res<true, true>), dim3(MTOK / 4), dim3(256), 0, stream, (const bf16*)Y, a.g_mem_post, (const void*)XR, (void*)XR, a.g_mlp_pre, H); break;
        case 12: hipLaunchKernelGGL(nv::gemm<nv::EP_RELU2>, dim3(D_FF / 128, MTOK / 128), dim3(256), 0, stream, H, DM, WUP, DM, (void*)U, D_FF, DM, (const bf16*)nullptr, 0); break;
        case 13: hipLaunchKernelGGL(nv::gemm<nv::EP_BF16>, dim3(DM / 128, MTOK / 128), dim3(256), 0, stream, U, D_FF, WDN, D_FF, (void*)Y, DM, D_FF, (const bf16*)nullptr, 0); break;
        case 14: hipLaunchKernelGGL((nv::norm_res<true, false>), dim3(MTOK / 4), dim3(256), 0, stream, (const bf16*)Y, a.g_mlp_post, (const void*)XR, (void*)OUT, (const float*)nullptr, (bf16*)nullptr); break;
        default: break;
        }
    };
#ifdef MK_PROBE_DUP
    { a.ph_lo = 0; a.ph_hi = MK_PROBE_DUP + 1; a.li = 0; hipLaunchKernelGGL(mk_fwd, dim3(grid), dim3(NWAVES * 64), LDS_BYTES, stream, a);
      a.ph_lo = MK_PROBE_DUP; a.ph_hi = NPHASE; a.li = 1; hipLaunchKernelGGL(mk_fwd, dim3(grid), dim3(NWAVES * 64), LDS_BYTES, stream, a); return; }
#endif
    int li = 0;
    for (int k = 0; k < NPHASE;) {
        if ((FAST >> k) & 1u) { int e = k + 1; while (e < NPHASE && ((FAST >> e) & 1u)) ++e;
            a.ph_lo = k; a.ph_hi = e; a.li = li++; hipLaunchKernelGGL(mk_fwd, dim3(grid), dim3(NWAVES * 64), LDS_BYTES, stream, a); k = e; }
        else { naive(k); ++k; }
    }
    const hipError_t le = hipPeekAtLastError();
    if (le != hipSuccess) fprintf(stderr, "kernel_launch: launch failed: %s\n", hipGetErrorName(le));
}
```
